# Optimizing an MI355X kernel written in HIP

```python
import jax, jax.numpy as jnp
from jax import lax
import numpy as np

D_MODEL = 1024
BATCH = 2
SEQ = 8192
DEPTH = 1
DEC_BATCH = 4
DEC_SEQ = 4096
PAST_LEN = 128

N_MEM = 256
MLA_HEADS = 8
QK_NOPE = 64
QK_ROPE = 32
QK_HEAD = QK_NOPE + QK_ROPE
V_HEAD = 64
Q_LORA = 384
KV_LORA = 256
CONV_WIDTH = 512
CONV_K = 3
XA_HEADS = 4
XA_HEAD = 128
N_BRANCH = 3
D_FF = 2816
ROPE_BASE = 10000.0
EPS = 1e-6
Q_BLOCK = 128

IN_SPLITS = (Q_LORA, KV_LORA, QK_ROPE, CONV_WIDTH, CONV_WIDTH, CONV_WIDTH, XA_HEADS * XA_HEAD, N_BRANCH * D_MODEL)
D_IN = Q_LORA + KV_LORA + QK_ROPE + 3 * CONV_WIDTH + XA_HEADS * XA_HEAD + N_BRANCH * D_MODEL

kernel_name = "hybrid_mla_shortconv_memory_encoder"


def _split_points():
    pts, acc = [], 0
    for w in IN_SPLITS[:-1]:
        acc += w
        pts.append(acc)
    return pts


def rmsnorm(x, g):
    xf = x.astype(jnp.float32)
    inv = lax.rsqrt(jnp.mean(xf * xf, axis=-1, keepdims=True) + EPS)
    return (xf * inv).astype(x.dtype) * g


def rope(x, pos):
    half = QK_ROPE // 2
    inv_freq = ROPE_BASE ** (-jnp.arange(half, dtype=jnp.float32) / half)
    ang = pos.astype(jnp.float32)[:, None] * inv_freq[None, :]
    cos = jnp.cos(ang)[:, None, :]
    sin = jnp.sin(ang)[:, None, :]
    xf = x.astype(jnp.float32)
    x1, x2 = xf[..., :half], xf[..., half:]
    return jnp.concatenate([x1 * cos - x2 * sin, x2 * cos + x1 * sin], axis=-1).astype(x.dtype)


def swiglu(x, w_gu, w_down):
    g, u = jnp.split(x @ w_gu, 2, axis=-1)
    return (jax.nn.silu(g) * u) @ w_down


def mla_attention(q, k, v):
    B, S, H, _ = q.shape
    nb = S // Q_BLOCK
    scale = QK_HEAD ** -0.5
    qb = q.reshape(B, nb, Q_BLOCK, H, QK_HEAD).transpose(1, 0, 2, 3, 4)

    def one_block(qblk):
        s = jnp.einsum('bqhd,bkhd->bhqk', qblk, k, preferred_element_type=jnp.float32) * scale
        p = jax.nn.softmax(s, axis=-1)
        return jnp.einsum('bhqk,bkhd->bqhd', p.astype(v.dtype), v)

    o = lax.map(one_block, qb)
    return o.transpose(1, 0, 2, 3, 4).reshape(B, S, H * V_HEAD)


def short_conv(u, w):
    S = u.shape[1]
    pad = CONV_K // 2
    up = jnp.pad(u, ((0, 0), (pad, pad), (0, 0)))
    y = up[:, 0:S] * w[0]
    for j in range(1, CONV_K):
        y = y + up[:, j:j + S] * w[j]
    return y


def cross_attention(q, k, v):
    B, S = q.shape[0], q.shape[1]
    s = jnp.einsum('bqhd,bmhd->bhqm', q, k, preferred_element_type=jnp.float32) * (XA_HEAD ** -0.5)
    p = jax.nn.softmax(s, axis=-1)
    o = jnp.einsum('bhqm,bmhd->bqhd', p.astype(v.dtype), v)
    return o.reshape(B, S, XA_HEADS * XA_HEAD)


def trunk(x, mem, ffn1_norm, ffn1_w_gu, ffn1_w_down, mix_norm, w_in, q_lora_norm, w_uq,
          kv_lora_norm, w_uk, w_uv, mla_q_norm, mla_k_norm, w_o_mla, conv_w, w_o_conv,
          mem_norm, w_mem_kv, xa_q_norm, xa_k_norm, w_o_mem, w_out, ffn2_norm, ffn2_w_gu, ffn2_w_down):
    B, S, _ = x.shape
    pos = jnp.arange(S, dtype=jnp.int32)
    splits = _split_points()
    for l in range(DEPTH):
        x = x + 0.5 * swiglu(rmsnorm(x, ffn1_norm[l]), ffn1_w_gu[l], ffn1_w_down[l])

        h = rmsnorm(x, mix_norm[l])
        c_q, c_kv, k_r, cb, cc, cx, xq, glog = jnp.split(h @ w_in[l], splits, axis=-1)

        q = (rmsnorm(c_q, q_lora_norm[l]) @ w_uq[l]).reshape(B, S, MLA_HEADS, QK_HEAD)
        c_kv = rmsnorm(c_kv, kv_lora_norm[l])
        k_nope = (c_kv @ w_uk[l]).reshape(B, S, MLA_HEADS, QK_NOPE)
        v = (c_kv @ w_uv[l]).reshape(B, S, MLA_HEADS, V_HEAD)
        k = jnp.concatenate([k_nope, jnp.broadcast_to(k_r[:, :, None, :], (B, S, MLA_HEADS, QK_ROPE))], axis=-1)
        q = rmsnorm(q, mla_q_norm[l])
        k = rmsnorm(k, mla_k_norm[l])
        q = jnp.concatenate([q[..., :QK_NOPE], rope(q[..., QK_NOPE:], pos)], axis=-1)
        k = jnp.concatenate([k[..., :QK_NOPE], rope(k[..., QK_NOPE:], pos)], axis=-1)
        y_mla = mla_attention(q, k, v) @ w_o_mla[l]

        y_conv = (cb * short_conv(cc * cx, conv_w[l])) @ w_o_conv[l]

        m = rmsnorm(mem, mem_norm[l])
        mk, mv = jnp.split(m @ w_mem_kv[l], 2, axis=-1)
        Bm, M = mem.shape[0], mem.shape[1]
        mk = rmsnorm(mk.reshape(Bm, M, XA_HEADS, XA_HEAD), xa_k_norm[l])
        mv = mv.reshape(Bm, M, XA_HEADS, XA_HEAD)
        xq = rmsnorm(xq.reshape(B, S, XA_HEADS, XA_HEAD), xa_q_norm[l])
        y_mem = cross_attention(xq, mk, mv) @ w_o_mem[l]

        gates = jax.nn.sigmoid(glog.reshape(B, S, N_BRANCH, D_MODEL))
        merged = gates[:, :, 0] * y_mla + gates[:, :, 1] * y_conv + gates[:, :, 2] * y_mem
        x = x + merged @ w_out[l]

        x = x + 0.5 * swiglu(rmsnorm(x, ffn2_norm[l]), ffn2_w_gu[l], ffn2_w_down[l])
    return x


def setup_inputs(seed: int = 0) -> dict:
    key = jax.random.key(seed)
    ks = jax.random.split(key, 32)

    def dense(k, shape, fan_in):
        return jax.random.normal(k, shape, jnp.float32) * (fan_in ** -0.5)

    def gain(k, n):
        return 1.0 + 0.02 * jax.random.normal(k, (DEPTH, n), jnp.float32)

    L = DEPTH
    return {
        "x_prompt": jax.random.normal(ks[0], (BATCH, SEQ, D_MODEL), jnp.float32),
        "x_sample": jax.random.normal(ks[1], (DEC_BATCH, DEC_SEQ, D_MODEL), jnp.float32),
        "mem_prompt": jax.random.normal(ks[2], (BATCH, N_MEM, D_MODEL), jnp.float32),
        "mem_sample": jax.random.normal(ks[3], (DEC_BATCH, N_MEM, D_MODEL), jnp.float32),
        "ffn1_norm": gain(ks[4], D_MODEL),
        "ffn1_w_gu": dense(ks[5], (L, D_MODEL, 2 * D_FF), D_MODEL),
        "ffn1_w_down": dense(ks[6], (L, D_FF, D_MODEL), D_FF),
        "mix_norm": gain(ks[7], D_MODEL),
        "w_in": dense(ks[8], (L, D_MODEL, D_IN), D_MODEL),
        "q_lora_norm": gain(ks[9], Q_LORA),
        "w_uq": dense(ks[10], (L, Q_LORA, MLA_HEADS * QK_HEAD), Q_LORA),
        "kv_lora_norm": gain(ks[11], KV_LORA),
        "w_uk": dense(ks[12], (L, KV_LORA, MLA_HEADS * QK_NOPE), KV_LORA),
        "w_uv": dense(ks[13], (L, KV_LORA, MLA_HEADS * V_HEAD), KV_LORA),
        "mla_q_norm": gain(ks[14], QK_HEAD),
        "mla_k_norm": gain(ks[15], QK_HEAD),
        "w_o_mla": dense(ks[16], (L, MLA_HEADS * V_HEAD, D_MODEL), MLA_HEADS * V_HEAD),
        "conv_w": dense(ks[17], (L, CONV_K, CONV_WIDTH), CONV_K),
        "w_o_conv": dense(ks[18], (L, CONV_WIDTH, D_MODEL), CONV_WIDTH),
        "mem_norm": gain(ks[19], D_MODEL),
        "w_mem_kv": dense(ks[20], (L, D_MODEL, 2 * XA_HEADS * XA_HEAD), D_MODEL),
        "xa_q_norm": gain(ks[21], XA_HEAD),
        "xa_k_norm": gain(ks[22], XA_HEAD),
        "w_o_mem": dense(ks[23], (L, XA_HEADS * XA_HEAD, D_MODEL), XA_HEADS * XA_HEAD),
        "w_out": dense(ks[24], (L, D_MODEL, D_MODEL), D_MODEL),
        "ffn2_norm": gain(ks[25], D_MODEL),
        "ffn2_w_gu": dense(ks[26], (L, D_MODEL, 2 * D_FF), D_MODEL),
        "ffn2_w_down": dense(ks[27], (L, D_FF, D_MODEL), D_FF),
    }


def reference(x_prompt, x_sample, mem_prompt, mem_sample, ffn1_norm, ffn1_w_gu, ffn1_w_down,
              mix_norm, w_in, q_lora_norm, w_uq, kv_lora_norm, w_uk, w_uv, mla_q_norm, mla_k_norm,
              w_o_mla, conv_w, w_o_conv, mem_norm, w_mem_kv, xa_q_norm, xa_k_norm, w_o_mem, w_out,
              ffn2_norm, ffn2_w_gu, ffn2_w_down):
    y_prompt = trunk(x_prompt, mem_prompt, ffn1_norm, ffn1_w_gu, ffn1_w_down, mix_norm, w_in,
                     q_lora_norm, w_uq, kv_lora_norm, w_uk, w_uv, mla_q_norm, mla_k_norm, w_o_mla,
                     conv_w, w_o_conv, mem_norm, w_mem_kv, xa_q_norm, xa_k_norm, w_o_mem, w_out,
                     ffn2_norm, ffn2_w_gu, ffn2_w_down)
    y_sample = trunk(x_sample, mem_sample, ffn1_norm, ffn1_w_gu, ffn1_w_down, mix_norm, w_in,
                     q_lora_norm, w_uq, kv_lora_norm, w_uk, w_uv, mla_q_norm, mla_k_norm, w_o_mla,
                     conv_w, w_o_conv, mem_norm, w_mem_kv, xa_q_norm, xa_k_norm, w_o_mem, w_out,
                     ffn2_norm, ffn2_w_gu, ffn2_w_down)
    return (y_prompt, y_sample)
```

```cpp
#include <hip/hip_runtime.h>
#include <hip/hip_cooperative_groups.h>
#include <cstdio>
#include <cstdint>
namespace cg = cooperative_groups;

#define DEVI __device__ __forceinline__
typedef unsigned short bf16_t;
typedef short bf16x8 __attribute__((ext_vector_type(8)));
typedef float f32x4 __attribute__((ext_vector_type(4)));
typedef float f32x16 __attribute__((ext_vector_type(16)));
typedef __bf16 bf16x2n __attribute__((ext_vector_type(2)));
typedef float f32x2n __attribute__((ext_vector_type(2)));

constexpr float EPS = 1e-6f;
constexpr int NTOK = 32768;
constexpr float QSCALE_MLA = 0.10206207261596575f * 1.4426950408889634f;
constexpr float QSCALE_XA = 0.08838834764831845f * 1.4426950408889634f;


constexpr size_t SZ_W_FFNGU = (size_t)5632 * 1024 * 2, SZ_W_FFNDN = (size_t)1024 * 2816 * 2;
constexpr size_t D1_OFF = (size_t)NTOK * 1024 * 2;
constexpr size_t D1_W2GU = D1_OFF, D1_WOUT = D1_W2GU + SZ_W_FFNGU, D1_RS2 = D1_WOUT + (size_t)1024 * 1024 * 2;
constexpr size_t OFF_W1GU = 0;
constexpr size_t OFF_W1DN = OFF_W1GU + SZ_W_FFNGU;
constexpr size_t OFF_W2DN = 0;
constexpr size_t OFF_W_IN1 = OFF_W1DN + SZ_W_FFNDN;
constexpr size_t OFF_W_IN2 = OFF_W_IN1 + (size_t)1280 * 1024 * 2;
constexpr size_t OFF_W_GATE = OFF_W_IN2 + (size_t)1536 * 1024 * 2;
constexpr size_t OFF_W_UQ = OFF_W_GATE + (size_t)3072 * 1024 * 2;
constexpr size_t OFF_W_UK = OFF_W_UQ + (size_t)1024 * 384 * 2;
constexpr size_t OFF_W_UV = OFF_W_UK + (size_t)512 * 288 * 2;
constexpr size_t OFF_W_OMLA = OFF_W_UV + (size_t)512 * 288 * 2;
constexpr size_t OFF_W_OCONV = OFF_W_OMLA + (size_t)1024 * 512 * 2;
constexpr size_t OFF_W_OMEM = OFF_W_OCONV + (size_t)1024 * 512 * 2;
constexpr size_t OFF_W_MEMK = OFF_W_OMEM + (size_t)1024 * 512 * 2;
constexpr size_t OFF_W_MEMV = OFF_W_MEMK + (size_t)512 * 1024 * 2;
constexpr size_t OFF_MK = OFF_W_MEMV + (size_t)512 * 1024 * 2;
constexpr size_t OFF_MVT = OFF_MK + (size_t)1536 * 512 * 2;
constexpr size_t OFF_ROPE = OFF_MVT + (size_t)1536 * 512 * 2;
constexpr size_t OFF_RSQ = OFF_ROPE + (size_t)8192 * 16 * 2 * 4;
constexpr size_t OFF_RSKV = OFF_RSQ + (size_t)NTOK * 4;
constexpr size_t OFF_RS1 = OFF_RSKV + (size_t)NTOK * 4;
constexpr size_t OFF_RS0 = OFF_RS1 + (size_t)NTOK * 4;
constexpr size_t OFF_MN = OFF_RS0 + (size_t)NTOK * 4;
constexpr size_t OFF_ACT = OFF_MN + (size_t)1536 * 1024 * 2;
constexpr size_t OFF_XQ = OFF_ACT;
constexpr size_t OFF_CQ = OFF_XQ + (size_t)NTOK * 512 * 2;
constexpr size_t OFF_CKV = OFF_CQ + (size_t)NTOK * 384 * 2;
constexpr size_t OFF_Q = OFF_CKV + (size_t)NTOK * 288 * 2;
constexpr size_t OFF_K = OFF_Q + (size_t)NTOK * 768 * 2;
constexpr size_t OFF_VT = OFF_K + (size_t)NTOK * 768 * 2;
constexpr size_t WS_NEEDED = OFF_VT + (size_t)NTOK * 512 * 2;
constexpr size_t WS_SIZE = (size_t)256 * 1024 * 1024;
constexpr size_t OFF_HID = OFF_ACT;
constexpr size_t OFF_AO = OFF_CQ;
constexpr size_t OFF_CB = OFF_Q;
constexpr size_t OFF_U = OFF_CB + (size_t)NTOK * 512 * 2;
constexpr size_t OFF_MERGED = OFF_U + (size_t)NTOK * 512 * 2;
constexpr size_t OFF_X2B = OFF_W2DN + SZ_W_FFNDN;
constexpr size_t OFF_BAR = WS_SIZE - 16384;
constexpr size_t OFF_HID2 = OFF_BAR - (size_t)NTOK * 2816 * 2;
static_assert(OFF_HID + (size_t)NTOK * 2816 * 2 <= WS_SIZE, "hid");
static_assert(OFF_AO + (size_t)NTOK * 512 * 2 <= OFF_Q, "ao");
static_assert(OFF_MERGED + (size_t)NTOK * 1024 * 2 <= WS_NEEDED, "merged");
static_assert(WS_NEEDED <= OFF_BAR && OFF_HID + (size_t)NTOK * 2816 * 2 <= OFF_BAR, "ws");
static_assert(OFF_X2B + (size_t)NTOK * 1024 * 2 <= OFF_HID2, "x2b");
static_assert(OFF_X2B + (size_t)NTOK * 1024 * 2 <= OFF_MERGED, "x2b/merged");
constexpr size_t D1_STILE = D1_RS2 + (size_t)NTOK * 4;
static_assert(D1_STILE + (size_t)256 * 131072 <= 2 * D1_OFF, "d1");

constexpr int TILE_BYTES = 128 * 144;
constexpr int SM_A = 0, SM_B = 2 * TILE_BYTES, SM_RSS = 4 * TILE_BYTES, SM_XCH = SM_RSS + 512, SM_TOTAL = SM_XCH + 1024;

struct Params {
    const float *xp, *xs, *memp, *mems;
    const float *ffn1_norm, *ffn1_gu, *ffn1_down, *mix_norm, *w_in, *q_lora_norm, *w_uq, *kv_lora_norm, *w_uk, *w_uv;
    const float *mla_q_norm, *mla_k_norm, *w_o_mla, *conv_w, *w_o_conv, *mem_norm, *w_mem_kv, *xa_q_norm, *xa_k_norm;
    const float *w_o_mem, *w_out, *ffn2_norm, *ffn2_gu, *ffn2_down;
    float* out;
    unsigned char* ws;
};

DEVI unsigned pk2(float lo, float hi) { f32x2n v = {lo, hi}; bf16x2n b = __builtin_convertvector(v, bf16x2n); return __builtin_bit_cast(unsigned, b); }
DEVI float bflo(unsigned w) { return __uint_as_float(w << 16); }
DEVI float bfhi(unsigned w) { return __uint_as_float(w & 0xffff0000u); }
DEVI void st_bf4(bf16_t* p, f32x4 v) { uint2 w; w.x = pk2(v[0], v[1]); w.y = pk2(v[2], v[3]); *(uint2*)p = w; }
DEVI f32x4 ld_bf4(const bf16_t* p) { uint2 w = *(const uint2*)p; f32x4 r = {bflo(w.x), bfhi(w.x), bflo(w.y), bfhi(w.y)}; return r; }
DEVI f32x4 ld_f4(const float* p) { float4 t = *(const float4*)p; f32x4 r = {t.x, t.y, t.z, t.w}; return r; }
DEVI float dot4(f32x4 v) { return v[0] * v[0] + v[1] * v[1] + v[2] * v[2] + v[3] * v[3]; }
DEVI float sigm(float x) { return __builtin_amdgcn_rcpf(1.f + __expf(-x)); }
DEVI int tok_pos(int tok) { return tok < 16384 ? (tok & 8191) : (tok & 4095); }
DEVI float red4q(float s) { s += __shfl_xor(s, 16); s += __shfl_xor(s, 32); return s; }

template <bool AF32>
DEVI void gemm_tile(f32x4 (&acc)[4][4], const void* Aptr, int lda, const bf16_t* Bptr, int ldb, int nk, unsigned char* smem) {
    int tid_ = threadIdx.x & 255; asm volatile("" : "+v"(tid_)); const int tid = tid_, lane = tid & 63, wid = tid >> 6, wr = wid >> 1, wc = wid & 1, fr = lane & 15, fq = lane >> 4;
    float4 af[8]; uint4 ab[4]; uint4 bb[4]; float ss[8];
#pragma unroll
    for (int i = 0; i < 8; ++i) ss[i] = 0.f;
    const float* Af = (const float*)Aptr + (size_t)(tid >> 4) * lda + (tid & 15) * 4;
    const bf16_t* Ab = (const bf16_t*)Aptr + (size_t)(tid >> 3) * lda + (tid & 7) * 8;
    const bf16_t* Bb = Bptr + (size_t)(tid >> 3) * ldb + (tid & 7) * 8;
    const int awf = (tid >> 4) * 144 + (tid & 15) * 8;
    const int awb = (tid >> 3) * 144 + (tid & 7) * 16;
    const int aro = (wr * 64 + fr) * 144 + fq * 16;
    const int bro = (wc * 64 + fr) * 144 + fq * 16;
#define GT_LOAD(kt) do { \
        if (AF32) { _Pragma("unroll") for (int i = 0; i < 8; ++i) af[i] = *(const float4*)(Af + (size_t)(16 * i) * lda + (kt) * 64); } \
        else      { _Pragma("unroll") for (int i = 0; i < 4; ++i) ab[i] = *(const uint4*)(Ab + (size_t)(32 * i) * lda + (kt) * 64); } \
        _Pragma("unroll") for (int i = 0; i < 4; ++i) bb[i] = *(const uint4*)(Bb + (size_t)(32 * i) * ldb + (kt) * 64); } while (0)
#define GT_STORE(buf) do { \
        unsigned char* As_ = smem + SM_A + (buf) * TILE_BYTES; unsigned char* Bs_ = smem + SM_B + (buf) * TILE_BYTES; \
        if (AF32) { _Pragma("unroll") for (int i = 0; i < 8; ++i) { float4 v = af[i]; ss[i] += v.x * v.x + v.y * v.y + v.z * v.z + v.w * v.w; \
                        uint2 w; w.x = pk2(v.x, v.y); w.y = pk2(v.z, v.w); *(uint2*)(As_ + awf + i * 16 * 144) = w; } } \
        else      { _Pragma("unroll") for (int i = 0; i < 4; ++i) *(uint4*)(As_ + awb + i * 32 * 144) = ab[i]; } \
        _Pragma("unroll") for (int i = 0; i < 4; ++i) *(uint4*)(Bs_ + awb + i * 32 * 144) = bb[i]; } while (0)
    GT_LOAD(0);
    GT_STORE(0);
    __syncthreads();
    for (int kt = 0; kt < nk; ++kt) {
        const bool more = kt + 1 < nk;
        if (more) GT_LOAD(kt + 1);
        const unsigned char* As = smem + SM_A + (kt & 1) * TILE_BYTES;
        const unsigned char* Bs = smem + SM_B + (kt & 1) * TILE_BYTES;
#pragma unroll
        for (int ks = 0; ks < 2; ++ks) {
            bf16x8 a[4], b[4];
#pragma unroll
            for (int m = 0; m < 4; ++m) a[m] = *(const bf16x8*)(As + aro + m * 16 * 144 + ks * 64);
#pragma unroll
            for (int n = 0; n < 4; ++n) b[n] = *(const bf16x8*)(Bs + bro + n * 16 * 144 + ks * 64);
#pragma unroll
            for (int m = 0; m < 4; ++m)
#pragma unroll
                for (int n = 0; n < 4; ++n) acc[m][n] = __builtin_amdgcn_mfma_f32_16x16x32_bf16(b[n], a[m], acc[m][n], 0, 0, 0);
        }
        if (more) GT_STORE((kt + 1) & 1);
        __syncthreads();
    }
    if (AF32) {
        float* rowss = (float*)(smem + SM_RSS);
#pragma unroll
        for (int i = 0; i < 8; ++i) {
            float s = ss[i];
            s += __shfl_xor(s, 1); s += __shfl_xor(s, 2); s += __shfl_xor(s, 4); s += __shfl_xor(s, 8);
            if ((tid & 15) == 0) rowss[(tid >> 4) + 16 * i] = s;
        }
        __syncthreads();
    }
#undef GT_LOAD
#undef GT_STORE
}
DEVI void zero_acc(f32x4 (&acc)[4][4]) {
#pragma unroll
    for (int m = 0; m < 4; ++m)
#pragma unroll
        for (int n = 0; n < 4; ++n) acc[m][n] = (f32x4){0.f, 0.f, 0.f, 0.f};
}
DEVI void tile_row_ss(const f32x4 (&acc)[4][4], float (&tot)[4], unsigned char* smem, int wr, int wc, int fr, int fq) {
    float* xch = (float*)(smem + SM_XCH);
#pragma unroll
    for (int m = 0; m < 4; ++m) {
        float s = 0.f;
#pragma unroll
        for (int n = 0; n < 4; ++n) s += dot4(acc[m][n]);
        s = red4q(s);
        if (fq == 0) xch[wc * 128 + wr * 64 + m * 16 + fr] = s;
    }
    __syncthreads();
#pragma unroll
    for (int m = 0; m < 4; ++m) { const int r = wr * 64 + m * 16 + fr; tot[m] = xch[r] + xch[128 + r]; }
}


enum { KD_ID = 0, KD_GU, KD_IN1, KD_IN2, KD_UK };
struct WSpec { const float* src; const float* gain; bf16_t* dst; int src_ld, K, Np, kind, coff, dld; };
DEVI int map_col(int kind, int coff, int np) {
    const int c2 = np & 255, pr = (c2 >> 7) * 64 + ((c2 >> 5) & 3) * 16 + (c2 & 15), n = (c2 >> 4) & 1;
    switch (kind) {
        case KD_GU: return n * 2816 + (np >> 8) * 128 + pr;
        case KD_IN1: return np < 672 ? np : (np < 768 ? -1 : 2208 + (np - 768));
        case KD_IN2: return np < 512 ? 672 + np : 1184 + n * 512 + ((np >> 8) - 2) * 128 + pr;
        case KD_UK: return ((np >> 8) * 4 + ((c2 >> 5) & 3)) * 64 + (c2 >> 7) * 32 + n * 16 + (c2 & 15);
        default: return coff + np;
    }
}
DEVI WSpec get_spec(const Params& p, int id) {
    unsigned char* ws = p.ws; unsigned char* d1 = (unsigned char*)p.out; WSpec s;
    switch (id) {
        case 0: s = {p.ffn1_gu, p.ffn1_norm, (bf16_t*)(ws + OFF_W1GU), 5632, 1024, 5632, KD_GU, 0, 1024}; break;
        case 1: s = {p.ffn1_down, nullptr, (bf16_t*)(ws + OFF_W1DN), 1024, 2816, 1024, KD_ID, 0, 2816}; break;
        case 2: s = {p.w_in, p.mix_norm, (bf16_t*)(ws + OFF_W_IN1), 5792, 1024, 1280, KD_IN1, 0, 1024}; break;
        case 3: s = {p.w_in, p.mix_norm, (bf16_t*)(ws + OFF_W_IN2), 5792, 1024, 1536, KD_IN2, 0, 1024}; break;
        case 4: s = {p.w_in, p.mix_norm, (bf16_t*)(ws + OFF_W_GATE), 5792, 1024, 3072, KD_ID, 2720, 1024}; break;
        case 5: s = {p.w_uq, p.q_lora_norm, (bf16_t*)(ws + OFF_W_UQ), 768, 384, 768, KD_ID, 0, 384}; break;
        case 6: s = {p.w_uk, p.kv_lora_norm, (bf16_t*)(ws + OFF_W_UK), 512, 256, 512, KD_UK, 0, 288}; break;
        case 7: s = {p.w_uv, p.kv_lora_norm, (bf16_t*)(ws + OFF_W_UV), 512, 256, 512, KD_ID, 0, 288}; break;
        case 8: s = {p.w_o_mla, nullptr, (bf16_t*)(ws + OFF_W_OMLA), 1024, 512, 1024, KD_ID, 0, 512}; break;
        case 9: s = {p.w_o_conv, nullptr, (bf16_t*)(ws + OFF_W_OCONV), 1024, 512, 1024, KD_ID, 0, 512}; break;
        case 10: s = {p.w_o_mem, nullptr, (bf16_t*)(ws + OFF_W_OMEM), 1024, 512, 1024, KD_ID, 0, 512}; break;
        case 11: s = {p.w_mem_kv, p.mem_norm, (bf16_t*)(ws + OFF_W_MEMK), 1024, 1024, 512, KD_ID, 0, 1024}; break;
        case 12: s = {p.w_mem_kv, p.mem_norm, (bf16_t*)(ws + OFF_W_MEMV), 1024, 1024, 512, KD_ID, 512, 1024}; break;
        case 13: s = {p.w_out, nullptr, (bf16_t*)(d1 + D1_WOUT), 1024, 1024, 1024, KD_ID, 0, 1024}; break;
        case 14: s = {p.ffn2_gu, p.ffn2_norm, (bf16_t*)(d1 + D1_W2GU), 5632, 1024, 5632, KD_GU, 0, 1024}; break;
        default: s = {p.ffn2_down, nullptr, (bf16_t*)(ws + OFF_W2DN), 1024, 2816, 1024, KD_ID, 0, 2816}; break;
    }
    return s;
}
DEVI void convert_spec(const WSpec& s, unsigned char* smem, int bid, int G, int tid, int& base) {
    float* T = (float*)smem;
    const int nkt = s.K >> 6, ntiles = (s.Np >> 6) * nkt;
    int first = (bid - base) % G; if (first < 0) first += G;
    base += ntiles;
    for (int t = first; t < ntiles; t += G) {
        const int n0 = (t / nkt) << 6, k0 = (t % nkt) << 6;
        const int c4 = (tid & 15) * 4, col = map_col(s.kind, s.coff, n0 + c4);
#pragma unroll
        for (int i = 0; i < 4; ++i) {
            const int r = (tid >> 4) + 16 * i;
            float4 v = make_float4(0.f, 0.f, 0.f, 0.f);
            if (col >= 0) { v = *(const float4*)(s.src + (size_t)(k0 + r) * s.src_ld + col); if (s.gain) { const float g = s.gain[k0 + r]; v.x *= g; v.y *= g; v.z *= g; v.w *= g; } }
            T[r * 65 + c4] = v.x; T[r * 65 + c4 + 1] = v.y; T[r * 65 + c4 + 2] = v.z; T[r * 65 + c4 + 3] = v.w;
        }
        __syncthreads();
#pragma unroll
        for (int i = 0; i < 2; ++i) {
            const int idx = tid + 256 * i, cn = idx >> 3, kc = idx & 7;
            uint4 w;
            w.x = pk2(T[(kc * 8 + 0) * 65 + cn], T[(kc * 8 + 1) * 65 + cn]);
            w.y = pk2(T[(kc * 8 + 2) * 65 + cn], T[(kc * 8 + 3) * 65 + cn]);
            w.z = pk2(T[(kc * 8 + 4) * 65 + cn], T[(kc * 8 + 5) * 65 + cn]);
            w.w = pk2(T[(kc * 8 + 6) * 65 + cn], T[(kc * 8 + 7) * 65 + cn]);
            *(uint4*)(s.dst + (size_t)(n0 + cn) * s.dld + k0 + kc * 8) = w;
        }
        __syncthreads();
    }
}

template <int DQK, int DV, bool PIPE, bool QNORM>
DEVI void attn_item(const float* qgain, float qscale, const bf16_t* Qp, int q_rs, const bf16_t* Kp, int k_rs, const bf16_t* Vtp, int vt_rs, int nkeys, bf16_t* Op, int o_rs, unsigned char* smem) {
    constexpr int KROW = (DQK + 8) * 2, VROW = 136, KT_BYTES = 64 * KROW, VT_BYTES = DV * VROW, STAGE = KT_BYTES + VT_BYTES;
    constexpr int KCH = DQK / 8, NKC = 64 * KCH / 256, NVC = DV * 8 / 256, NKK = DQK / 16, NDB = DV / 32;
    static_assert(2 * STAGE <= SM_TOTAL, "attn lds");
    int tid_ = threadIdx.x & 255; asm volatile("" : "+v"(tid_)); const int tid = tid_, lane = tid & 63, wid = tid >> 6, ql = lane & 31, half = lane >> 5;
    __syncthreads();
    bf16x8 qf[NKK];
    {
        const bf16_t* qrow = Qp + (size_t)(wid * 32 + ql) * q_rs + half * 8;
#pragma unroll
        for (int kk = 0; kk < NKK; ++kk) qf[kk] = *(const bf16x8*)(qrow + kk * 16);
    }
    if (QNORM) {
        float ss = 0.f;
#pragma unroll
        for (int kk = 0; kk < NKK; ++kk) { const uint4 w = __builtin_bit_cast(uint4, qf[kk]);
            ss += bflo(w.x) * bflo(w.x) + bfhi(w.x) * bfhi(w.x) + bflo(w.y) * bflo(w.y) + bfhi(w.y) * bfhi(w.y) + bflo(w.z) * bflo(w.z) + bfhi(w.z) * bfhi(w.z) + bflo(w.w) * bflo(w.w) + bfhi(w.w) * bfhi(w.w); }
        ss += __shfl_xor(ss, 32);
        const float inv = rsqrtf(ss * (1.f / DQK) + EPS) * qscale;
#pragma unroll
        for (int kk = 0; kk < NKK; ++kk) { const uint4 w = __builtin_bit_cast(uint4, qf[kk]);
            const f32x4 g0 = ld_f4(qgain + kk * 16 + half * 8), g1 = ld_f4(qgain + kk * 16 + half * 8 + 4); uint4 o;
            o.x = pk2(bflo(w.x) * inv * g0[0], bfhi(w.x) * inv * g0[1]); o.y = pk2(bflo(w.y) * inv * g0[2], bfhi(w.y) * inv * g0[3]);
            o.z = pk2(bflo(w.z) * inv * g1[0], bfhi(w.z) * inv * g1[1]); o.w = pk2(bflo(w.w) * inv * g1[2], bfhi(w.w) * inv * g1[3]);
            qf[kk] = __builtin_bit_cast(bf16x8, o); }
    }
    f32x16 accO[NDB];
#pragma unroll
    for (int db = 0; db < NDB; ++db)
#pragma unroll
        for (int r = 0; r < 16; ++r) accO[db][r] = 0.f;
    float m_run = -INFINITY, l_run = 0.f;
    uint4 kreg[NKC], vreg[NVC];
#define AT_LOAD(t) do { const int s0_ = (t) * 64; \
        _Pragma("unroll") for (int i = 0; i < NKC; ++i) { const int c = tid + 256 * i, row = c / KCH, kc = c % KCH; kreg[i] = *(const uint4*)(Kp + (size_t)(s0_ + row) * k_rs + kc * 8); } \
        _Pragma("unroll") for (int i = 0; i < NVC; ++i) { const int c = tid + 256 * i, d = c >> 3, kc = c & 7; vreg[i] = *(const uint4*)(Vtp + (size_t)d * vt_rs + s0_ + kc * 8); } } while (0)
#define AT_STORE(buf) do { unsigned char* Ks_ = smem + (buf) * STAGE; unsigned char* Vs_ = Ks_ + KT_BYTES; \
        _Pragma("unroll") for (int i = 0; i < NKC; ++i) { const int c = tid + 256 * i, row = c / KCH, kc = c % KCH; *(uint4*)(Ks_ + row * KROW + kc * 16) = kreg[i]; } \
        _Pragma("unroll") for (int i = 0; i < NVC; ++i) { const int c = tid + 256 * i, d = c >> 3, kc = c & 7; uint2 lo_, hi_; lo_.x = vreg[i].x; lo_.y = vreg[i].y; hi_.x = vreg[i].z; hi_.y = vreg[i].w; \
            *(uint2*)(Vs_ + d * VROW + kc * 16) = lo_; *(uint2*)(Vs_ + d * VROW + kc * 16 + 8) = hi_; } } while (0)
    const int nt = nkeys >> 6;
    if (PIPE) { AT_LOAD(0); AT_STORE(0); __syncthreads(); }
    for (int t = 0; t < nt; ++t) {
        const bool more = PIPE && (t + 1 < nt);
        if (PIPE) { if (more) AT_LOAD(t + 1); }
        else { AT_LOAD(t); AT_STORE(t & 1); __syncthreads(); }
        const unsigned char* Ks = smem + (t & 1) * STAGE;
        const unsigned char* Vs = Ks + KT_BYTES;
        f32x16 s[2];
#pragma unroll
        for (int kb = 0; kb < 2; ++kb) {
#pragma unroll
            for (int r = 0; r < 16; ++r) s[kb][r] = 0.f;
#pragma unroll
            for (int kk = 0; kk < NKK; ++kk) {
                const bf16x8 kf = *(const bf16x8*)(Ks + (kb * 32 + ql) * KROW + kk * 32 + half * 16);
                s[kb] = __builtin_amdgcn_mfma_f32_32x32x16_bf16(kf, qf[kk], s[kb], 0, 0, 0);
            }
        }
        float mx = s[0][0];
#pragma unroll
        for (int r = 1; r < 16; ++r) mx = fmaxf(mx, s[0][r]);
#pragma unroll
        for (int r = 0; r < 16; ++r) mx = fmaxf(mx, s[1][r]);
        mx = fmaxf(mx, __shfl_xor(mx, 32));
        const float m_new = fmaxf(m_run, mx);
        const float alpha = __builtin_amdgcn_exp2f(m_run - m_new);
        m_run = m_new;
        float psum = 0.f;
#pragma unroll
        for (int kb = 0; kb < 2; ++kb)
#pragma unroll
            for (int r = 0; r < 16; ++r) { const float pv = __builtin_amdgcn_exp2f(s[kb][r] - m_new); s[kb][r] = pv; psum += pv; }
        l_run = l_run * alpha + psum;
#pragma unroll
        for (int db = 0; db < NDB; ++db)
#pragma unroll
            for (int r = 0; r < 16; ++r) accO[db][r] *= alpha;
#pragma unroll
        for (int kb = 0; kb < 2; ++kb)
#pragma unroll
            for (int p2 = 0; p2 < 2; ++p2) {
                uint4 pw;
                pw.x = pk2(s[kb][8 * p2 + 0], s[kb][8 * p2 + 1]); pw.y = pk2(s[kb][8 * p2 + 2], s[kb][8 * p2 + 3]);
                pw.z = pk2(s[kb][8 * p2 + 4], s[kb][8 * p2 + 5]); pw.w = pk2(s[kb][8 * p2 + 6], s[kb][8 * p2 + 7]);
                const bf16x8 pf = __builtin_bit_cast(bf16x8, pw);
#pragma unroll
                for (int db = 0; db < NDB; ++db) {
                    const unsigned char* vp = Vs + (db * 32 + ql) * VROW + (kb * 32 + 16 * p2 + half * 4) * 2;
                    const uint2 vlo = *(const uint2*)vp, vhi = *(const uint2*)(vp + 16);
                    uint4 vw; vw.x = vlo.x; vw.y = vlo.y; vw.z = vhi.x; vw.w = vhi.y;
                    accO[db] = __builtin_amdgcn_mfma_f32_32x32x16_bf16(__builtin_bit_cast(bf16x8, vw), pf, accO[db], 0, 0, 0);
                }
            }
        if (PIPE) { if (more) AT_STORE((t + 1) & 1); __syncthreads(); }
    }
#undef AT_LOAD
#undef AT_STORE
    const float l = l_run + __shfl_xor(l_run, 32);
    const float inv = 1.f / l;
    bf16_t* orow = Op + (size_t)(wid * 32 + ql) * o_rs + half * 4;
#pragma unroll
    for (int db = 0; db < NDB; ++db)
#pragma unroll
        for (int g = 0; g < 4; ++g) {
            f32x4 v = {accO[db][4 * g] * inv, accO[db][4 * g + 1] * inv, accO[db][4 * g + 2] * inv, accO[db][4 * g + 3] * inv};
            st_bf4(orow + db * 32 + 8 * g, v);
        }
}


DEVI void attn_mla_item(const float* gq, const float* ROPEp, int pos0, const bf16_t* Qp, const bf16_t* Kp, const bf16_t* Vtp, int vt_rs, int nkeys, bf16_t* Op, unsigned char* smem, int tx) {
    constexpr int KROW = 208, VROW = 264, KT_BYTES = 128 * KROW, VT_BYTES = 64 * VROW, STAGE = KT_BYTES + VT_BYTES;
    static_assert(2 * STAGE <= 2 * SM_TOTAL, "attn lds");
    const int lane = tx & 63, wid = tx >> 6, ql = lane & 31, half = lane >> 5;
    __syncthreads();
    bf16x8 qf[6];
    {
        const bf16_t* qrow = Qp + (size_t)(wid * 32 + ql) * 768 + half * 8;
#pragma unroll
        for (int kk = 0; kk < 6; ++kk) qf[kk] = *(const bf16x8*)(qrow + kk * 16);
    }
    {
        float ss = 0.f;
#pragma unroll
        for (int kk = 0; kk < 6; ++kk) { const uint4 w = __builtin_bit_cast(uint4, qf[kk]);
            ss += bflo(w.x) * bflo(w.x) + bfhi(w.x) * bfhi(w.x) + bflo(w.y) * bflo(w.y) + bfhi(w.y) * bfhi(w.y) + bflo(w.z) * bflo(w.z) + bfhi(w.z) * bfhi(w.z) + bflo(w.w) * bflo(w.w) + bfhi(w.w) * bfhi(w.w); }
        ss += __shfl_xor(ss, 32);
        const float inv = rsqrtf(ss * (1.f / 96.f) + EPS) * QSCALE_MLA;
#pragma unroll
        for (int kk = 0; kk < 4; ++kk) { const uint4 w = __builtin_bit_cast(uint4, qf[kk]);
            const f32x4 g0 = ld_f4(gq + kk * 16 + half * 8), g1 = ld_f4(gq + kk * 16 + half * 8 + 4); uint4 o;
            o.x = pk2(bflo(w.x) * inv * g0[0], bfhi(w.x) * inv * g0[1]); o.y = pk2(bflo(w.y) * inv * g0[2], bfhi(w.y) * inv * g0[3]);
            o.z = pk2(bflo(w.z) * inv * g1[0], bfhi(w.z) * inv * g1[1]); o.w = pk2(bflo(w.w) * inv * g1[2], bfhi(w.w) * inv * g1[3]);
            qf[kk] = __builtin_bit_cast(bf16x8, o); }
        const uint4 wa = __builtin_bit_cast(uint4, qf[4]), wb = __builtin_bit_cast(uint4, qf[5]);
        const float* rp = ROPEp + ((size_t)(pos0 + wid * 32 + ql) * 16 + half * 8) * 2;
        const float* ga = gq + 64 + half * 8; const float* gb = gq + 80 + half * 8;
        float x1[8] = {bflo(wa.x), bfhi(wa.x), bflo(wa.y), bfhi(wa.y), bflo(wa.z), bfhi(wa.z), bflo(wa.w), bfhi(wa.w)};
        float x2[8] = {bflo(wb.x), bfhi(wb.x), bflo(wb.y), bfhi(wb.y), bflo(wb.z), bfhi(wb.z), bflo(wb.w), bfhi(wb.w)};
        float r1[8], r2[8];
#pragma unroll
        for (int q4 = 0; q4 < 2; ++q4) {
            const f32x4 g1v = ld_f4(ga + q4 * 4), g2v = ld_f4(gb + q4 * 4), csA = ld_f4(rp + q4 * 8), csB = ld_f4(rp + q4 * 8 + 4);
            const float co[4] = {csA[0], csA[2], csB[0], csB[2]}, si[4] = {csA[1], csA[3], csB[1], csB[3]};
#pragma unroll
            for (int j = 0; j < 4; ++j) { const float a = x1[q4 * 4 + j] * inv * g1v[j], b = x2[q4 * 4 + j] * inv * g2v[j]; r1[q4 * 4 + j] = a * co[j] - b * si[j]; r2[q4 * 4 + j] = b * co[j] + a * si[j]; }
        }
        uint4 oa, ob;
        oa.x = pk2(r1[0], r1[1]); oa.y = pk2(r1[2], r1[3]); oa.z = pk2(r1[4], r1[5]); oa.w = pk2(r1[6], r1[7]);
        ob.x = pk2(r2[0], r2[1]); ob.y = pk2(r2[2], r2[3]); ob.z = pk2(r2[4], r2[5]); ob.w = pk2(r2[6], r2[7]);
        qf[4] = __builtin_bit_cast(bf16x8, oa); qf[5] = __builtin_bit_cast(bf16x8, ob);
    }
    f32x16 accO[2];
#pragma unroll
    for (int db = 0; db < 2; ++db)
#pragma unroll
        for (int r = 0; r < 16; ++r) accO[db][r] = 0.f;
    float m_run = -INFINITY, l_run = 0.f;
    uint4 kreg[3], vreg[2];
#define AM_LOAD(t) do { const int s0_ = (t) * 128; \
        _Pragma("unroll") for (int i = 0; i < 3; ++i) { const int c = tx + 512 * i, row = c / 12, kc = c % 12; kreg[i] = *(const uint4*)(Kp + (size_t)(s0_ + row) * 768 + kc * 8); } \
        _Pragma("unroll") for (int i = 0; i < 2; ++i) { const int c = tx + 512 * i, d = c >> 4, kc = c & 15; vreg[i] = *(const uint4*)(Vtp + (size_t)d * vt_rs + s0_ + kc * 8); } } while (0)
#define AM_STORE(buf) do { unsigned char* Ks_ = smem + (buf) * STAGE; unsigned char* Vs_ = Ks_ + KT_BYTES; \
        _Pragma("unroll") for (int i = 0; i < 3; ++i) { const int c = tx + 512 * i, row = c / 12, kc = c % 12; *(uint4*)(Ks_ + row * KROW + kc * 16) = kreg[i]; } \
        _Pragma("unroll") for (int i = 0; i < 2; ++i) { const int c = tx + 512 * i, d = c >> 4, kc = c & 15; uint2 lo_, hi_; lo_.x = vreg[i].x; lo_.y = vreg[i].y; hi_.x = vreg[i].z; hi_.y = vreg[i].w; \
            *(uint2*)(Vs_ + d * VROW + kc * 16) = lo_; *(uint2*)(Vs_ + d * VROW + kc * 16 + 8) = hi_; } } while (0)
    const int nt = nkeys >> 7;
    AM_LOAD(0); AM_STORE(0); __syncthreads();
    for (int t = 0; t < nt; ++t) {
        const bool more = t + 1 < nt;
        if (more) AM_LOAD(t + 1);
        const unsigned char* Ks = smem + (t & 1) * STAGE;
        const unsigned char* Vs = Ks + KT_BYTES;
        f32x16 s[4];
#pragma unroll
        for (int kb = 0; kb < 4; ++kb)
#pragma unroll
            for (int r = 0; r < 16; ++r) s[kb][r] = 0.f;
#pragma unroll
        for (int kk = 0; kk < 6; ++kk)
#pragma unroll
            for (int kb = 0; kb < 4; ++kb) {
                const bf16x8 kf = *(const bf16x8*)(Ks + (kb * 32 + ql) * KROW + kk * 32 + half * 16);
                s[kb] = __builtin_amdgcn_mfma_f32_32x32x16_bf16(kf, qf[kk], s[kb], 0, 0, 0);
            }
        float mx = -INFINITY;
#pragma unroll
        for (int kb = 0; kb < 4; ++kb)
#pragma unroll
            for (int r = 0; r < 16; r += 2) mx = fmaxf(fmaxf(mx, s[kb][r]), s[kb][r + 1]);
        mx = fmaxf(mx, __shfl_xor(mx, 32));
        const float m_new = fmaxf(m_run, mx);
        if (__any(m_new > m_run)) {
            const float alpha = __builtin_amdgcn_exp2f(m_run - m_new);
            l_run *= alpha;
#pragma unroll
            for (int db = 0; db < 2; ++db)
#pragma unroll
                for (int r = 0; r < 16; ++r) accO[db][r] *= alpha;
        }
        m_run = m_new;
        float psum = 0.f;
#pragma unroll
        for (int kb = 0; kb < 4; ++kb)
#pragma unroll
            for (int r = 0; r < 16; ++r) { const float pv = __builtin_amdgcn_exp2f(s[kb][r] - m_new); s[kb][r] = pv; psum += pv; }
        l_run += psum;
#pragma unroll
        for (int kb = 0; kb < 4; ++kb)
#pragma unroll
            for (int p2 = 0; p2 < 2; ++p2) {
                uint4 pw;
                pw.x = pk2(s[kb][8 * p2 + 0], s[kb][8 * p2 + 1]); pw.y = pk2(s[kb][8 * p2 + 2], s[kb][8 * p2 + 3]);
                pw.z = pk2(s[kb][8 * p2 + 4], s[kb][8 * p2 + 5]); pw.w = pk2(s[kb][8 * p2 + 6], s[kb][8 * p2 + 7]);
                const bf16x8 pf = __builtin_bit_cast(bf16x8, pw);
#pragma unroll
                for (int db = 0; db < 2; ++db) {
                    const unsigned char* vp = Vs + (db * 32 + ql) * VROW + (kb * 32 + 16 * p2 + half * 4) * 2;
                    const uint2 vlo = *(const uint2*)vp, vhi = *(const uint2*)(vp + 16);
                    uint4 vw; vw.x = vlo.x; vw.y = vlo.y; vw.z = vhi.x; vw.w = vhi.y;
                    accO[db] = __builtin_amdgcn_mfma_f32_32x32x16_bf16(__builtin_bit_cast(bf16x8, vw), pf, accO[db], 0, 0, 0);
                }
            }
        if (more) AM_STORE((t + 1) & 1);
        __syncthreads();
    }
#undef AM_LOAD
#undef AM_STORE
    const float l = l_run + __shfl_xor(l_run, 32);
    const float inv = 1.f / l;
    bf16_t* orow = Op + (size_t)(wid * 32 + ql) * 512 + half * 4;
#pragma unroll
    for (int db = 0; db < 2; ++db)
#pragma unroll
        for (int g = 0; g < 4; ++g) {
            f32x4 v = {accO[db][4 * g] * inv, accO[db][4 * g + 1] * inv, accO[db][4 * g + 2] * inv, accO[db][4 * g + 3] * inv};
            st_bf4(orow + db * 32 + 8 * g, v);
        }
}

namespace pg8 {
#define PG8_LAS __attribute__((address_space(3)))
typedef unsigned short bf16_t;
typedef short bf16x8 __attribute__((ext_vector_type(8)));
typedef float f32x4 __attribute__((ext_vector_type(4)));
typedef unsigned u32x4 __attribute__((ext_vector_type(4)));
constexpr int BM = 256, BK = 64, HALF = 128, HTB = HALF * BK * 2  , STAGE_BYTES = 8 * HTB, NXCD = 8, WGM = 8;

__host__ __device__ __forceinline__ int lds_byte(int r, int c) { const int st = (r >> 4) * 2 + (c >> 5), rr = r & 15, cc = c & 31, ob = rr * 64 + cc * 2; return st * 1024 + (ob ^ (((ob >> 9) & 1) << 5)); }
__host__ __device__ __forceinline__ void stage_rc(int b, int& R, int& C) { const int st = b / 1024, sb = b % 1024, swz = sb ^ (((sb >> 9) & 1) << 5); R = (st >> 1) * 16 + swz / 64; C = (st & 1) * 32 + (swz % 64) / 2; }
__host__ __device__ __forceinline__ int perm32(int rho) { const int n = rho >> 4, i = rho & 15; return 8 * (i >> 2) + 4 * n + (i & 3); }

struct Unit { int pm, pn; };
struct Gemm { const bf16_t* A; const bf16_t* Bt; int M, N, K, lda, ldb; size_t kstepA, kstepB; };

struct StaticOrder {
    int nM, nN, nwg, G, c;
    __host__ __device__ void init(int M, int N, int G_, int c_) { nM = M / BM; nN = N / BM; nwg = nM * nN; G = G_; c = c_; }
    __host__ __device__ bool next(int i, Unit& u) const {
        const long L = (long)i * G + c; if (L >= nwg) return false;
        int wgid = (int)L; { const int q = nwg / NXCD, r = nwg % NXCD, xcd = wgid % NXCD, off = wgid / NXCD; wgid = (xcd < r ? xcd * (q + 1) : r * (q + 1) + (xcd - r) * q) + off; }
        const int nig = WGM * nN, gid = wgid / nig, fm = gid * WGM, gsz = (nM - fm) < WGM ? (nM - fm) : WGM;
        u.pm = fm + ((wgid % nig) % gsz); u.pn = (wgid % nig) / gsz; return true;
    }
    __device__ __forceinline__ void a_ready(const Unit&) const {}
    __device__ __forceinline__ void done(const Unit&) const {}
};


DEVI float rs_inv(const float* rs, int row) { return rsqrtf(rs[row] * (1.f / 1024.f) + EPS); }
struct EpiGU {
    static constexpr bool PERM = false, AFTER_DRAIN = false;
    bf16_t* HID; const float* rs;
    __device__ __forceinline__ void operator()(const f32x4 (&acc)[2][2][4][2], const Unit& u, int wr, int wc, int fr, int fq) const {
        asm volatile("" : "+v"(fr), "+v"(fq));
#pragma unroll
        for (int ai = 0; ai < 2; ++ai)
#pragma unroll
            for (int m = 0; m < 4; ++m) {
                const int row = u.pm * BM + ai * HALF + wr * 64 + m * 16 + fr; const float ri = rs_inv(rs, row);
                bf16_t* rowp = HID + ((size_t)(u.pn * 2) * NTOK + (size_t)(u.pm * 2 + ai) * 128) * 64 + ((wr * 4 + m) * 4 + wc) * 256 + fr * 16 + fq * 4;
#pragma unroll
                for (int bj = 0; bj < 2; ++bj) {
                    const f32x4 g = acc[ai][bj][m][0] * ri, up = acc[ai][bj][m][1] * ri; f32x4 h;
#pragma unroll
                    for (int j = 0; j < 4; ++j) h[j] = g[j] * __builtin_amdgcn_rcpf(1.f + __expf(-g[j])) * up[j];
                    ::st_bf4(rowp + (size_t)bj * NTOK * 64, h);
                }
            }
    }
};
template <int RES> struct EpiRes {
    static constexpr bool PERM = false, AFTER_DRAIN = false;
    const float* rf0; const float* rf1; const bf16_t* rb; bf16_t* out; float* rs; float scale;
    __device__ __forceinline__ void operator()(const f32x4 (&acc)[2][2][4][2], const Unit& u, int wr, int wc, int fr, int fq) const {
        asm volatile("" : "+v"(fr), "+v"(fq));
#pragma unroll
        for (int ai = 0; ai < 2; ++ai) {
            const int row0 = u.pm * BM + ai * HALF + wr * 64 + fr, col0 = u.pn * BM + wc * 32 + fq * 4;
            f32x4 r[4][2][2];
#pragma unroll
            for (int m = 0; m < 4; ++m) {
                const int row = row0 + m * 16;
                const float* rp = (row < 16384 ? rf0 + (size_t)row * 1024 : rf1 + (size_t)(row - 16384) * 1024) + col0;
#pragma unroll
                for (int bj = 0; bj < 2; ++bj)
#pragma unroll
                    for (int n = 0; n < 2; ++n) r[m][bj][n] = RES == 0 ? ::ld_f4(rp + bj * HALF + n * 16) : ::ld_bf4(rb + (size_t)row * 1024 + col0 + bj * HALF + n * 16);
            }
#pragma unroll
            for (int m = 0; m < 4; ++m) {
                const int row = row0 + m * 16;
                float ss = 0.f;
#pragma unroll
                for (int bj = 0; bj < 2; ++bj)
#pragma unroll
                    for (int n = 0; n < 2; ++n) {
                        const f32x4 o = r[m][bj][n] + acc[ai][bj][m][n] * scale;
                        ss += ::dot4(o);
                        ::st_bf4(out + (size_t)row * 1024 + col0 + bj * HALF + n * 16, o);
                    }
                ss = ::red4q(ss);
                if (fq == 0) atomicAdd(rs + row, ss);
            }
        }
    }
};
struct EpiFinal {
    static constexpr bool PERM = false, AFTER_DRAIN = false;
    const bf16_t* rb; float* out;
    __device__ __forceinline__ void operator()(const f32x4 (&acc)[2][2][4][2], const Unit& u, int wr, int wc, int fr, int fq) const {
        asm volatile("" : "+v"(fr), "+v"(fq));
#pragma unroll
        for (int ai = 0; ai < 2; ++ai)
#pragma unroll
            for (int m = 0; m < 4; ++m) {
                const size_t off = (size_t)(u.pm * BM + ai * HALF + wr * 64 + m * 16 + fr) * 1024 + u.pn * BM + wc * 32 + fq * 4;
#pragma unroll
                for (int bj = 0; bj < 2; ++bj)
#pragma unroll
                    for (int n = 0; n < 2; ++n) { const f32x4 o = ::ld_bf4(rb + off + bj * HALF + n * 16) + acc[ai][bj][m][n] * 0.5f; *(float4*)(out + off + bj * HALF + n * 16) = make_float4(o[0], o[1], o[2], o[3]); }
            }
    }
};

struct EpiQ {
    static constexpr bool PERM = false, AFTER_DRAIN = false;
    const float* RSQ; bf16_t* Q;
    __device__ __forceinline__ void operator()(const f32x4 (&acc)[2][2][4][2], const Unit& u, int wr, int wc, int fr, int fq) const {
        asm volatile("" : "+v"(fr), "+v"(fq));
#pragma unroll
        for (int ai = 0; ai < 2; ++ai)
#pragma unroll
            for (int m = 0; m < 4; ++m) {
                const int row = u.pm * BM + ai * HALF + wr * 64 + m * 16 + fr; const float ri = rsqrtf(RSQ[row] * (1.f / 384.f) + EPS);
                bf16_t* d = Q + (size_t)row * 768 + u.pn * BM + wc * 32 + fq * 4;
#pragma unroll
                for (int bj = 0; bj < 2; ++bj)
#pragma unroll
                    for (int n = 0; n < 2; ++n) ::st_bf4(d + bj * HALF + n * 16, acc[ai][bj][m][n] * ri);
            }
    }
};
struct EpiK {
    static constexpr bool PERM = false, AFTER_DRAIN = false;
    const float* RSKV; const bf16_t* CKV; const float* gk; const float* ROPE; bf16_t* K;
    __device__ __forceinline__ void operator()(const f32x4 (&acc)[2][2][4][2], const Unit& u, int wr, int wc, int fr, int fq) const {
        asm volatile("" : "+v"(fr), "+v"(fq));
        const int h = u.pn * 4 + wc;
#pragma unroll
        for (int ai = 0; ai < 2; ++ai)
#pragma unroll
            for (int m = 0; m < 4; ++m) {
                const int row = u.pm * BM + ai * HALF + wr * 64 + m * 16 + fr; const float ri = rsqrtf(RSKV[row] * (1.f / 256.f) + EPS);
                f32x4 v[2][2]; float s = 0.f;
#pragma unroll
                for (int bj = 0; bj < 2; ++bj)
#pragma unroll
                    for (int n = 0; n < 2; ++n) { v[bj][n] = acc[ai][bj][m][n] * ri; s += ::dot4(v[bj][n]); }
                const f32x4 kr1 = ::ld_bf4(CKV + (size_t)row * 288 + 256 + fq * 4), kr2 = ::ld_bf4(CKV + (size_t)row * 288 + 272 + fq * 4);
                s += ::dot4(kr1) + ::dot4(kr2);
                s = ::red4q(s);
                const float inv = rsqrtf(s * (1.f / 96.f) + EPS);
                bf16_t* dst = K + ((size_t)row * 8 + h) * 96;
#pragma unroll
                for (int bj = 0; bj < 2; ++bj)
#pragma unroll
                    for (int n = 0; n < 2; ++n) { const int c = bj * 32 + n * 16 + fq * 4; ::st_bf4(dst + c, v[bj][n] * inv * ::ld_f4(gk + c)); }
                const int pos = ::tok_pos(row);
                const f32x4 x1 = kr1 * inv * ::ld_f4(gk + 64 + fq * 4), x2 = kr2 * inv * ::ld_f4(gk + 80 + fq * 4);
                const f32x4 cs0 = ::ld_f4(ROPE + ((size_t)pos * 16 + fq * 4) * 2), cs1 = ::ld_f4(ROPE + ((size_t)pos * 16 + fq * 4) * 2 + 4);
                const f32x4 co = {cs0[0], cs0[2], cs1[0], cs1[2]}, si = {cs0[1], cs0[3], cs1[1], cs1[3]};
                ::st_bf4(dst + 64 + fq * 4, x1 * co - x2 * si);
                ::st_bf4(dst + 80 + fq * 4, x2 * co + x1 * si);
            }
    }
};
struct EpiVt {
    static constexpr bool PERM = false, AFTER_DRAIN = false;
    const float* RSKV; bf16_t* VT;
    __device__ __forceinline__ void operator()(const f32x4 (&acc)[2][2][4][2], const Unit& u, int wr, int wc, int fr, int fq) const {
        asm volatile("" : "+v"(fr), "+v"(fq));
#pragma unroll
        for (int bj = 0; bj < 2; ++bj)
#pragma unroll
            for (int n = 0; n < 2; ++n) {
                const int tok0 = u.pn * BM + bj * HALF + wc * 32 + n * 16 + fq * 4;
                f32x4 ric = ::ld_f4(RSKV + tok0);
#pragma unroll
                for (int j = 0; j < 4; ++j) ric[j] = rsqrtf(ric[j] * (1.f / 256.f) + EPS);
#pragma unroll
                for (int ai = 0; ai < 2; ++ai)
#pragma unroll
                    for (int m = 0; m < 4; ++m) {
                        const int hd = u.pm * BM + ai * HALF + wr * 64 + m * 16 + fr, h = hd >> 6, d = hd & 63;
                        size_t off;
                        if (tok0 < 16384) off = ((size_t)((tok0 >> 13) * 8 + h) * 64 + d) * 8192 + (tok0 & 8191);
                        else { const int tt = tok0 - 16384; off = (size_t)8388608 + ((size_t)((tt >> 12) * 8 + h) * 64 + d) * 4096 + (tt & 4095); }
                        ::st_bf4(VT + off, acc[ai][bj][m][n] * ric);
                    }
            }
    }
};
struct EpiIn1 {
    static constexpr bool PERM = false, AFTER_DRAIN = false;
    const float* rs1; bf16_t* CQ; bf16_t* CKV; bf16_t* XQ; float* RSQ; float* RSKV;
    __device__ __forceinline__ void operator()(const f32x4 (&acc)[2][2][4][2], const Unit& u, int wr, int wc, int fr, int fq) const {
        asm volatile("" : "+v"(fr), "+v"(fq));
#pragma unroll
        for (int bj = 0; bj < 2; ++bj) {
            const int cg = u.pn * BM + bj * HALF + wc * 32;
            bf16_t* dst; int ld, c0; float* rs = nullptr;
            if (cg < 384) { dst = CQ; ld = 384; c0 = cg; rs = RSQ; }
            else if (cg < 640) { dst = CKV; ld = 288; c0 = cg - 384; rs = RSKV; }
            else if (cg < 672) { dst = CKV; ld = 288; c0 = 256 + (cg - 640); }
            else if (cg < 768) continue;
            else { dst = XQ; ld = 512; c0 = cg - 768; }
#pragma unroll
            for (int ai = 0; ai < 2; ++ai)
#pragma unroll
                for (int m = 0; m < 4; ++m) {
                    const int row = u.pm * BM + ai * HALF + wr * 64 + m * 16 + fr; const float ri = rs_inv(rs1, row);
                    const f32x4 v0 = acc[ai][bj][m][0] * ri, v1 = acc[ai][bj][m][1] * ri;
                    ::st_bf4(dst + (size_t)row * ld + c0 + fq * 4, v0); ::st_bf4(dst + (size_t)row * ld + c0 + 16 + fq * 4, v1);
                    if (rs) { const float s = ::red4q(::dot4(v0) + ::dot4(v1)); if (fq == 0) atomicAdd(rs + row, s); }
                }
        }
    }
};
struct EpiIn2 {
    static constexpr bool PERM = false, AFTER_DRAIN = false;
    const float* rs1; bf16_t* CB; bf16_t* U;
    __device__ __forceinline__ void operator()(const f32x4 (&acc)[2][2][4][2], const Unit& u, int wr, int wc, int fr, int fq) const {
        asm volatile("" : "+v"(fr), "+v"(fq));
#pragma unroll
        for (int ai = 0; ai < 2; ++ai)
#pragma unroll
            for (int m = 0; m < 4; ++m) {
                const int row = u.pm * BM + ai * HALF + wr * 64 + m * 16 + fr; const float ri = rs_inv(rs1, row);
#pragma unroll
                for (int bj = 0; bj < 2; ++bj) {
                    const f32x4 v0 = acc[ai][bj][m][0] * ri, v1 = acc[ai][bj][m][1] * ri;
                    if (u.pn < 2) { bf16_t* d = CB + (size_t)row * 512 + u.pn * BM + bj * HALF + wc * 32 + fq * 4; ::st_bf4(d, v0); ::st_bf4(d + 16, v1); }
                    else ::st_bf4(U + (size_t)row * 512 + (u.pn - 2) * 128 + bj * 64 + wc * 16 + fq * 4, v0 * v1);
                }
            }
    }
};
template <class Epi, class Sched, bool ALIGN_EPI = false, bool SP2 = false>
__device__ __forceinline__ void gemm_phase(PG8_LAS unsigned char* lds, const Gemm g, const Sched& S, const Epi& E) {
    int tid_ = threadIdx.x; asm volatile("" : "+v"(tid_));
    const int tid = tid_, wid = __builtin_amdgcn_readfirstlane(tid >> 6), lane = tid & 63, wr = wid >> 2, wc = wid & 3, fr = lane & 15, fq = lane >> 4;
    const int K = g.K, nt = K / BK;
    unsigned voffA[2], voffB[2];
#pragma unroll
    for (int i = 0; i < 2; ++i) { int R, C; stage_rc(tid * 16 + i * 8192, R, C); const int Rb = Epi::PERM ? ((R & ~31) + perm32(R & 31)) : R;
        voffA[i] = g.lda ? (unsigned)(R * g.lda + C) * 2u : (unsigned)(((R >> 4) * 4 + (C >> 4)) * 512 + (R & 15) * 32 + ((C >> 3) & 1) * 16);
        voffB[i] = (unsigned)(Rb * g.ldb + C) * 2u; }
    const size_t kstepA = g.kstepA, kstepB = g.kstepB;
    const size_t hstepA = (size_t)HALF * (g.lda ? g.lda : 64) * 2, hstepB = (size_t)HALF * g.ldb * 2;
    const size_t tstepA = 2 * hstepA, tstepB = 2 * hstepB;
    const unsigned ldsw = (unsigned)wid * 1024u;
    const int aoff = lds_byte(wr * 64 + fr, fq * 8), boff = lds_byte(wc * 32 + fr, fq * 8);
#define PG8_SA(b, h) (((b) * 2 + (h)) * HTB)
#define PG8_SB(b, h) ((4 + (b) * 2 + (h)) * HTB)
#define PG8_STAGE(bufoff, gbase, voff) do { _Pragma("unroll") for (int _i = 0; _i < 2; ++_i) \
        __builtin_amdgcn_global_load_lds((const unsigned*)((const char*)(gbase) + (voff)[_i]), (PG8_LAS unsigned*)(lds + (bufoff) + ldsw + _i * 8192), 16, 0, 0); } while (0)
#define PG8_LDA(dst, b, h) do { _Pragma("unroll") for (int m = 0; m < 4; ++m) _Pragma("unroll") for (int k = 0; k < 2; ++k) dst[m][k] = *(const PG8_LAS bf16x8*)(lds + PG8_SA(b, h) + aoff + m * 2048 + k * 1024); } while (0)
#define PG8_LDB(dst, b, h) do { _Pragma("unroll") for (int n = 0; n < 2; ++n) _Pragma("unroll") for (int k = 0; k < 2; ++k) dst[n][k] = *(const PG8_LAS bf16x8*)(lds + PG8_SB(b, h) + boff + n * 2048 + k * 1024); } while (0)
#define PG8_MMA(ai, bj, At, Bt) do { __builtin_amdgcn_s_setprio(1); _Pragma("unroll") for (int m = 0; m < 4; ++m) _Pragma("unroll") for (int n = 0; n < 2; ++n) _Pragma("unroll") for (int k = 0; k < 2; ++k) \
        acc[ai][bj][m][n] = __builtin_amdgcn_mfma_f32_16x16x32_bf16(Bt[n][k], At[m][k], acc[ai][bj][m][n], 0, 0, 0); __builtin_amdgcn_s_setprio(0); } while (0)
#define PG8_WAIT_V(n) asm volatile("s_waitcnt vmcnt(" #n ")" ::: "memory")
#define PG8_WAIT_L(n) asm volatile("s_waitcnt lgkmcnt(" #n ")" ::: "memory")
#define PG8_BAR __builtin_amdgcn_s_barrier()
#define PG8_SCHED __builtin_amdgcn_sched_barrier(0)
    Unit cur, nxt; int ui = 0;
    if (!S.next(0, cur)) return;
    f32x4 acc[2][2][4][2];
#pragma unroll
    for (int a = 0; a < 2; ++a)
#pragma unroll
        for (int b = 0; b < 2; ++b)
#pragma unroll
            for (int m = 0; m < 4; ++m)
#pragma unroll
                for (int n = 0; n < 2; ++n) acc[a][b][m][n] = (f32x4){0.f, 0.f, 0.f, 0.f};
    bf16x8 At[4][2], B0[2][2], B1[2][2];
    const char* cA = (const char*)g.A + (size_t)cur.pm * tstepA; const char* cB = (const char*)g.Bt + (size_t)cur.pn * tstepB;
    S.a_ready(cur);
    if constexpr (SP2) {
        PG8_STAGE(PG8_SB(0, 0), cB, voffB); PG8_STAGE(PG8_SB(0, 1), cB + hstepB, voffB); PG8_STAGE(PG8_SA(0, 0), cA, voffA); PG8_STAGE(PG8_SA(0, 1), cA + hstepA, voffA);
        if (wr == 1) PG8_BAR;
        PG8_WAIT_V(2); PG8_BAR;
        PG8_STAGE(PG8_SB(1, 0), cB + kstepB, voffB); PG8_STAGE(PG8_SA(1, 0), cA + kstepA, voffA); PG8_STAGE(PG8_SB(1, 1), cB + hstepB + kstepB, voffB);
        PG8_WAIT_V(6); PG8_BAR;
    } else {
        PG8_STAGE(PG8_SB(0, 0), cB, voffB); PG8_STAGE(PG8_SA(0, 0), cA, voffA); PG8_STAGE(PG8_SB(0, 1), cB + hstepB, voffB); PG8_STAGE(PG8_SA(0, 1), cA + hstepA, voffA);
        if (wr == 1) PG8_BAR;
        PG8_WAIT_V(4); PG8_BAR;
        PG8_STAGE(PG8_SB(1, 0), cB + kstepB, voffB); PG8_STAGE(PG8_SA(1, 0), cA + kstepA, voffA); PG8_STAGE(PG8_SB(1, 1), cB + hstepB + kstepB, voffB);
        PG8_WAIT_V(6); PG8_BAR;
    }
    for (;;) {
        const bool has_next = S.next(ui + 1, nxt);
        const char* nA = has_next ? (const char*)g.A + (size_t)nxt.pm * tstepA : cA; const char* nB = has_next ? (const char*)g.Bt + (size_t)nxt.pn * tstepB : cB;
        for (int t = 0; t < nt; t += 2) {
            const bool last = (t == nt - 2);
            const char* a1 = cA + (size_t)(t + 1) * kstepA;
            const char* a2 = last ? nA : cA + (size_t)(t + 2) * kstepA; const char* b2 = last ? nB : cB + (size_t)(t + 2) * kstepB;
            const char* a3 = a2 + kstepA; const char* b3 = b2 + kstepB;
            if (last && has_next) S.a_ready(nxt);
            if constexpr (SP2) {
            PG8_LDB(B0, 0, 0); PG8_LDB(B1, 0, 1); PG8_SCHED; PG8_LDA(At, 0, 0); PG8_STAGE(PG8_SA(1, 1), a1 + hstepA, voffA);
            PG8_WAIT_V(8); PG8_WAIT_L(0); PG8_BAR; PG8_MMA(0, 0, At, B0); PG8_MMA(0, 1, At, B1); PG8_BAR; PG8_SCHED;
            PG8_LDA(At, 0, 1); PG8_STAGE(PG8_SB(0, 0), b2, voffB); PG8_STAGE(PG8_SB(0, 1), b2 + hstepB, voffB); PG8_STAGE(PG8_SA(0, 0), a2, voffA);
            PG8_WAIT_V(8); PG8_WAIT_L(0); PG8_BAR; PG8_MMA(1, 0, At, B0); PG8_MMA(1, 1, At, B1); PG8_BAR; PG8_SCHED;
            PG8_LDB(B0, 1, 0); PG8_LDB(B1, 1, 1); PG8_SCHED; PG8_LDA(At, 1, 0); PG8_STAGE(PG8_SA(0, 1), a2 + hstepA, voffA);
            PG8_WAIT_V(8); PG8_WAIT_L(0); PG8_BAR; PG8_MMA(0, 0, At, B0); PG8_MMA(0, 1, At, B1); PG8_BAR; PG8_SCHED;
            PG8_LDA(At, 1, 1); PG8_STAGE(PG8_SB(1, 0), b3, voffB); PG8_STAGE(PG8_SB(1, 1), b3 + hstepB, voffB); PG8_STAGE(PG8_SA(1, 0), a3, voffA);
            PG8_WAIT_V(8); PG8_WAIT_L(0); PG8_BAR; PG8_MMA(1, 0, At, B0); PG8_MMA(1, 1, At, B1); PG8_BAR; PG8_SCHED;
            } else {
            PG8_LDB(B0, 0, 0); PG8_SCHED; PG8_LDA(At, 0, 0); PG8_STAGE(PG8_SA(1, 1), a1 + hstepA, voffA);
            PG8_WAIT_L(8); PG8_BAR; PG8_WAIT_L(0); PG8_MMA(0, 0, At, B0); PG8_BAR; PG8_SCHED;
            PG8_LDB(B1, 0, 1); PG8_STAGE(PG8_SB(0, 0), b2, voffB);
            PG8_BAR; PG8_WAIT_L(0); PG8_MMA(0, 1, At, B1); PG8_BAR;
            PG8_LDA(At, 0, 1); PG8_STAGE(PG8_SA(0, 0), a2, voffA);
            PG8_BAR; PG8_WAIT_L(0); PG8_MMA(1, 0, At, B0); PG8_BAR; PG8_SCHED;
            PG8_STAGE(PG8_SB(0, 1), b2 + hstepB, voffB);
            PG8_WAIT_V(6); PG8_BAR; PG8_MMA(1, 1, At, B1); PG8_BAR;
            PG8_LDB(B0, 1, 0); PG8_SCHED; PG8_LDA(At, 1, 0); PG8_STAGE(PG8_SA(0, 1), a2 + hstepA, voffA);
            PG8_WAIT_L(8); PG8_BAR; PG8_WAIT_L(0); PG8_MMA(0, 0, At, B0); PG8_BAR; PG8_SCHED;
            PG8_LDB(B1, 1, 1); PG8_STAGE(PG8_SB(1, 0), b3, voffB);
            PG8_BAR; PG8_WAIT_L(0); PG8_MMA(0, 1, At, B1); PG8_BAR;
            PG8_LDA(At, 1, 1); PG8_STAGE(PG8_SA(1, 0), a3, voffA);
            PG8_BAR; PG8_WAIT_L(0); PG8_MMA(1, 0, At, B0); PG8_BAR; PG8_SCHED;
            PG8_STAGE(PG8_SB(1, 1), b3 + hstepB, voffB);
            PG8_WAIT_V(6); PG8_BAR; PG8_MMA(1, 1, At, B1); PG8_BAR;
            }
        }
        if constexpr (ALIGN_EPI) { if (wr == 0) PG8_BAR; }
        if constexpr (!Epi::AFTER_DRAIN) { E(acc, cur, wr, wc, fr, fq); S.done(cur); }
        if (!has_next) break;
#pragma unroll
        for (int a = 0; a < 2; ++a)
#pragma unroll
            for (int b = 0; b < 2; ++b)
#pragma unroll
                for (int m = 0; m < 4; ++m)
#pragma unroll
                    for (int n = 0; n < 2; ++n) acc[a][b][m][n] = (f32x4){0.f, 0.f, 0.f, 0.f};
        cur = nxt; cA = nA; cB = nB; ++ui;
        if constexpr (ALIGN_EPI) { if (wr == 1) PG8_BAR; }
    }
    PG8_WAIT_V(0);
    if constexpr (!ALIGN_EPI) { if (wr == 0) PG8_BAR; }
    PG8_BAR;
    if constexpr (Epi::AFTER_DRAIN) { E.fused(acc, cur, wr, wc, fr, fq, lds, wid, lane); S.done(cur); }
#undef PG8_SA
#undef PG8_SB
#undef PG8_STAGE
#undef PG8_LDA
#undef PG8_LDB
#undef PG8_MMA
#undef PG8_WAIT_V
#undef PG8_WAIT_L
#undef PG8_BAR
#undef PG8_SCHED
}
struct MUnit { int pm, pn, b, g; };
template <class Epi>
__device__ __forceinline__ void gemm_phase_merge(PG8_LAS unsigned char* lds, const unsigned char* ws, const bf16_t* XBp, const StaticOrder& S, const Epi& E) {
    int tid_ = threadIdx.x; asm volatile("" : "+v"(tid_));
    const int tid = tid_, wid = __builtin_amdgcn_readfirstlane(tid >> 6), lane = tid & 63, wr = wid >> 2, wc = wid & 3, fr = lane & 15, fq = lane >> 4;
    unsigned vY0, vGd;
    { int R, C; stage_rc(tid * 16, R, C); vY0 = (unsigned)(R * 512 + C) * 2u; vGd = (unsigned)(R * 512) * 2u; }
    constexpr size_t kstep = (size_t)(BK * 2), hY = (size_t)HALF * 512 * 2, hG = (size_t)HALF * 1024 * 2;
    const unsigned ldsw = (unsigned)wid * 1024u;
    const int aoff = lds_byte(wr * 64 + fr, fq * 8), boff = lds_byte(wc * 32 + fr, fq * 8);
#define PG8_SA(b, h) (((b) * 2 + (h)) * HTB)
#define PG8_SB(b, h) ((4 + (b) * 2 + (h)) * HTB)
#define PG8_STAGE(bufoff, gbase, voff, q64) do { const char* gb0_ = (const char*)(gbase); const char* gb1_ = gb0_ + (q64); unsigned vo_ = (voff); \
        asm volatile("" : "+s"(gb0_)); asm volatile("" : "+s"(gb1_)); asm volatile("" : "+v"(vo_));        \
        __builtin_amdgcn_global_load_lds((const unsigned*)(gb0_ + vo_), (PG8_LAS unsigned*)(lds + (bufoff) + ldsw), 16, 0, 0); \
        __builtin_amdgcn_global_load_lds((const unsigned*)(gb1_ + vo_), (PG8_LAS unsigned*)(lds + (bufoff) + ldsw + 8192), 16, 0, 0); } while (0)
#define PG8_LDA(dst, b, h) do { _Pragma("unroll") for (int m = 0; m < 4; ++m) _Pragma("unroll") for (int k = 0; k < 2; ++k) dst[m][k] = *(const PG8_LAS bf16x8*)(lds + PG8_SA(b, h) + aoff + m * 2048 + k * 1024); } while (0)
#define PG8_LDB(dst, b, h) do { _Pragma("unroll") for (int n = 0; n < 2; ++n) _Pragma("unroll") for (int k = 0; k < 2; ++k) dst[n][k] = *(const PG8_LAS bf16x8*)(lds + PG8_SB(b, h) + boff + n * 2048 + k * 1024); } while (0)
#define PG8_MMA(ai, bj, At, Bt) do { __builtin_amdgcn_s_setprio(1); _Pragma("unroll") for (int m = 0; m < 4; ++m) _Pragma("unroll") for (int n = 0; n < 2; ++n) _Pragma("unroll") for (int k = 0; k < 2; ++k) \
        acc[ai][bj][m][n] = __builtin_amdgcn_mfma_f32_16x16x32_bf16(Bt[n][k], At[m][k], acc[ai][bj][m][n], 0, 0, 0); __builtin_amdgcn_s_setprio(0); } while (0)
#define PG8_WAIT_V(n) asm volatile("s_waitcnt vmcnt(" #n ")" ::: "memory")
#define PG8_WAIT_L(n) asm volatile("s_waitcnt lgkmcnt(" #n ")" ::: "memory")
#define PG8_BAR __builtin_amdgcn_s_barrier()
#define PG8_SCHED __builtin_amdgcn_sched_barrier(0)
#define MU_NEXT(i, u, ok) do { Unit t_; const int ti_ = (i) / 6, sub_ = (i) - 6 * ti_; ok = S.next(ti_, t_); u.pm = t_.pm; u.pn = t_.pn; u.b = sub_ >> 1; u.g = sub_ & 1; } while (0)
#define MU_BASEA(u) ((u).g ? (const char*)XBp + (size_t)(u).pm * (2 * hG) : (const char*)ws + ((u).b == 0 ? OFF_AO : ((u).b == 1 ? OFF_CB : OFF_XQ)) + (size_t)(u).pm * (2 * hY))
#define MU_BASEB(u) ((u).g ? (const char*)ws + OFF_W_GATE + ((size_t)(u).b * 1024 + (size_t)(u).pn * 256) * 2048 : (const char*)ws + OFF_W_OMLA + (size_t)(u).b * 1048576 + (size_t)(u).pn * (2 * hY))
    MUnit cur, nxt; int ui = 0; bool ok0;
    MU_NEXT(0, cur, ok0);
    if (!ok0) return;
    f32x4 acc[2][2][4][2];
#pragma unroll
    for (int a = 0; a < 2; ++a)
#pragma unroll
        for (int b = 0; b < 2; ++b)
#pragma unroll
            for (int m = 0; m < 4; ++m)
#pragma unroll
                for (int n = 0; n < 2; ++n) acc[a][b][m][n] = (f32x4){0.f, 0.f, 0.f, 0.f};
    bf16x8 At[4][2], B0[2][2], B1[2][2];
    const char* cA = MU_BASEA(cur); const char* cB = MU_BASEB(cur);
    {
        const unsigned vc = cur.g ? vY0 + vGd : vY0; const size_t hc = cur.g ? hG : hY, qc = hc >> 1;
        PG8_STAGE(PG8_SB(0, 0), cB, vc, qc); PG8_STAGE(PG8_SB(0, 1), cB + hc, vc, qc); PG8_STAGE(PG8_SA(0, 0), cA, vc, qc); PG8_STAGE(PG8_SA(0, 1), cA + hc, vc, qc);
        if (wr == 1) PG8_BAR;
        PG8_WAIT_V(2); PG8_BAR;
        PG8_STAGE(PG8_SB(1, 0), cB + kstep, vc, qc); PG8_STAGE(PG8_SA(1, 0), cA + kstep, vc, qc); PG8_STAGE(PG8_SB(1, 1), cB + hc + kstep, vc, qc);
        PG8_WAIT_V(6); PG8_BAR;
    }
    for (;;) {
        bool has_next; MU_NEXT(ui + 1, nxt, has_next);
        const char* nA = has_next ? MU_BASEA(nxt) : cA; const char* nB = has_next ? MU_BASEB(nxt) : cB;
        const int ng = has_next ? nxt.g : cur.g;
        const unsigned vc = cur.g ? vY0 + vGd : vY0, vn = ng ? vY0 + vGd : vY0;
        const size_t hc = cur.g ? hG : hY, hn = ng ? hG : hY, qc = hc >> 1;
        const int nt = cur.g ? 16 : 8;
        for (int t = 0; t < nt; t += 2) {
            const bool last = (t == nt - 2);
            const char* a1 = cA + (size_t)(t + 1) * kstep;
            const char* a2 = last ? nA : cA + (size_t)(t + 2) * kstep; const char* b2 = last ? nB : cB + (size_t)(t + 2) * kstep;
            const char* a3 = a2 + kstep; const char* b3 = b2 + kstep;
            const unsigned v2 = last ? vn : vc; const size_t h2 = last ? hn : hc, q2 = h2 >> 1;
            PG8_LDB(B0, 0, 0); PG8_LDB(B1, 0, 1); PG8_SCHED; PG8_LDA(At, 0, 0); PG8_STAGE(PG8_SA(1, 1), a1 + hc, vc, qc);
            PG8_WAIT_V(8); PG8_WAIT_L(0); PG8_BAR; PG8_MMA(0, 0, At, B0); PG8_MMA(0, 1, At, B1); PG8_BAR; PG8_SCHED;
            PG8_LDA(At, 0, 1); PG8_STAGE(PG8_SB(0, 0), b2, v2, q2); PG8_STAGE(PG8_SB(0, 1), b2 + h2, v2, q2); PG8_STAGE(PG8_SA(0, 0), a2, v2, q2);
            PG8_WAIT_V(8); PG8_WAIT_L(0); PG8_BAR; PG8_MMA(1, 0, At, B0); PG8_MMA(1, 1, At, B1); PG8_BAR; PG8_SCHED;
            PG8_LDB(B0, 1, 0); PG8_LDB(B1, 1, 1); PG8_SCHED; PG8_LDA(At, 1, 0); PG8_STAGE(PG8_SA(0, 1), a2 + h2, v2, q2);
            PG8_WAIT_V(8); PG8_WAIT_L(0); PG8_BAR; PG8_MMA(0, 0, At, B0); PG8_MMA(0, 1, At, B1); PG8_BAR; PG8_SCHED;
            PG8_LDA(At, 1, 1); PG8_STAGE(PG8_SB(1, 0), b3, v2, q2); PG8_STAGE(PG8_SB(1, 1), b3 + h2, v2, q2); PG8_STAGE(PG8_SA(1, 0), a3, v2, q2);
            PG8_WAIT_V(8); PG8_WAIT_L(0); PG8_BAR; PG8_MMA(1, 0, At, B0); PG8_MMA(1, 1, At, B1); PG8_BAR; PG8_SCHED;
        }
        if (wr == 0) PG8_BAR;
        E(acc, cur, wr, wc, fr, fq);
        if (!has_next) break;
#pragma unroll
        for (int a = 0; a < 2; ++a)
#pragma unroll
            for (int b = 0; b < 2; ++b)
#pragma unroll
                for (int m = 0; m < 4; ++m)
#pragma unroll
                    for (int n = 0; n < 2; ++n) acc[a][b][m][n] = (f32x4){0.f, 0.f, 0.f, 0.f};
        cur = nxt; cA = nA; cB = nB; ++ui;
        if (wr == 1) PG8_BAR;
    }
    PG8_WAIT_V(0);
    PG8_BAR;
#undef MU_NEXT
#undef MU_BASEA
#undef MU_BASEB
#undef PG8_SA
#undef PG8_SB
#undef PG8_STAGE
#undef PG8_LDA
#undef PG8_LDB
#undef PG8_MMA
#undef PG8_WAIT_V
#undef PG8_WAIT_L
#undef PG8_BAR
#undef PG8_SCHED
}
struct EpiMerge {
    uint4* ytile; uint4* stile; const float* rs1; bf16_t* MERGED;
    __device__ __forceinline__ void operator()(const f32x4 (&acc)[2][2][4][2], const MUnit& u, int wr, int wc, int fr, int fq) const {
        asm volatile("" : "+v"(fr), "+v"(fq));
        const int slot = (wr * 4 + wc) * 16 * 64 + fq * 16 + fr;
#pragma unroll
        for (int ai = 0; ai < 2; ++ai) {
            if (!u.g) {
#pragma unroll
                for (int m = 0; m < 4; ++m)
#pragma unroll
                    for (int bj = 0; bj < 2; ++bj) {
                        const f32x4 v0 = acc[ai][bj][m][0], v1 = acc[ai][bj][m][1]; uint4 w;
                        w.x = ::pk2(v0[0], v0[1]); w.y = ::pk2(v0[2], v0[3]); w.z = ::pk2(v1[0], v1[1]); w.w = ::pk2(v1[2], v1[3]);
                        ytile[slot + ((ai * 4 + m) * 2 + bj) * 64] = w;
                    }
            } else {
                uint4 ys[4][2], ss[4][2]; float ri[4];
#pragma unroll
                for (int m = 0; m < 4; ++m) {
                    ri[m] = rs1[u.pm * BM + ai * HALF + wr * 64 + m * 16 + fr];
#pragma unroll
                    for (int bj = 0; bj < 2; ++bj) {
                        ys[m][bj] = ytile[slot + ((ai * 4 + m) * 2 + bj) * 64];
                        if (u.b > 0) ss[m][bj] = stile[slot + ((ai * 4 + m) * 2 + bj) * 64]; else ss[m][bj] = make_uint4(0u, 0u, 0u, 0u);
                    }
                }
#pragma unroll
                for (int m = 0; m < 4; ++m) {
                    const float rinv = rsqrtf(ri[m] * (1.f / 1024.f) + EPS);
                    bf16_t* mp = MERGED + ((size_t)(u.pn * 4 + (wc >> 1)) * NTOK + (size_t)(u.pm * 2 + ai) * 128) * 64 + ((wr * 4 + m) * 4 + (wc & 1) * 2) * 256 + fr * 16 + fq * 4;
#pragma unroll
                    for (int bj = 0; bj < 2; ++bj) {
                        const uint4 yw = ys[m][bj], sw = ss[m][bj];
                        const f32x4 g0 = acc[ai][bj][m][0] * rinv, g1 = acc[ai][bj][m][1] * rinv;
                        const f32x4 y0 = {::bflo(yw.x), ::bfhi(yw.x), ::bflo(yw.y), ::bfhi(yw.y)}, y1 = {::bflo(yw.z), ::bfhi(yw.z), ::bflo(yw.w), ::bfhi(yw.w)};
                        f32x4 v0 = {::bflo(sw.x), ::bfhi(sw.x), ::bflo(sw.y), ::bfhi(sw.y)}, v1 = {::bflo(sw.z), ::bfhi(sw.z), ::bflo(sw.w), ::bfhi(sw.w)};
#pragma unroll
                        for (int j = 0; j < 4; ++j) { v0[j] += y0[j] * __builtin_amdgcn_rcpf(1.f + __expf(-g0[j])); v1[j] += y1[j] * __builtin_amdgcn_rcpf(1.f + __expf(-g1[j])); }
                        if (u.b < 2) {
                            uint4 w; w.x = ::pk2(v0[0], v0[1]); w.y = ::pk2(v0[2], v0[3]); w.z = ::pk2(v1[0], v1[1]); w.w = ::pk2(v1[2], v1[3]);
                            stile[slot + ((ai * 4 + m) * 2 + bj) * 64] = w;
                        } else { ::st_bf4(mp + (size_t)bj * 2 * NTOK * 64, v0); ::st_bf4(mp + (size_t)bj * 2 * NTOK * 64 + 256, v1); }
                    }
                }
            }
        }
    }
};
}

DEVI void copy_rows_bf16(const float* x0, const float* x1, bf16_t* dst, float* rs, int gw, int nw, int lane) {
    for (int row = gw; row < NTOK; row += nw) {
        const float* src = row < 16384 ? x0 + (size_t)row * 1024 : x1 + (size_t)(row - 16384) * 1024;
        f32x4 v[4]; float s = 0.f;
#pragma unroll
        for (int i = 0; i < 4; ++i) { v[i] = ld_f4(src + lane * 4 + 256 * i); s += dot4(v[i]); }
        s += __shfl_xor(s, 1); s += __shfl_xor(s, 2); s += __shfl_xor(s, 4); s += __shfl_xor(s, 8); s += __shfl_xor(s, 16); s += __shfl_xor(s, 32);
        if (lane == 0) rs[row] = s;
#pragma unroll
        for (int i = 0; i < 4; ++i) st_bf4(dst + (size_t)row * 1024 + lane * 4 + 256 * i, v[i]);
    }
}

#define W1GU ((bf16_t*)(ws + OFF_W1GU))
#define W1DN ((bf16_t*)(ws + OFF_W1DN))
#define W2DN ((bf16_t*)(ws + OFF_W2DN))
#define W2GU ((bf16_t*)((unsigned char*)p.out + D1_W2GU))
#define W_OUT ((bf16_t*)((unsigned char*)p.out + D1_WOUT))
#define RS2 ((float*)((unsigned char*)p.out + D1_RS2))
#define RS0 ((float*)(ws + OFF_RS0))
#define RS1 ((float*)(ws + OFF_RS1))
#define XB ((bf16_t*)p.out)
#define XB0 ((bf16_t*)((unsigned char*)p.out + D1_OFF))
#define X2B ((bf16_t*)(ws + OFF_X2B))
#define HID2 ((bf16_t*)(ws + OFF_HID2))
#define W_IN1 ((bf16_t*)(ws + OFF_W_IN1))
#define W_IN2 ((bf16_t*)(ws + OFF_W_IN2))
#define W_GATE ((bf16_t*)(ws + OFF_W_GATE))
#define W_UQ ((bf16_t*)(ws + OFF_W_UQ))
#define W_UK ((bf16_t*)(ws + OFF_W_UK))
#define W_UV ((bf16_t*)(ws + OFF_W_UV))
#define W_OMLA ((bf16_t*)(ws + OFF_W_OMLA))
#define W_OCONV ((bf16_t*)(ws + OFF_W_OCONV))
#define W_OMEM ((bf16_t*)(ws + OFF_W_OMEM))
#define W_MEMK ((bf16_t*)(ws + OFF_W_MEMK))
#define W_MEMV ((bf16_t*)(ws + OFF_W_MEMV))
#define MK ((bf16_t*)(ws + OFF_MK))
#define MVT ((bf16_t*)(ws + OFF_MVT))
#define ROPE ((float*)(ws + OFF_ROPE))
#define RSQ ((float*)(ws + OFF_RSQ))
#define RSKV ((float*)(ws + OFF_RSKV))
#define MN ((bf16_t*)(ws + OFF_MN))
#define XQ ((bf16_t*)(ws + OFF_XQ))
#define CQ ((bf16_t*)(ws + OFF_CQ))
#define CKV ((bf16_t*)(ws + OFF_CKV))
#define Qb ((bf16_t*)(ws + OFF_Q))
#define Kb ((bf16_t*)(ws + OFF_K))
#define VT ((bf16_t*)(ws + OFF_VT))
#define HID ((bf16_t*)(ws + OFF_HID))
#define AO ((bf16_t*)(ws + OFF_AO))
#define CB ((bf16_t*)(ws + OFF_CB))
#define Ub ((bf16_t*)(ws + OFF_U))
#define MERGED ((bf16_t*)(ws + OFF_MERGED))
#define LAS __attribute__((address_space(3)))
#define XB_TMO      128
#define XB_XCNT(j)  (256  + 64 * (j))
#define XB_XSUB(j)  (1280 + 64 * (j))
#define XB_XGEN(j)  (2304 + 64 * (j))
#define XB_TOP      3328
#define XB_TOPGEN   3392
#define XCD_BAR_WORDS 3456
#define XB_SPIN_CAP (1u << 18)

__device__ __forceinline__ unsigned xb_ld(unsigned* p)              { return __hip_atomic_load(p, __ATOMIC_RELAXED, __HIP_MEMORY_SCOPE_AGENT); }
__device__ __forceinline__ unsigned xb_add(unsigned* p, unsigned v) { return __hip_atomic_fetch_add(p, v, __ATOMIC_RELAXED, __HIP_MEMORY_SCOPE_AGENT); }
__device__ __forceinline__ unsigned xb_xcc_id() { return (unsigned)__builtin_amdgcn_s_getreg((3 << 11) | 20) & 0xFu; }
#define XB_SPIN(cond, bar) do { unsigned _sp = 0; while (cond) { __builtin_amdgcn_s_sleep(1); \
    if ((++_sp & 255u) == 0u) { if (xb_ld(&(bar)[XB_TMO])) break; if (_sp > XB_SPIN_CAP) { atomicAdd(&(bar)[XB_TMO], 1u); break; } } } } while (0)

struct XcdBarrier {
    unsigned* bar; unsigned x;
    volatile LAS unsigned* st;
};

__device__ __forceinline__ XcdBarrier xcd_barrier_post(unsigned* bar, volatile LAS unsigned* st) {
    XcdBarrier b; b.bar = bar; b.x = xb_xcc_id(); b.st = st;
    if (threadIdx.x == 0) (void)xb_add(&bar[XB_XCNT(b.x)], 1u);
    return b;
}
__device__ __forceinline__ void xcd_barrier_complete(unsigned* bar, unsigned x, unsigned& nloc, unsigned& nx) {
    const unsigned G = gridDim.x * gridDim.y * gridDim.z;
    unsigned sum, cnt, mine, sp = 0u;
    for (;;) {
        sum = 0u; cnt = 0u; mine = 0u;
#pragma unroll
        for (unsigned j = 0; j < 16; ++j) { const unsigned c = xb_ld(&bar[XB_XCNT(j)]); sum += c; cnt += (c > 0u) ? 1u : 0u; mine = (j == x) ? c : mine; }
        if (sum == G) break;
        __builtin_amdgcn_s_sleep(1);
        if ((++sp & 255u) == 0u) { if (xb_ld(&bar[XB_TMO])) break; if (sp > XB_SPIN_CAP) { atomicAdd(&bar[XB_TMO], 1u); break; } }
    }
    nloc = mine > 0u ? mine : 1u; nx = cnt > 0u ? cnt : 1u;
}

__device__ __forceinline__ void xcd_barrier(const XcdBarrier& b) {
    asm volatile("s_waitcnt vmcnt(0)" ::: "memory");
    __syncthreads();
    if (threadIdx.x == 0) {
        unsigned* bar = b.bar;
        __builtin_amdgcn_s_waitcnt(0);
        unsigned nloc = b.st[0], nx = b.st[1];
        if (nloc == 0u) { xcd_barrier_complete(bar, b.x, nloc, nx); b.st[0] = nloc; b.st[1] = nx; }
        const unsigned old = xb_add(&bar[XB_XSUB(b.x)], 1u);
        const unsigned gen = old / nloc;
        if (old + 1u == (gen + 1u) * nloc) {
            __builtin_amdgcn_fence(__ATOMIC_RELEASE, "agent");
            asm volatile("s_waitcnt vmcnt(0)" ::: "memory");
            const unsigned og = xb_add(&bar[XB_TOP], 1u);
            const unsigned tg = og / nx;
            if (og + 1u == (tg + 1u) * nx) xb_add(&bar[XB_TOPGEN], 1u);
            else XB_SPIN(xb_ld(&bar[XB_TOPGEN]) == tg, bar);
            __builtin_amdgcn_fence(__ATOMIC_ACQUIRE, "agent");
            xb_add(&bar[XB_XGEN(b.x)], 1u);
            asm volatile("s_waitcnt vmcnt(0)" ::: "memory");
        } else {
            XB_SPIN(xb_ld(&bar[XB_XGEN(b.x)]) == gen, bar);
            __builtin_amdgcn_fence(__ATOMIC_ACQUIRE, "agent");
            asm volatile("s_waitcnt vmcnt(0)" ::: "memory");
        }
    }
    __syncthreads();
}

#define PHASE_VARS \
    int tx_ = threadIdx.x; asm volatile("" : "+v"(tx_)); \
    const int vh = __builtin_amdgcn_readfirstlane(tx_ >> 8); \
    unsigned char* const smem = smem_all + vh * SM_TOTAL; \
    const int tid = tx_ & 255, lane = tid & 63, wid = tid >> 6, wr = wid >> 1, wc = wid & 1, fr = lane & 15, fq = lane >> 4; \
    const int G = gridDim.x * 2, bid = blockIdx.x * 2 + vh; \
    (void)smem; (void)tid; (void)lane; (void)wid; (void)wr; (void)wc; (void)fr; (void)fq; (void)G; (void)bid;
__global__ void __launch_bounds__(512, 2) mega(Params p) {
    extern __shared__ __attribute__((aligned(16))) unsigned char smem_all[];

    cg::grid_group grid = cg::this_grid();
    unsigned char* ws = p.ws;
    volatile LAS unsigned* bst = (volatile LAS unsigned*)((LAS unsigned char*)smem_all + 2 * SM_TOTAL);
    if (threadIdx.x == 0) { bst[0] = 0u; bst[1] = 0u; }
    __syncthreads();
    const XcdBarrier xbar = xcd_barrier_post((unsigned*)(ws + OFF_BAR), bst);

    { PHASE_VARS
    { int cbase = 0; for (int id = 0; id < 13; ++id) { const WSpec s = get_spec(p, id); convert_spec(s, smem, bid, G, tid, cbase); } }
    for (int i = bid * 256 + tid; i < 3 * NTOK; i += G * 256) RSQ[i] = 0.f;
    for (int i = bid * 256 + tid; i < 8192 * 16; i += G * 256) {
        const int s = i >> 4, f = i & 15, a = f >> 2, b = f & 3;
        const double fa = a == 0 ? 1.0 : (a == 1 ? 0.1 : (a == 2 ? 0.01 : 0.001));
        const double fb = b == 0 ? 1.0 : (b == 1 ? 0.5623413251903491 : (b == 2 ? 0.31622776601683794 : 0.1778279410038923));
        double rev = (double)s * fa * fb * 0.15915494309189535; rev -= floor(rev);
        const float rv = (float)rev;
        ROPE[2 * i] = __builtin_amdgcn_cosf(rv); ROPE[2 * i + 1] = __builtin_amdgcn_sinf(rv);
    }
    for (int row = bid * 4 + wid; row < 1536; row += G * 4) {
        const float* src = row < 512 ? p.memp + (size_t)row * 1024 : p.mems + (size_t)(row - 512) * 1024;
        f32x4 v[4]; float s = 0.f;
#pragma unroll
        for (int i = 0; i < 4; ++i) { v[i] = ld_f4(src + lane * 4 + 256 * i); s += dot4(v[i]); }
        s += __shfl_xor(s, 1); s += __shfl_xor(s, 2); s += __shfl_xor(s, 4); s += __shfl_xor(s, 8); s += __shfl_xor(s, 16); s += __shfl_xor(s, 32);
        const float inv = rsqrtf(s * (1.f / 1024.f) + EPS);
#pragma unroll
        for (int i = 0; i < 4; ++i) st_bf4(MN + (size_t)row * 1024 + lane * 4 + 256 * i, v[i] * inv);
    }
    copy_rows_bf16(p.xp, p.xs, XB0, RS0, bid * 4 + wid, G * 4, lane);
    }
    grid.sync();
    { PHASE_VARS
    { pg8::Gemm g{XB0, W1GU, NTOK, 5632, 1024, 1024, 1024, 128, 128}; pg8::StaticOrder so; so.init(NTOK, 5632, gridDim.x, blockIdx.x);
      pg8::gemm_phase<pg8::EpiGU, pg8::StaticOrder, true, true>((PG8_LAS unsigned char*)smem_all, g, so, pg8::EpiGU{HID, RS0}); }
    __syncthreads();
    for (int u = bid; u < 96; u += G) {
        f32x4 acc[4][4]; zero_acc(acc);
        if (u < 48) {
            const int tm = u >> 2, hh = u & 3;
            gemm_tile<false>(acc, MN + (size_t)tm * 128 * 1024, 1024, W_MEMK + (size_t)hh * 128 * 1024, 1024, 16, smem);
            float tot[4]; tile_row_ss(acc, tot, smem, wr, wc, fr, fq);
#pragma unroll
            for (int m = 0; m < 4; ++m) {
                const int row = tm * 128 + wr * 64 + m * 16 + fr; const float inv = rsqrtf(tot[m] * (1.f / 128.f) + EPS);
#pragma unroll
                for (int n = 0; n < 4; ++n) { const int c = wc * 64 + n * 16 + fq * 4; st_bf4(MK + (size_t)row * 512 + hh * 128 + c, acc[m][n] * inv * ld_f4(p.xa_k_norm + c)); }
            }
        } else {
            const int v = u - 48, tm = v / 12, tn = v % 12;
            gemm_tile<false>(acc, W_MEMV + (size_t)tm * 128 * 1024, 1024, MN + (size_t)tn * 128 * 1024, 1024, 16, smem);
#pragma unroll
            for (int m = 0; m < 4; ++m) {
                const int d = wr * 64 + m * 16 + fr;
#pragma unroll
                for (int n = 0; n < 4; ++n) { const int col = tn * 128 + wc * 64 + n * 16 + fq * 4, b = col >> 8, mm = col & 255; st_bf4(MVT + ((size_t)(b * 4 + tm) * 128 + d) * 256 + mm, acc[m][n]); }
            }
        }
    }
    }
    xcd_barrier(xbar);
    { PHASE_VARS
    { pg8::Gemm g{HID, W1DN, NTOK, 1024, 2816, 0, 2816, (size_t)NTOK * 128, 128}; pg8::StaticOrder so; so.init(NTOK, 1024, gridDim.x, blockIdx.x);
      pg8::gemm_phase<pg8::EpiRes<0>, pg8::StaticOrder, true, true>((PG8_LAS unsigned char*)smem_all, g, so, pg8::EpiRes<0>{p.xp, p.xs, nullptr, XB, RS1, 0.5f}); }
    }
    xcd_barrier(xbar);
    { PHASE_VARS
    { int cbase = 0; for (int id = 13; id < 16; ++id) { const WSpec s = get_spec(p, id); convert_spec(s, smem, bid, G, tid, cbase); } }
    for (int i = bid * 256 + tid; i < NTOK; i += G * 256) RS2[i] = 0.f;
    __syncthreads();
    { pg8::Gemm g{XB, W_IN1, NTOK, 1280, 1024, 1024, 1024, 128, 128}; pg8::StaticOrder so; so.init(NTOK, 1280, gridDim.x, blockIdx.x);
      pg8::gemm_phase<pg8::EpiIn1, pg8::StaticOrder, true, true>((PG8_LAS unsigned char*)smem_all, g, so, pg8::EpiIn1{RS1, CQ, CKV, XQ, RSQ, RSKV}); }
    }
    xcd_barrier(xbar);
    { PHASE_VARS
    { pg8::Gemm g{CQ, W_UQ, NTOK, 768, 384, 384, 384, 128, 128}; pg8::StaticOrder so; so.init(NTOK, 768, gridDim.x, blockIdx.x);
      pg8::gemm_phase<pg8::EpiQ, pg8::StaticOrder, true, true>((PG8_LAS unsigned char*)smem_all, g, so, pg8::EpiQ{RSQ, Qb}); }
    { pg8::Gemm g{CKV, W_UK, NTOK, 512, 256, 288, 288, 128, 128}; pg8::StaticOrder so; so.init(NTOK, 512, gridDim.x, blockIdx.x);
      pg8::gemm_phase<pg8::EpiK, pg8::StaticOrder, true, true>((PG8_LAS unsigned char*)smem_all, g, so, pg8::EpiK{RSKV, CKV, p.mla_k_norm, ROPE, Kb}); }
    { pg8::Gemm g{W_UV, CKV, 512, NTOK, 256, 288, 288, 128, 128}; pg8::StaticOrder so; so.init(512, NTOK, gridDim.x, blockIdx.x);
      pg8::gemm_phase<pg8::EpiVt, pg8::StaticOrder, true, true>((PG8_LAS unsigned char*)smem_all, g, so, pg8::EpiVt{RSKV, VT}); }
    }
    xcd_barrier(xbar);
    { PHASE_VARS
    for (int j = blockIdx.x; j < 1024; j += gridDim.x) {
        int tok0i, pair, qt, nk, vtoff;
        if (j < 512) { const int r = j >> 8, i = j & 255; pair = (i & 7) + 8 * r; qt = i >> 3; tok0i = (pair >> 3) * 8192; nk = 8192; vtoff = 0; }
        else { const int jj = j - 512, r = jj >> 8, i = jj & 255, slot = i >> 3; pair = (i & 7) + 8 * (2 * r + (slot >> 4)); qt = slot & 15; tok0i = 16384 + (pair >> 3) * 4096; nk = 4096; vtoff = 8388608; }
        const int h = pair & 7;
        const size_t tok0 = (size_t)tok0i;
        attn_mla_item(p.mla_q_norm, ROPE, qt * 256, Qb + ((tok0 + qt * 256) * 8 + h) * 96, Kb + (tok0 * 8 + h) * 96, VT + (size_t)vtoff + (size_t)pair * 64 * nk, nk, nk, AO + (tok0 + qt * 256) * 512 + h * 64, smem_all, tx_);
    }
    __syncthreads();
    for (int jj = bid; jj < 1024; jj += G) {
        const int tile = jj >> 2, hh = jj & 3, tok0 = tile * 128;
        const int mb = tok0 < 16384 ? (tok0 >> 13) : 2 + ((tok0 - 16384) >> 12);
        bf16_t* qp = XQ + (size_t)tok0 * 512 + hh * 128;
        attn_item<128, 128, false, true>(p.xa_q_norm, QSCALE_XA, qp, 512, MK + (size_t)mb * 256 * 512 + hh * 128, 512, MVT + (size_t)(mb * 4 + hh) * 128 * 256, 256, 256, qp, 512, smem);
    }
    }
    xcd_barrier(xbar);
    { PHASE_VARS
    { pg8::Gemm g{XB, W_IN2, NTOK, 1536, 1024, 1024, 1024, 128, 128}; pg8::StaticOrder so; so.init(NTOK, 1536, gridDim.x, blockIdx.x);
      pg8::gemm_phase<pg8::EpiIn2, pg8::StaticOrder, true, true>((PG8_LAS unsigned char*)smem_all, g, so, pg8::EpiIn2{RS1, CB, Ub}); }
    }
    xcd_barrier(xbar);
    { PHASE_VARS
    for (int i = bid * 256 + tid; i < NTOK * 64; i += G * 256) {
        const int tok = i >> 6, c0 = (i & 63) * 8, pos = tok_pos(tok), slen = tok < 16384 ? 8192 : 4096;
        const bf16_t* up = Ub + (size_t)tok * 512 + c0;
        const uint4 z = {0u, 0u, 0u, 0u};
        const uint4 u0 = pos > 0 ? *(const uint4*)(up - 512) : z, u1 = *(const uint4*)up, u2 = pos < slen - 1 ? *(const uint4*)(up + 512) : z;
        const uint4 cb = *(const uint4*)(CB + (size_t)tok * 512 + c0);
        const unsigned a0[4] = {u0.x, u0.y, u0.z, u0.w}, a1[4] = {u1.x, u1.y, u1.z, u1.w}, a2[4] = {u2.x, u2.y, u2.z, u2.w}, ab[4] = {cb.x, cb.y, cb.z, cb.w};
        unsigned o[4];
#pragma unroll
        for (int q = 0; q < 4; ++q) {
            const int c = c0 + 2 * q;
            const float w0l = p.conv_w[c], w0h = p.conv_w[c + 1], w1l = p.conv_w[512 + c], w1h = p.conv_w[512 + c + 1], w2l = p.conv_w[1024 + c], w2h = p.conv_w[1024 + c + 1];
            const float yl = bflo(a0[q]) * w0l + bflo(a1[q]) * w1l + bflo(a2[q]) * w2l, yh = bfhi(a0[q]) * w0h + bfhi(a1[q]) * w1h + bfhi(a2[q]) * w2h;
            o[q] = pk2(bflo(ab[q]) * yl, bfhi(ab[q]) * yh);
        }
        uint4 ov; ov.x = o[0]; ov.y = o[1]; ov.z = o[2]; ov.w = o[3];
        *(uint4*)(CB + (size_t)tok * 512 + c0) = ov;
    }
    }
    xcd_barrier(xbar);
    { PHASE_VARS
    { pg8::StaticOrder so; so.init(NTOK, 1024, gridDim.x, blockIdx.x);
      pg8::gemm_phase_merge<pg8::EpiMerge>((PG8_LAS unsigned char*)smem_all, ws, XB, so, pg8::EpiMerge{(uint4*)Ub + (size_t)blockIdx.x * 8192, (uint4*)((unsigned char*)p.out + D1_STILE) + (size_t)blockIdx.x * 8192, RS1, MERGED}); }
    }
    xcd_barrier(xbar);
    { PHASE_VARS
    { pg8::Gemm g{MERGED, W_OUT, NTOK, 1024, 1024, 0, 1024, (size_t)NTOK * 128, 128}; pg8::StaticOrder so; so.init(NTOK, 1024, gridDim.x, blockIdx.x);
      pg8::gemm_phase<pg8::EpiRes<1>, pg8::StaticOrder, true, true>((PG8_LAS unsigned char*)smem_all, g, so, pg8::EpiRes<1>{nullptr, nullptr, XB, X2B, RS2, 1.0f}); }
    }
    xcd_barrier(xbar);
    { PHASE_VARS
    { pg8::Gemm g{X2B, W2GU, NTOK, 5632, 1024, 1024, 1024, 128, 128}; pg8::StaticOrder so; so.init(NTOK, 5632, gridDim.x, blockIdx.x);
      pg8::gemm_phase<pg8::EpiGU, pg8::StaticOrder, true, true>((PG8_LAS unsigned char*)smem_all, g, so, pg8::EpiGU{HID2, RS2}); }
    }
    xcd_barrier(xbar);
    { PHASE_VARS
    { pg8::Gemm g{HID2, W2DN, NTOK, 1024, 2816, 0, 2816, (size_t)NTOK * 128, 128}; pg8::StaticOrder so; so.init(NTOK, 1024, gridDim.x, blockIdx.x);
      pg8::gemm_phase<pg8::EpiFinal, pg8::StaticOrder, true, true>((PG8_LAS unsigned char*)smem_all, g, so, pg8::EpiFinal{X2B, p.out}); }
    }
}

extern "C" void kernel_launch(void* const* d_in, const int* in_sizes, int n_in, void* d_out, int out_size, void* d_ws, size_t ws_size, hipStream_t stream) {
    (void)in_sizes; (void)n_in; (void)out_size;
    static int grid_blocks = 0;
    if (!grid_blocks) {
        int dev = 0, cus = 0, per_cu = 0;
        (void)hipGetDevice(&dev);
        (void)hipDeviceGetAttribute(&cus, hipDeviceAttributeMultiprocessorCount, dev);
        (void)hipFuncSetAttribute((const void*)mega, hipFuncAttributeMaxDynamicSharedMemorySize, 2 * SM_TOTAL + 16);
        (void)hipOccupancyMaxActiveBlocksPerMultiprocessor(&per_cu, (const void*)mega, 512, 2 * SM_TOTAL + 16);
        if (per_cu > 1) per_cu = 1;
        if (per_cu < 1) per_cu = 1;
        grid_blocks = cus * per_cu;
        if (grid_blocks > 256) grid_blocks = 256;
    }
    if (ws_size < WS_SIZE) { fprintf(stderr, "workspace too small: %zu < %zu\n", ws_size, (size_t)WS_SIZE); return; }
    Params p{};
    const float* const* in = (const float* const*)d_in;
    p.xp = in[0]; p.xs = in[1]; p.memp = in[2]; p.mems = in[3];
    p.ffn1_norm = in[4]; p.ffn1_gu = in[5]; p.ffn1_down = in[6]; p.mix_norm = in[7]; p.w_in = in[8]; p.q_lora_norm = in[9]; p.w_uq = in[10];
    p.kv_lora_norm = in[11]; p.w_uk = in[12]; p.w_uv = in[13]; p.mla_q_norm = in[14]; p.mla_k_norm = in[15]; p.w_o_mla = in[16]; p.conv_w = in[17];
    p.w_o_conv = in[18]; p.mem_norm = in[19]; p.w_mem_kv = in[20]; p.xa_q_norm = in[21]; p.xa_k_norm = in[22]; p.w_o_mem = in[23]; p.w_out = in[24];
    p.ffn2_norm = in[25]; p.ffn2_gu = in[26]; p.ffn2_down = in[27];
    p.out = (float*)d_out; p.ws = (unsigned char*)d_ws;
    if (hipMemsetAsync((unsigned char*)d_ws + OFF_BAR, 0, 16384, stream) != hipSuccess) { fprintf(stderr, "memset of the barrier words failed\n"); return; }
    void* args[] = {&p};
    hipError_t e = hipLaunchCooperativeKernel((const void*)mega, dim3(grid_blocks), dim3(512), args, 2 * SM_TOTAL + 16, stream);
    if (e != hipSuccess) fprintf(stderr, "cooperative launch failed: %s (grid %d)\n", hipGetErrorString(e), grid_blocks);
}
```

```cpp
#include <hip/hip_runtime.h>
#include <hip/hip_cooperative_groups.h>
#include <cstdio>
#include <cstdint>
namespace cg = cooperative_groups;

#define DEVI __device__ __forceinline__
typedef unsigned short bf16_t;
typedef short bf16x8 __attribute__((ext_vector_type(8)));
typedef float f32x4 __attribute__((ext_vector_type(4)));
typedef float f32x16 __attribute__((ext_vector_type(16)));
typedef __bf16 bf16x2n __attribute__((ext_vector_type(2)));
typedef float f32x2n __attribute__((ext_vector_type(2)));

constexpr float EPS = 1e-6f;
constexpr int NTOK = 32768;
constexpr float QSCALE_MLA = 0.10206207261596575f * 1.4426950408889634f;
constexpr float QSCALE_XA = 0.08838834764831845f * 1.4426950408889634f;


constexpr size_t SZ_W_FFNGU = (size_t)5632 * 1024 * 2, SZ_W_FFNDN = (size_t)1024 * 2816 * 2;
constexpr size_t D1_OFF = (size_t)NTOK * 1024 * 2;
constexpr size_t D1_W2GU = D1_OFF, D1_WOUT = D1_W2GU + SZ_W_FFNGU, D1_RS2 = D1_WOUT + (size_t)1024 * 1024 * 2;
constexpr size_t OFF_W1GU = 0;
constexpr size_t OFF_W1DN = OFF_W1GU + SZ_W_FFNGU;
constexpr size_t OFF_W2DN = 0;
constexpr size_t OFF_W_IN1 = OFF_W1DN + SZ_W_FFNDN;
constexpr size_t OFF_W_IN2 = OFF_W_IN1 + (size_t)1280 * 1024 * 2;
constexpr size_t OFF_W_GATE = OFF_W_IN2 + (size_t)1536 * 1024 * 2;
constexpr size_t OFF_W_UQ = OFF_W_GATE + (size_t)3072 * 1024 * 2;
constexpr size_t OFF_W_UK = OFF_W_UQ + (size_t)1024 * 384 * 2;
constexpr size_t OFF_W_UV = OFF_W_UK + (size_t)512 * 288 * 2;
constexpr size_t OFF_W_OMLA = OFF_W_UV + (size_t)512 * 288 * 2;
constexpr size_t OFF_W_OCONV = OFF_W_OMLA + (size_t)1024 * 512 * 2;
constexpr size_t OFF_W_OMEM = OFF_W_OCONV + (size_t)1024 * 512 * 2;
constexpr size_t OFF_W_MEMK = OFF_W_OMEM + (size_t)1024 * 512 * 2;
constexpr size_t OFF_W_MEMV = OFF_W_MEMK + (size_t)512 * 1024 * 2;
constexpr size_t OFF_MK = OFF_W_MEMV + (size_t)512 * 1024 * 2;
constexpr size_t OFF_MVT = OFF_MK + (size_t)1536 * 512 * 2;
constexpr size_t OFF_ROPE = OFF_MVT + (size_t)1536 * 512 * 2;
constexpr size_t OFF_RSQ = OFF_ROPE + (size_t)8192 * 16 * 2 * 4;
constexpr size_t OFF_RSKV = OFF_RSQ + (size_t)NTOK * 4;
constexpr size_t OFF_RS1 = OFF_RSKV + (size_t)NTOK * 4;
constexpr size_t OFF_RS0 = OFF_RS1 + (size_t)NTOK * 4;
constexpr size_t OFF_MN = OFF_RS0 + (size_t)NTOK * 4;
constexpr size_t OFF_ACT = OFF_MN + (size_t)1536 * 1024 * 2;
constexpr size_t OFF_XQ = OFF_ACT;
constexpr size_t OFF_CQ = OFF_XQ + (size_t)NTOK * 512 * 2;
constexpr size_t OFF_CKV = OFF_CQ + (size_t)NTOK * 384 * 2;
constexpr size_t OFF_Q = OFF_CKV + (size_t)NTOK * 288 * 2;
constexpr size_t OFF_K = OFF_Q + (size_t)NTOK * 768 * 2;
constexpr size_t OFF_VT = OFF_K + (size_t)NTOK * 768 * 2;
constexpr size_t WS_NEEDED = OFF_VT + (size_t)NTOK * 512 * 2;
constexpr size_t WS_SIZE = (size_t)256 * 1024 * 1024;
constexpr size_t OFF_HID = OFF_ACT;
constexpr size_t OFF_AO = OFF_CQ;
constexpr size_t OFF_CB = OFF_Q;
constexpr size_t OFF_U = OFF_CB + (size_t)NTOK * 512 * 2;
constexpr size_t OFF_MERGED = OFF_U + (size_t)NTOK * 512 * 2;
constexpr size_t OFF_X2B = OFF_W2DN + SZ_W_FFNDN;
constexpr size_t OFF_BAR = WS_SIZE - 16384;
constexpr size_t OFF_HID2 = OFF_BAR - (size_t)NTOK * 2816 * 2;
static_assert(OFF_HID + (size_t)NTOK * 2816 * 2 <= WS_SIZE, "hid");
static_assert(OFF_AO + (size_t)NTOK * 512 * 2 <= OFF_Q, "ao");
static_assert(OFF_MERGED + (size_t)NTOK * 1024 * 2 <= WS_NEEDED, "merged");
static_assert(WS_NEEDED <= OFF_BAR && OFF_HID + (size_t)NTOK * 2816 * 2 <= OFF_BAR, "ws");
static_assert(OFF_X2B + (size_t)NTOK * 1024 * 2 <= OFF_HID2, "x2b");
static_assert(OFF_X2B + (size_t)NTOK * 1024 * 2 <= OFF_MERGED, "x2b/merged");
constexpr size_t D1_STILE = D1_RS2 + (size_t)NTOK * 4;
static_assert(D1_STILE + (size_t)256 * 131072 <= 2 * D1_OFF, "d1");

constexpr int TILE_BYTES = 128 * 144;
constexpr int SM_A = 0, SM_B = 2 * TILE_BYTES, SM_RSS = 4 * TILE_BYTES, SM_XCH = SM_RSS + 512, SM_TOTAL = SM_XCH + 1024;

struct Params {
    const float *xp, *xs, *memp, *mems;
    const float *ffn1_norm, *ffn1_gu, *ffn1_down, *mix_norm, *w_in, *q_lora_norm, *w_uq, *kv_lora_norm, *w_uk, *w_uv;
    const float *mla_q_norm, *mla_k_norm, *w_o_mla, *conv_w, *w_o_conv, *mem_norm, *w_mem_kv, *xa_q_norm, *xa_k_norm;
    const float *w_o_mem, *w_out, *ffn2_norm, *ffn2_gu, *ffn2_down;
    float* out;
    unsigned char* ws;
};

DEVI unsigned pk2(float lo, float hi) { f32x2n v = {lo, hi}; bf16x2n b = __builtin_convertvector(v, bf16x2n); return __builtin_bit_cast(unsigned, b); }
DEVI float bflo(unsigned w) { return __uint_as_float(w << 16); }
DEVI float bfhi(unsigned w) { return __uint_as_float(w & 0xffff0000u); }
DEVI void st_bf4(bf16_t* p, f32x4 v) { uint2 w; w.x = pk2(v[0], v[1]); w.y = pk2(v[2], v[3]); *(uint2*)p = w; }
DEVI f32x4 ld_bf4(const bf16_t* p) { uint2 w = *(const uint2*)p; f32x4 r = {bflo(w.x), bfhi(w.x), bflo(w.y), bfhi(w.y)}; return r; }
DEVI f32x4 ld_f4(const float* p) { float4 t = *(const float4*)p; f32x4 r = {t.x, t.y, t.z, t.w}; return r; }
DEVI float dot4(f32x4 v) { return v[0] * v[0] + v[1] * v[1] + v[2] * v[2] + v[3] * v[3]; }
DEVI float sigm(float x) { return __builtin_amdgcn_rcpf(1.f + __expf(-x)); }
DEVI int tok_pos(int tok) { return tok < 16384 ? (tok & 8191) : (tok & 4095); }
DEVI float red4q(float s) { s += __shfl_xor(s, 16); s += __shfl_xor(s, 32); return s; }

template <bool AF32>
DEVI void gemm_tile(f32x4 (&acc)[4][4], const void* Aptr, int lda, const bf16_t* Bptr, int ldb, int nk, unsigned char* smem) {
    int tid_ = threadIdx.x & 255; asm volatile("" : "+v"(tid_)); const int tid = tid_, lane = tid & 63, wid = tid >> 6, wr = wid >> 1, wc = wid & 1, fr = lane & 15, fq = lane >> 4;
    float4 af[8]; uint4 ab[4]; uint4 bb[4]; float ss[8];
#pragma unroll
    for (int i = 0; i < 8; ++i) ss[i] = 0.f;
    const float* Af = (const float*)Aptr + (size_t)(tid >> 4) * lda + (tid & 15) * 4;
    const bf16_t* Ab = (const bf16_t*)Aptr + (size_t)(tid >> 3) * lda + (tid & 7) * 8;
    const bf16_t* Bb = Bptr + (size_t)(tid >> 3) * ldb + (tid & 7) * 8;
    const int awf = (tid >> 4) * 144 + (tid & 15) * 8;
    const int awb = (tid >> 3) * 144 + (tid & 7) * 16;
    const int aro = (wr * 64 + fr) * 144 + fq * 16;
    const int bro = (wc * 64 + fr) * 144 + fq * 16;
#define GT_LOAD(kt) do { \
        if (AF32) { _Pragma("unroll") for (int i = 0; i < 8; ++i) af[i] = *(const float4*)(Af + (size_t)(16 * i) * lda + (kt) * 64); } \
        else      { _Pragma("unroll") for (int i = 0; i < 4; ++i) ab[i] = *(const uint4*)(Ab + (size_t)(32 * i) * lda + (kt) * 64); } \
        _Pragma("unroll") for (int i = 0; i < 4; ++i) bb[i] = *(const uint4*)(Bb + (size_t)(32 * i) * ldb + (kt) * 64); } while (0)
#define GT_STORE(buf) do { \
        unsigned char* As_ = smem + SM_A + (buf) * TILE_BYTES; unsigned char* Bs_ = smem + SM_B + (buf) * TILE_BYTES; \
        if (AF32) { _Pragma("unroll") for (int i = 0; i < 8; ++i) { float4 v = af[i]; ss[i] += v.x * v.x + v.y * v.y + v.z * v.z + v.w * v.w; \
                        uint2 w; w.x = pk2(v.x, v.y); w.y = pk2(v.z, v.w); *(uint2*)(As_ + awf + i * 16 * 144) = w; } } \
        else      { _Pragma("unroll") for (int i = 0; i < 4; ++i) *(uint4*)(As_ + awb + i * 32 * 144) = ab[i]; } \
        _Pragma("unroll") for (int i = 0; i < 4; ++i) *(uint4*)(Bs_ + awb + i * 32 * 144) = bb[i]; } while (0)
    GT_LOAD(0);
    GT_STORE(0);
    __syncthreads();
    for (int kt = 0; kt < nk; ++kt) {
        const bool more = kt + 1 < nk;
        if (more) GT_LOAD(kt + 1);
        const unsigned char* As = smem + SM_A + (kt & 1) * TILE_BYTES;
        const unsigned char* Bs = smem + SM_B + (kt & 1) * TILE_BYTES;
#pragma unroll
        for (int ks = 0; ks < 2; ++ks) {
            bf16x8 a[4], b[4];
#pragma unroll
            for (int m = 0; m < 4; ++m) a[m] = *(const bf16x8*)(As + aro + m * 16 * 144 + ks * 64);
#pragma unroll
            for (int n = 0; n < 4; ++n) b[n] = *(const bf16x8*)(Bs + bro + n * 16 * 144 + ks * 64);
#pragma unroll
            for (int m = 0; m < 4; ++m)
#pragma unroll
                for (int n = 0; n < 4; ++n) acc[m][n] = __builtin_amdgcn_mfma_f32_16x16x32_bf16(b[n], a[m], acc[m][n], 0, 0, 0);
        }
        if (more) GT_STORE((kt + 1) & 1);
        __syncthreads();
    }
    if (AF32) {
        float* rowss = (float*)(smem + SM_RSS);
#pragma unroll
        for (int i = 0; i < 8; ++i) {
            float s = ss[i];
            s += __shfl_xor(s, 1); s += __shfl_xor(s, 2); s += __shfl_xor(s, 4); s += __shfl_xor(s, 8);
            if ((tid & 15) == 0) rowss[(tid >> 4) + 16 * i] = s;
        }
        __syncthreads();
    }
#undef GT_LOAD
#undef GT_STORE
}
DEVI void zero_acc(f32x4 (&acc)[4][4]) {
#pragma unroll
    for (int m = 0; m < 4; ++m)
#pragma unroll
        for (int n = 0; n < 4; ++n) acc[m][n] = (f32x4){0.f, 0.f, 0.f, 0.f};
}
DEVI void tile_row_ss(const f32x4 (&acc)[4][4], float (&tot)[4], unsigned char* smem, int wr, int wc, int fr, int fq) {
    float* xch = (float*)(smem + SM_XCH);
#pragma unroll
    for (int m = 0; m < 4; ++m) {
        float s = 0.f;
#pragma unroll
        for (int n = 0; n < 4; ++n) s += dot4(acc[m][n]);
        s = red4q(s);
        if (fq == 0) xch[wc * 128 + wr * 64 + m * 16 + fr] = s;
    }
    __syncthreads();
#pragma unroll
    for (int m = 0; m < 4; ++m) { const int r = wr * 64 + m * 16 + fr; tot[m] = xch[r] + xch[128 + r]; }
}


enum { KD_ID = 0, KD_GU, KD_IN1, KD_IN2, KD_UK };
struct WSpec { const float* src; const float* gain; bf16_t* dst; int src_ld, K, Np, kind, coff, dld; };
DEVI int map_col(int kind, int coff, int np) {
    const int c2 = np & 255, pr = (c2 >> 7) * 64 + ((c2 >> 5) & 3) * 16 + (c2 & 15), n = (c2 >> 4) & 1;
    switch (kind) {
        case KD_GU: return n * 2816 + (np >> 8) * 128 + pr;
        case KD_IN1: return np < 672 ? np : (np < 768 ? -1 : 2208 + (np - 768));
        case KD_IN2: return np < 512 ? 672 + np : 1184 + n * 512 + ((np >> 8) - 2) * 128 + pr;
        case KD_UK: return ((np >> 8) * 4 + ((c2 >> 5) & 3)) * 64 + (c2 >> 7) * 32 + n * 16 + (c2 & 15);
        default: return coff + np;
    }
}
DEVI WSpec get_spec(const Params& p, int id) {
    unsigned char* ws = p.ws; unsigned char* d1 = (unsigned char*)p.out; WSpec s;
    switch (id) {
        case 0: s = {p.ffn1_gu, p.ffn1_norm, (bf16_t*)(ws + OFF_W1GU), 5632, 1024, 5632, KD_GU, 0, 1024}; break;
        case 1: s = {p.ffn1_down, nullptr, (bf16_t*)(ws + OFF_W1DN), 1024, 2816, 1024, KD_ID, 0, 2816}; break;
        case 2: s = {p.w_in, p.mix_norm, (bf16_t*)(ws + OFF_W_IN1), 5792, 1024, 1280, KD_IN1, 0, 1024}; break;
        case 3: s = {p.w_in, p.mix_norm, (bf16_t*)(ws + OFF_W_IN2), 5792, 1024, 1536, KD_IN2, 0, 1024}; break;
        case 4: s = {p.w_in, p.mix_norm, (bf16_t*)(ws + OFF_W_GATE), 5792, 1024, 3072, KD_ID, 2720, 1024}; break;
        case 5: s = {p.w_uq, p.q_lora_norm, (bf16_t*)(ws + OFF_W_UQ), 768, 384, 768, KD_ID, 0, 384}; break;
        case 6: s = {p.w_uk, p.kv_lora_norm, (bf16_t*)(ws + OFF_W_UK), 512, 256, 512, KD_UK, 0, 288}; break;
        case 7: s = {p.w_uv, p.kv_lora_norm, (bf16_t*)(ws + OFF_W_UV), 512, 256, 512, KD_ID, 0, 288}; break;
        case 8: s = {p.w_o_mla, nullptr, (bf16_t*)(ws + OFF_W_OMLA), 1024, 512, 1024, KD_ID, 0, 512}; break;
        case 9: s = {p.w_o_conv, nullptr, (bf16_t*)(ws + OFF_W_OCONV), 1024, 512, 1024, KD_ID, 0, 512}; break;
        case 10: s = {p.w_o_mem, nullptr, (bf16_t*)(ws + OFF_W_OMEM), 1024, 512, 1024, KD_ID, 0, 512}; break;
        case 11: s = {p.w_mem_kv, p.mem_norm, (bf16_t*)(ws + OFF_W_MEMK), 1024, 1024, 512, KD_ID, 0, 1024}; break;
        case 12: s = {p.w_mem_kv, p.mem_norm, (bf16_t*)(ws + OFF_W_MEMV), 1024, 1024, 512, KD_ID, 512, 1024}; break;
        case 13: s = {p.w_out, nullptr, (bf16_t*)(d1 + D1_WOUT), 1024, 1024, 1024, KD_ID, 0, 1024}; break;
        case 14: s = {p.ffn2_gu, p.ffn2_norm, (bf16_t*)(d1 + D1_W2GU), 5632, 1024, 5632, KD_GU, 0, 1024}; break;
        default: s = {p.ffn2_down, nullptr, (bf16_t*)(ws + OFF_W2DN), 1024, 2816, 1024, KD_ID, 0, 2816}; break;
    }
    return s;
}
DEVI void convert_spec(const WSpec& s, unsigned char* smem, int bid, int G, int tid, int& base) {
    float* T = (float*)smem;
    const int nkt = s.K >> 6, ntiles = (s.Np >> 6) * nkt;
    int first = (bid - base) % G; if (first < 0) first += G;
    base += ntiles;
    for (int t = first; t < ntiles; t += G) {
        const int n0 = (t / nkt) << 6, k0 = (t % nkt) << 6;
        const int c4 = (tid & 15) * 4, col = map_col(s.kind, s.coff, n0 + c4);
#pragma unroll
        for (int i = 0; i < 4; ++i) {
            const int r = (tid >> 4) + 16 * i;
            float4 v = make_float4(0.f, 0.f, 0.f, 0.f);
            if (col >= 0) { v = *(const float4*)(s.src + (size_t)(k0 + r) * s.src_ld + col); if (s.gain) { const float g = s.gain[k0 + r]; v.x *= g; v.y *= g; v.z *= g; v.w *= g; } }
            T[r * 65 + c4] = v.x; T[r * 65 + c4 + 1] = v.y; T[r * 65 + c4 + 2] = v.z; T[r * 65 + c4 + 3] = v.w;
        }
        __syncthreads();
#pragma unroll
        for (int i = 0; i < 2; ++i) {
            const int idx = tid + 256 * i, cn = idx >> 3, kc = idx & 7;
            uint4 w;
            w.x = pk2(T[(kc * 8 + 0) * 65 + cn], T[(kc * 8 + 1) * 65 + cn]);
            w.y = pk2(T[(kc * 8 + 2) * 65 + cn], T[(kc * 8 + 3) * 65 + cn]);
            w.z = pk2(T[(kc * 8 + 4) * 65 + cn], T[(kc * 8 + 5) * 65 + cn]);
            w.w = pk2(T[(kc * 8 + 6) * 65 + cn], T[(kc * 8 + 7) * 65 + cn]);
            *(uint4*)(s.dst + (size_t)(n0 + cn) * s.dld + k0 + kc * 8) = w;
        }
        __syncthreads();
    }
}

template <int DQK, int DV, bool PIPE, bool QNORM>
DEVI void attn_item(const float* qgain, float qscale, const bf16_t* Qp, int q_rs, const bf16_t* Kp, int k_rs, const bf16_t* Vtp, int vt_rs, int nkeys, bf16_t* Op, int o_rs, unsigned char* smem) {
    constexpr int KROW = (DQK + 8) * 2, VROW = 136, KT_BYTES = 64 * KROW, VT_BYTES = DV * VROW, STAGE = KT_BYTES + VT_BYTES;
    constexpr int KCH = DQK / 8, NKC = 64 * KCH / 256, NVC = DV * 8 / 256, NKK = DQK / 16, NDB = DV / 32;
    static_assert(2 * STAGE <= SM_TOTAL, "attn lds");
    int tid_ = threadIdx.x & 255; asm volatile("" : "+v"(tid_)); const int tid = tid_, lane = tid & 63, wid = tid >> 6, ql = lane & 31, half = lane >> 5;
    __syncthreads();
    bf16x8 qf[NKK];
    {
        const bf16_t* qrow = Qp + (size_t)(wid * 32 + ql) * q_rs + half * 8;
#pragma unroll
        for (int kk = 0; kk < NKK; ++kk) qf[kk] = *(const bf16x8*)(qrow + kk * 16);
    }
    if (QNORM) {
        float ss = 0.f;
#pragma unroll
        for (int kk = 0; kk < NKK; ++kk) { const uint4 w = __builtin_bit_cast(uint4, qf[kk]);
            ss += bflo(w.x) * bflo(w.x) + bfhi(w.x) * bfhi(w.x) + bflo(w.y) * bflo(w.y) + bfhi(w.y) * bfhi(w.y) + bflo(w.z) * bflo(w.z) + bfhi(w.z) * bfhi(w.z) + bflo(w.w) * bflo(w.w) + bfhi(w.w) * bfhi(w.w); }
        ss += __shfl_xor(ss, 32);
        const float inv = rsqrtf(ss * (1.f / DQK) + EPS) * qscale;
#pragma unroll
        for (int kk = 0; kk < NKK; ++kk) { const uint4 w = __builtin_bit_cast(uint4, qf[kk]);
            const f32x4 g0 = ld_f4(qgain + kk * 16 + half * 8), g1 = ld_f4(qgain + kk * 16 + half * 8 + 4); uint4 o;
            o.x = pk2(bflo(w.x) * inv * g0[0], bfhi(w.x) * inv * g0[1]); o.y = pk2(bflo(w.y) * inv * g0[2], bfhi(w.y) * inv * g0[3]);
            o.z = pk2(bflo(w.z) * inv * g1[0], bfhi(w.z) * inv * g1[1]); o.w = pk2(bflo(w.w) * inv * g1[2], bfhi(w.w) * inv * g1[3]);
            qf[kk] = __builtin_bit_cast(bf16x8, o); }
    }
    f32x16 accO[NDB];
#pragma unroll
    for (int db = 0; db < NDB; ++db)
#pragma unroll
        for (int r = 0; r < 16; ++r) accO[db][r] = 0.f;
    float m_run = -INFINITY, l_run = 0.f;
    uint4 kreg[NKC], vreg[NVC];
#define AT_LOAD(t) do { const int s0_ = (t) * 64; \
        _Pragma("unroll") for (int i = 0; i < NKC; ++i) { const int c = tid + 256 * i, row = c / KCH, kc = c % KCH; kreg[i] = *(const uint4*)(Kp + (size_t)(s0_ + row) * k_rs + kc * 8); } \
        _Pragma("unroll") for (int i = 0; i < NVC; ++i) { const int c = tid + 256 * i, d = c >> 3, kc = c & 7; vreg[i] = *(const uint4*)(Vtp + (size_t)d * vt_rs + s0_ + kc * 8); } } while (0)
#define AT_STORE(buf) do { unsigned char* Ks_ = smem + (buf) * STAGE; unsigned char* Vs_ = Ks_ + KT_BYTES; \
        _Pragma("unroll") for (int i = 0; i < NKC; ++i) { const int c = tid + 256 * i, row = c / KCH, kc = c % KCH; *(uint4*)(Ks_ + row * KROW + kc * 16) = kreg[i]; } \
        _Pragma("unroll") for (int i = 0; i < NVC; ++i) { const int c = tid + 256 * i, d = c >> 3, kc = c & 7; uint2 lo_, hi_; lo_.x = vreg[i].x; lo_.y = vreg[i].y; hi_.x = vreg[i].z; hi_.y = vreg[i].w; \
            *(uint2*)(Vs_ + d * VROW + kc * 16) = lo_; *(uint2*)(Vs_ + d * VROW + kc * 16 + 8) = hi_; } } while (0)
    const int nt = nkeys >> 6;
    if (PIPE) { AT_LOAD(0); AT_STORE(0); __syncthreads(); }
    for (int t = 0; t < nt; ++t) {
        const bool more = PIPE && (t + 1 < nt);
        if (PIPE) { if (more) AT_LOAD(t + 1); }
        else { AT_LOAD(t); AT_STORE(t & 1); __syncthreads(); }
        const unsigned char* Ks = smem + (t & 1) * STAGE;
        const unsigned char* Vs = Ks + KT_BYTES;
        f32x16 s[2];
#pragma unroll
        for (int kb = 0; kb < 2; ++kb) {
#pragma unroll
            for (int r = 0; r < 16; ++r) s[kb][r] = 0.f;
#pragma unroll
            for (int kk = 0; kk < NKK; ++kk) {
                const bf16x8 kf = *(const bf16x8*)(Ks + (kb * 32 + ql) * KROW + kk * 32 + half * 16);
                s[kb] = __builtin_amdgcn_mfma_f32_32x32x16_bf16(kf, qf[kk], s[kb], 0, 0, 0);
            }
        }
        float mx = s[0][0];
#pragma unroll
        for (int r = 1; r < 16; ++r) mx = fmaxf(mx, s[0][r]);
#pragma unroll
        for (int r = 0; r < 16; ++r) mx = fmaxf(mx, s[1][r]);
        mx = fmaxf(mx, __shfl_xor(mx, 32));
        const float m_new = fmaxf(m_run, mx);
        const float alpha = __builtin_amdgcn_exp2f(m_run - m_new);
        m_run = m_new;
        float psum = 0.f;
#pragma unroll
        for (int kb = 0; kb < 2; ++kb)
#pragma unroll
            for (int r = 0; r < 16; ++r) { const float pv = __builtin_amdgcn_exp2f(s[kb][r] - m_new); s[kb][r] = pv; psum += pv; }
        l_run = l_run * alpha + psum;
#pragma unroll
        for (int db = 0; db < NDB; ++db)
#pragma unroll
            for (int r = 0; r < 16; ++r) accO[db][r] *= alpha;
#pragma unroll
        for (int kb = 0; kb < 2; ++kb)
#pragma unroll
            for (int p2 = 0; p2 < 2; ++p2) {
                uint4 pw;
                pw.x = pk2(s[kb][8 * p2 + 0], s[kb][8 * p2 + 1]); pw.y = pk2(s[kb][8 * p2 + 2], s[kb][8 * p2 + 3]);
                pw.z = pk2(s[kb][8 * p2 + 4], s[kb][8 * p2 + 5]); pw.w = pk2(s[kb][8 * p2 + 6], s[kb][8 * p2 + 7]);
                const bf16x8 pf = __builtin_bit_cast(bf16x8, pw);
#pragma unroll
                for (int db = 0; db < NDB; ++db) {
                    const unsigned char* vp = Vs + (db * 32 + ql) * VROW + (kb * 32 + 16 * p2 + half * 4) * 2;
                    const uint2 vlo = *(const uint2*)vp, vhi = *(const uint2*)(vp + 16);
                    uint4 vw; vw.x = vlo.x; vw.y = vlo.y; vw.z = vhi.x; vw.w = vhi.y;
                    accO[db] = __builtin_amdgcn_mfma_f32_32x32x16_bf16(__builtin_bit_cast(bf16x8, vw), pf, accO[db], 0, 0, 0);
                }
            }
        if (PIPE) { if (more) AT_STORE((t + 1) & 1); __syncthreads(); }
    }
#undef AT_LOAD
#undef AT_STORE
    const float l = l_run + __shfl_xor(l_run, 32);
    const float inv = 1.f / l;
    bf16_t* orow = Op + (size_t)(wid * 32 + ql) * o_rs + half * 4;
#pragma unroll
    for (int db = 0; db < NDB; ++db)
#pragma unroll
        for (int g = 0; g < 4; ++g) {
            f32x4 v = {accO[db][4 * g] * inv, accO[db][4 * g + 1] * inv, accO[db][4 * g + 2] * inv, accO[db][4 * g + 3] * inv};
            st_bf4(orow + db * 32 + 8 * g, v);
        }
}


DEVI void attn_mla_item(const float* gq, const float* ROPEp, int pos0, const bf16_t* Qp, const bf16_t* Kp, const bf16_t* Vtp, int vt_rs, int nkeys, bf16_t* Op, unsigned char* smem, int tx) {
    constexpr int KROW = 208, VROW = 264, KT_BYTES = 128 * KROW, VT_BYTES = 64 * VROW, STAGE = KT_BYTES + VT_BYTES;
    static_assert(2 * STAGE <= 2 * SM_TOTAL, "attn lds");
    const int lane = tx & 63, wid = tx >> 6, ql = lane & 31, half = lane >> 5;
    __syncthreads();
    bf16x8 qf[6];
    {
        const bf16_t* qrow = Qp + (size_t)(wid * 32 + ql) * 768 + half * 8;
#pragma unroll
        for (int kk = 0; kk < 6; ++kk) qf[kk] = *(const bf16x8*)(qrow + kk * 16);
    }
    {
        float ss = 0.f;
#pragma unroll
        for (int kk = 0; kk < 6; ++kk) { const uint4 w = __builtin_bit_cast(uint4, qf[kk]);
            ss += bflo(w.x) * bflo(w.x) + bfhi(w.x) * bfhi(w.x) + bflo(w.y) * bflo(w.y) + bfhi(w.y) * bfhi(w.y) + bflo(w.z) * bflo(w.z) + bfhi(w.z) * bfhi(w.z) + bflo(w.w) * bflo(w.w) + bfhi(w.w) * bfhi(w.w); }
        ss += __shfl_xor(ss, 32);
        const float inv = rsqrtf(ss * (1.f / 96.f) + EPS) * QSCALE_MLA;
#pragma unroll
        for (int kk = 0; kk < 4; ++kk) { const uint4 w = __builtin_bit_cast(uint4, qf[kk]);
            const f32x4 g0 = ld_f4(gq + kk * 16 + half * 8), g1 = ld_f4(gq + kk * 16 + half * 8 + 4); uint4 o;
            o.x = pk2(bflo(w.x) * inv * g0[0], bfhi(w.x) * inv * g0[1]); o.y = pk2(bflo(w.y) * inv * g0[2], bfhi(w.y) * inv * g0[3]);
            o.z = pk2(bflo(w.z) * inv * g1[0], bfhi(w.z) * inv * g1[1]); o.w = pk2(bflo(w.w) * inv * g1[2], bfhi(w.w) * inv * g1[3]);
            qf[kk] = __builtin_bit_cast(bf16x8, o); }
        const uint4 wa = __builtin_bit_cast(uint4, qf[4]), wb = __builtin_bit_cast(uint4, qf[5]);
        const float* rp = ROPEp + ((size_t)(pos0 + wid * 32 + ql) * 16 + half * 8) * 2;
        const float* ga = gq + 64 + half * 8; const float* gb = gq + 80 + half * 8;
        float x1[8] = {bflo(wa.x), bfhi(wa.x), bflo(wa.y), bfhi(wa.y), bflo(wa.z), bfhi(wa.z), bflo(wa.w), bfhi(wa.w)};
        float x2[8] = {bflo(wb.x), bfhi(wb.x), bflo(wb.y), bfhi(wb.y), bflo(wb.z), bfhi(wb.z), bflo(wb.w), bfhi(wb.w)};
        float r1[8], r2[8];
#pragma unroll
        for (int q4 = 0; q4 < 2; ++q4) {
            const f32x4 g1v = ld_f4(ga + q4 * 4), g2v = ld_f4(gb + q4 * 4), csA = ld_f4(rp + q4 * 8), csB = ld_f4(rp + q4 * 8 + 4);
            const float co[4] = {csA[0], csA[2], csB[0], csB[2]}, si[4] = {csA[1], csA[3], csB[1], csB[3]};
#pragma unroll
            for (int j = 0; j < 4; ++j) { const float a = x1[q4 * 4 + j] * inv * g1v[j], b = x2[q4 * 4 + j] * inv * g2v[j]; r1[q4 * 4 + j] = a * co[j] - b * si[j]; r2[q4 * 4 + j] = b * co[j] + a * si[j]; }
        }
        uint4 oa, ob;
        oa.x = pk2(r1[0], r1[1]); oa.y = pk2(r1[2], r1[3]); oa.z = pk2(r1[4], r1[5]); oa.w = pk2(r1[6], r1[7]);
        ob.x = pk2(r2[0], r2[1]); ob.y = pk2(r2[2], r2[3]); ob.z = pk2(r2[4], r2[5]); ob.w = pk2(r2[6], r2[7]);
        qf[4] = __builtin_bit_cast(bf16x8, oa); qf[5] = __builtin_bit_cast(bf16x8, ob);
    }
    f32x16 accO[2];
#pragma unroll
    for (int db = 0; db < 2; ++db)
#pragma unroll
        for (int r = 0; r < 16; ++r) accO[db][r] = 0.f;
    float m_run = -INFINITY, l_run = 0.f;
    uint4 kreg[3], vreg[2];
#define AM_LOAD(t) do { const int s0_ = (t) * 128; \
        _Pragma("unroll") for (int i = 0; i < 3; ++i) { const int c = tx + 512 * i, row = c / 12, kc = c % 12; kreg[i] = *(const uint4*)(Kp + (size_t)(s0_ + row) * 768 + kc * 8); } \
        _Pragma("unroll") for (int i = 0; i < 2; ++i) { const int c = tx + 512 * i, d = c >> 4, kc = c & 15; vreg[i] = *(const uint4*)(Vtp + (size_t)d * vt_rs + s0_ + kc * 8); } } while (0)
#define AM_STORE(buf) do { unsigned char* Ks_ = smem + (buf) * STAGE; unsigned char* Vs_ = Ks_ + KT_BYTES; \
        _Pragma("unroll") for (int i = 0; i < 3; ++i) { const int c = tx + 512 * i, row = c / 12, kc = c % 12; *(uint4*)(Ks_ + row * KROW + kc * 16) = kreg[i]; } \
        _Pragma("unroll") for (int i = 0; i < 2; ++i) { const int c = tx + 512 * i, d = c >> 4, kc = c & 15; uint2 lo_, hi_; lo_.x = vreg[i].x; lo_.y = vreg[i].y; hi_.x = vreg[i].z; hi_.y = vreg[i].w; \
            *(uint2*)(Vs_ + d * VROW + kc * 16) = lo_; *(uint2*)(Vs_ + d * VROW + kc * 16 + 8) = hi_; } } while (0)
    const int nt = nkeys >> 7;
    AM_LOAD(0); AM_STORE(0); __syncthreads();
    for (int t = 0; t < nt; ++t) {
        const bool more = t + 1 < nt;
        if (more) AM_LOAD(t + 1);
        const unsigned char* Ks = smem + (t & 1) * STAGE;
        const unsigned char* Vs = Ks + KT_BYTES;
        f32x16 s[4];
#pragma unroll
        for (int kb = 0; kb < 4; ++kb)
#pragma unroll
            for (int r = 0; r < 16; ++r) s[kb][r] = 0.f;
#pragma unroll
        for (int kk = 0; kk < 6; ++kk)
#pragma unroll
            for (int kb = 0; kb < 4; ++kb) {
                const bf16x8 kf = *(const bf16x8*)(Ks + (kb * 32 + ql) * KROW + kk * 32 + half * 16);
                s[kb] = __builtin_amdgcn_mfma_f32_32x32x16_bf16(kf, qf[kk], s[kb], 0, 0, 0);
            }
        float mx = -INFINITY;
#pragma unroll
        for (int kb = 0; kb < 4; ++kb)
#pragma unroll
            for (int r = 0; r < 16; r += 2) mx = fmaxf(fmaxf(mx, s[kb][r]), s[kb][r + 1]);
        mx = fmaxf(mx, __shfl_xor(mx, 32));
        const float m_new = fmaxf(m_run, mx);
        if (__any(m_new > m_run)) {
            const float alpha = __builtin_amdgcn_exp2f(m_run - m_new);
            l_run *= alpha;
#pragma unroll
            for (int db = 0; db < 2; ++db)
#pragma unroll
                for (int r = 0; r < 16; ++r) accO[db][r] *= alpha;
        }
        m_run = m_new;
        float psum = 0.f;
#pragma unroll
        for (int kb = 0; kb < 4; ++kb)
#pragma unroll
            for (int r = 0; r < 16; ++r) { const float pv = __builtin_amdgcn_exp2f(s[kb][r] - m_new); s[kb][r] = pv; psum += pv; }
        l_run += psum;
#pragma unroll
        for (int kb = 0; kb < 4; ++kb)
#pragma unroll
            for (int p2 = 0; p2 < 2; ++p2) {
                uint4 pw;
                pw.x = pk2(s[kb][8 * p2 + 0], s[kb][8 * p2 + 1]); pw.y = pk2(s[kb][8 * p2 + 2], s[kb][8 * p2 + 3]);
                pw.z = pk2(s[kb][8 * p2 + 4], s[kb][8 * p2 + 5]); pw.w = pk2(s[kb][8 * p2 + 6], s[kb][8 * p2 + 7]);
                const bf16x8 pf = __builtin_bit_cast(bf16x8, pw);
#pragma unroll
                for (int db = 0; db < 2; ++db) {
                    const unsigned char* vp = Vs + (db * 32 + ql) * VROW + (kb * 32 + 16 * p2 + half * 4) * 2;
                    const uint2 vlo = *(const uint2*)vp, vhi = *(const uint2*)(vp + 16);
                    uint4 vw; vw.x = vlo.x; vw.y = vlo.y; vw.z = vhi.x; vw.w = vhi.y;
                    accO[db] = __builtin_amdgcn_mfma_f32_32x32x16_bf16(__builtin_bit_cast(bf16x8, vw), pf, accO[db], 0, 0, 0);
                }
            }
        if (more) AM_STORE((t + 1) & 1);
        __syncthreads();
    }
#undef AM_LOAD
#undef AM_STORE
    const float l = l_run + __shfl_xor(l_run, 32);
    const float inv = 1.f / l;
    bf16_t* orow = Op + (size_t)(wid * 32 + ql) * 512 + half * 4;
#pragma unroll
    for (int db = 0; db < 2; ++db)
#pragma unroll
        for (int g = 0; g < 4; ++g) {
            f32x4 v = {accO[db][4 * g] * inv, accO[db][4 * g + 1] * inv, accO[db][4 * g + 2] * inv, accO[db][4 * g + 3] * inv};
            st_bf4(orow + db * 32 + 8 * g, v);
        }
}

namespace pg8 {
#define PG8_LAS __attribute__((address_space(3)))
typedef unsigned short bf16_t;
typedef short bf16x8 __attribute__((ext_vector_type(8)));
typedef float f32x4 __attribute__((ext_vector_type(4)));
typedef unsigned u32x4 __attribute__((ext_vector_type(4)));
constexpr int BM = 256, BK = 64, HALF = 128, HTB = HALF * BK * 2  , STAGE_BYTES = 8 * HTB, NXCD = 8, WGM = 8;

__host__ __device__ __forceinline__ int lds_byte(int r, int c) { const int st = (r >> 4) * 2 + (c >> 5), rr = r & 15, cc = c & 31, ob = rr * 64 + cc * 2; return st * 1024 + (ob ^ (((ob >> 9) & 1) << 5)); }
__host__ __device__ __forceinline__ void stage_rc(int b, int& R, int& C) { const int st = b / 1024, sb = b % 1024, swz = sb ^ (((sb >> 9) & 1) << 5); R = (st >> 1) * 16 + swz / 64; C = (st & 1) * 32 + (swz % 64) / 2; }
__host__ __device__ __forceinline__ int perm32(int rho) { const int n = rho >> 4, i = rho & 15; return 8 * (i >> 2) + 4 * n + (i & 3); }

struct Unit { int pm, pn; };
struct Gemm { const bf16_t* A; const bf16_t* Bt; int M, N, K, lda, ldb; size_t kstepA, kstepB; };

struct StaticOrder {
    int nM, nN, nwg, G, c;
    __host__ __device__ void init(int M, int N, int G_, int c_) { nM = M / BM; nN = N / BM; nwg = nM * nN; G = G_; c = c_; }
    __host__ __device__ bool next(int i, Unit& u) const {
        const long L = (long)i * G + c; if (L >= nwg) return false;
        int wgid = (int)L; { const int q = nwg / NXCD, r = nwg % NXCD, xcd = wgid % NXCD, off = wgid / NXCD; wgid = (xcd < r ? xcd * (q + 1) : r * (q + 1) + (xcd - r) * q) + off; }
        const int nig = WGM * nN, gid = wgid / nig, fm = gid * WGM, gsz = (nM - fm) < WGM ? (nM - fm) : WGM;
        u.pm = fm + ((wgid % nig) % gsz); u.pn = (wgid % nig) / gsz; return true;
    }
    __device__ __forceinline__ void a_ready(const Unit&) const {}
    __device__ __forceinline__ void done(const Unit&) const {}
};


DEVI float rs_inv(const float* rs, int row) { return rsqrtf(rs[row] * (1.f / 1024.f) + EPS); }
struct EpiGU {
    static constexpr bool PERM = false, AFTER_DRAIN = false;
    bf16_t* HID; const float* rs;
    __device__ __forceinline__ void operator()(const f32x4 (&acc)[2][2][4][2], const Unit& u, int wr, int wc, int fr, int fq) const {
        asm volatile("" : "+v"(fr), "+v"(fq));
#pragma unroll
        for (int ai = 0; ai < 2; ++ai)
#pragma unroll
            for (int m = 0; m < 4; ++m) {
                const int row = u.pm * BM + ai * HALF + wr * 64 + m * 16 + fr; const float ri = rs_inv(rs, row);
                bf16_t* rowp = HID + ((size_t)(u.pn * 2) * NTOK + (size_t)(u.pm * 2 + ai) * 128) * 64 + ((wr * 4 + m) * 4 + wc) * 256 + fr * 16 + fq * 4;
#pragma unroll
                for (int bj = 0; bj < 2; ++bj) {
                    const f32x4 g = acc[ai][bj][m][0] * ri, up = acc[ai][bj][m][1] * ri; f32x4 h;
#pragma unroll
                    for (int j = 0; j < 4; ++j) h[j] = g[j] * __builtin_amdgcn_rcpf(1.f + __expf(-g[j])) * up[j];
                    ::st_bf4(rowp + (size_t)bj * NTOK * 64, h);
                }
            }
    }
};
template <int RES> struct EpiRes {
    static constexpr bool PERM = false, AFTER_DRAIN = false;
    const float* rf0; const float* rf1; const bf16_t* rb; bf16_t* out; float* rs; float scale;
    __device__ __forceinline__ void operator()(const f32x4 (&acc)[2][2][4][2], const Unit& u, int wr, int wc, int fr, int fq) const {
        asm volatile("" : "+v"(fr), "+v"(fq));
#pragma unroll
        for (int ai = 0; ai < 2; ++ai) {
            const int row0 = u.pm * BM + ai * HALF + wr * 64 + fr, col0 = u.pn * BM + wc * 32 + fq * 4;
            f32x4 r[4][2][2];
#pragma unroll
            for (int m = 0; m < 4; ++m) {
                const int row = row0 + m * 16;
                const float* rp = (row < 16384 ? rf0 + (size_t)row * 1024 : rf1 + (size_t)(row - 16384) * 1024) + col0;
#pragma unroll
                for (int bj = 0; bj < 2; ++bj)
#pragma unroll
                    for (int n = 0; n < 2; ++n) r[m][bj][n] = RES == 0 ? ::ld_f4(rp + bj * HALF + n * 16) : ::ld_bf4(rb + (size_t)row * 1024 + col0 + bj * HALF + n * 16);
            }
#pragma unroll
            for (int m = 0; m < 4; ++m) {
                const int row = row0 + m * 16;
                float ss = 0.f;
#pragma unroll
                for (int bj = 0; bj < 2; ++bj)
#pragma unroll
                    for (int n = 0; n < 2; ++n) {
                        const f32x4 o = r[m][bj][n] + acc[ai][bj][m][n] * scale;
                        ss += ::dot4(o);
                        ::st_bf4(out + (size_t)row * 1024 + col0 + bj * HALF + n * 16, o);
                    }
                ss = ::red4q(ss);
                if (fq == 0) atomicAdd(rs + row, ss);
            }
        }
    }
};
struct EpiFinal {
    static constexpr bool PERM = false, AFTER_DRAIN = false;
    const bf16_t* rb; float* out;
    __device__ __forceinline__ void operator()(const f32x4 (&acc)[2][2][4][2], const Unit& u, int wr, int wc, int fr, int fq) const {
        asm volatile("" : "+v"(fr), "+v"(fq));
#pragma unroll
        for (int ai = 0; ai < 2; ++ai)
#pragma unroll
            for (int m = 0; m < 4; ++m) {
                const size_t off = (size_t)(u.pm * BM + ai * HALF + wr * 64 + m * 16 + fr) * 1024 + u.pn * BM + wc * 32 + fq * 4;
#pragma unroll
                for (int bj = 0; bj < 2; ++bj)
#pragma unroll
                    for (int n = 0; n < 2; ++n) { const f32x4 o = ::ld_bf4(rb + off + bj * HALF + n * 16) + acc[ai][bj][m][n] * 0.5f; *(float4*)(out + off + bj * HALF + n * 16) = make_float4(o[0], o[1], o[2], o[3]); }
            }
    }
};

struct EpiQ {
    static constexpr bool PERM = false, AFTER_DRAIN = false;
    const float* RSQ; bf16_t* Q;
    __device__ __forceinline__ void operator()(const f32x4 (&acc)[2][2][4][2], const Unit& u, int wr, int wc, int fr, int fq) const {
        asm volatile("" : "+v"(fr), "+v"(fq));
#pragma unroll
        for (int ai = 0; ai < 2; ++ai)
#pragma unroll
            for (int m = 0; m < 4; ++m) {
                const int row = u.pm * BM + ai * HALF + wr * 64 + m * 16 + fr; const float ri = rsqrtf(RSQ[row] * (1.f / 384.f) + EPS);
                bf16_t* d = Q + (size_t)row * 768 + u.pn * BM + wc * 32 + fq * 4;
#pragma unroll
                for (int bj = 0; bj < 2; ++bj)
#pragma unroll
                    for (int n = 0; n < 2; ++n) ::st_bf4(d + bj * HALF + n * 16, acc[ai][bj][m][n] * ri);
            }
    }
};
struct EpiK {
    static constexpr bool PERM = false, AFTER_DRAIN = false;
    const float* RSKV; const bf16_t* CKV; const float* gk; const float* ROPE; bf16_t* K;
    __device__ __forceinline__ void operator()(const f32x4 (&acc)[2][2][4][2], const Unit& u, int wr, int wc, int fr, int fq) const {
        asm volatile("" : "+v"(fr), "+v"(fq));
        const int h = u.pn * 4 + wc;
#pragma unroll
        for (int ai = 0; ai < 2; ++ai)
#pragma unroll
            for (int m = 0; m < 4; ++m) {
                const int row = u.pm * BM + ai * HALF + wr * 64 + m * 16 + fr; const float ri = rsqrtf(RSKV[row] * (1.f / 256.f) + EPS);
                f32x4 v[2][2]; float s = 0.f;
#pragma unroll
                for (int bj = 0; bj < 2; ++bj)
#pragma unroll
                    for (int n = 0; n < 2; ++n) { v[bj][n] = acc[ai][bj][m][n] * ri; s += ::dot4(v[bj][n]); }
                const f32x4 kr1 = ::ld_bf4(CKV + (size_t)row * 288 + 256 + fq * 4), kr2 = ::ld_bf4(CKV + (size_t)row * 288 + 272 + fq * 4);
                s += ::dot4(kr1) + ::dot4(kr2);
                s = ::red4q(s);
                const float inv = rsqrtf(s * (1.f / 96.f) + EPS);
                bf16_t* dst = K + ((size_t)row * 8 + h) * 96;
#pragma unroll
                for (int bj = 0; bj < 2; ++bj)
#pragma unroll
                    for (int n = 0; n < 2; ++n) { const int c = bj * 32 + n * 16 + fq * 4; ::st_bf4(dst + c, v[bj][n] * inv * ::ld_f4(gk + c)); }
                const int pos = ::tok_pos(row);
                const f32x4 x1 = kr1 * inv * ::ld_f4(gk + 64 + fq * 4), x2 = kr2 * inv * ::ld_f4(gk + 80 + fq * 4);
                const f32x4 cs0 = ::ld_f4(ROPE + ((size_t)pos * 16 + fq * 4) * 2), cs1 = ::ld_f4(ROPE + ((size_t)pos * 16 + fq * 4) * 2 + 4);
                const f32x4 co = {cs0[0], cs0[2], cs1[0], cs1[2]}, si = {cs0[1], cs0[3], cs1[1], cs1[3]};
                ::st_bf4(dst + 64 + fq * 4, x1 * co - x2 * si);
                ::st_bf4(dst + 80 + fq * 4, x2 * co + x1 * si);
            }
    }
};
struct EpiVt {
    static constexpr bool PERM = false, AFTER_DRAIN = false;
    const float* RSKV; bf16_t* VT;
    __device__ __forceinline__ void operator()(const f32x4 (&acc)[2][2][4][2], const Unit& u, int wr, int wc, int fr, int fq) const {
        asm volatile("" : "+v"(fr), "+v"(fq));
#pragma unroll
        for (int bj = 0; bj < 2; ++bj)
#pragma unroll
            for (int n = 0; n < 2; ++n) {
                const int tok0 = u.pn * BM + bj * HALF + wc * 32 + n * 16 + fq * 4;
                f32x4 ric = ::ld_f4(RSKV + tok0);
#pragma unroll
                for (int j = 0; j < 4; ++j) ric[j] = rsqrtf(ric[j] * (1.f / 256.f) + EPS);
#pragma unroll
                for (int ai = 0; ai < 2; ++ai)
#pragma unroll
                    for (int m = 0; m < 4; ++m) {
                        const int hd = u.pm * BM + ai * HALF + wr * 64 + m * 16 + fr, h = hd >> 6, d = hd & 63;
                        size_t off;
                        if (tok0 < 16384) off = ((size_t)((tok0 >> 13) * 8 + h) * 64 + d) * 8192 + (tok0 & 8191);
                        else { const int tt = tok0 - 16384; off = (size_t)8388608 + ((size_t)((tt >> 12) * 8 + h) * 64 + d) * 4096 + (tt & 4095); }
                        ::st_bf4(VT + off, acc[ai][bj][m][n] * ric);
                    }
            }
    }
};
struct EpiIn1 {
    static constexpr bool PERM = false, AFTER_DRAIN = false;
    const float* rs1; bf16_t* CQ; bf16_t* CKV; bf16_t* XQ; float* RSQ; float* RSKV;
    __device__ __forceinline__ void operator()(const f32x4 (&acc)[2][2][4][2], const Unit& u, int wr, int wc, int fr, int fq) const {
        asm volatile("" : "+v"(fr), "+v"(fq));
#pragma unroll
        for (int bj = 0; bj < 2; ++bj) {
            const int cg = u.pn * BM + bj * HALF + wc * 32;
            bf16_t* dst; int ld, c0; float* rs = nullptr;
            if (cg < 384) { dst = CQ; ld = 384; c0 = cg; rs = RSQ; }
            else if (cg < 640) { dst = CKV; ld = 288; c0 = cg - 384; rs = RSKV; }
            else if (cg < 672) { dst = CKV; ld = 288; c0 = 256 + (cg - 640); }
            else if (cg < 768) continue;
            else { dst = XQ; ld = 512; c0 = cg - 768; }
#pragma unroll
            for (int ai = 0; ai < 2; ++ai)
#pragma unroll
                for (int m = 0; m < 4; ++m) {
                    const int row = u.pm * BM + ai * HALF + wr * 64 + m * 16 + fr; const float ri = rs_inv(rs1, row);
                    const f32x4 v0 = acc[ai][bj][m][0] * ri, v1 = acc[ai][bj][m][1] * ri;
                    ::st_bf4(dst + (size_t)row * ld + c0 + fq * 4, v0); ::st_bf4(dst + (size_t)row * ld + c0 + 16 + fq * 4, v1);
                    if (rs) { const float s = ::red4q(::dot4(v0) + ::dot4(v1)); if (fq == 0) atomicAdd(rs + row, s); }
                }
        }
    }
};
struct EpiIn2 {
    static constexpr bool PERM = false, AFTER_DRAIN = false;
    const float* rs1; bf16_t* CB; bf16_t* U;
    __device__ __forceinline__ void operator()(const f32x4 (&acc)[2][2][4][2], const Unit& u, int wr, int wc, int fr, int fq) const {
        asm volatile("" : "+v"(fr), "+v"(fq));
#pragma unroll
        for (int ai = 0; ai < 2; ++ai)
#pragma unroll
            for (int m = 0; m < 4; ++m) {
                const int row = u.pm * BM + ai * HALF + wr * 64 + m * 16 + fr; const float ri = rs_inv(rs1, row);
#pragma unroll
                for (int bj = 0; bj < 2; ++bj) {
                    const f32x4 v0 = acc[ai][bj][m][0] * ri, v1 = acc[ai][bj][m][1] * ri;
                    if (u.pn < 2) { bf16_t* d = CB + (size_t)row * 512 + u.pn * BM + bj * HALF + wc * 32 + fq * 4; ::st_bf4(d, v0); ::st_bf4(d + 16, v1); }
                    else ::st_bf4(U + (size_t)row * 512 + (u.pn - 2) * 128 + bj * 64 + wc * 16 + fq * 4, v0 * v1);
                }
            }
    }
};
template <class Epi, class Sched, bool ALIGN_EPI = false, bool SP2 = false>
__device__ __forceinline__ void gemm_phase(PG8_LAS unsigned char* lds, const Gemm g, const Sched& S, const Epi& E) {
    int tid_ = threadIdx.x; asm volatile("" : "+v"(tid_));
    const int tid = tid_, wid = __builtin_amdgcn_readfirstlane(tid >> 6), lane = tid & 63, wr = wid >> 2, wc = wid & 3, fr = lane & 15, fq = lane >> 4;
    const int K = g.K, nt = K / BK;
    unsigned voffA[2], voffB[2];
#pragma unroll
    for (int i = 0; i < 2; ++i) { int R, C; stage_rc(tid * 16 + i * 8192, R, C); const int Rb = Epi::PERM ? ((R & ~31) + perm32(R & 31)) : R;
        voffA[i] = g.lda ? (unsigned)(R * g.lda + C) * 2u : (unsigned)(((R >> 4) * 4 + (C >> 4)) * 512 + (R & 15) * 32 + ((C >> 3) & 1) * 16);
        voffB[i] = (unsigned)(Rb * g.ldb + C) * 2u; }
    const size_t kstepA = g.kstepA, kstepB = g.kstepB;
    const size_t hstepA = (size_t)HALF * (g.lda ? g.lda : 64) * 2, hstepB = (size_t)HALF * g.ldb * 2;
    const size_t tstepA = 2 * hstepA, tstepB = 2 * hstepB;
    const unsigned ldsw = (unsigned)wid * 1024u;
    const int aoff = lds_byte(wr * 64 + fr, fq * 8), boff = lds_byte(wc * 32 + fr, fq * 8);
#define PG8_SA(b, h) (((b) * 2 + (h)) * HTB)
#define PG8_SB(b, h) ((4 + (b) * 2 + (h)) * HTB)
#define PG8_STAGE(bufoff, gbase, voff) do { _Pragma("unroll") for (int _i = 0; _i < 2; ++_i) \
        __builtin_amdgcn_global_load_lds((const unsigned*)((const char*)(gbase) + (voff)[_i]), (PG8_LAS unsigned*)(lds + (bufoff) + ldsw + _i * 8192), 16, 0, 0); } while (0)
#define PG8_LDA(dst, b, h) do { _Pragma("unroll") for (int m = 0; m < 4; ++m) _Pragma("unroll") for (int k = 0; k < 2; ++k) dst[m][k] = *(const PG8_LAS bf16x8*)(lds + PG8_SA(b, h) + aoff + m * 2048 + k * 1024); } while (0)
#define PG8_LDB(dst, b, h) do { _Pragma("unroll") for (int n = 0; n < 2; ++n) _Pragma("unroll") for (int k = 0; k < 2; ++k) dst[n][k] = *(const PG8_LAS bf16x8*)(lds + PG8_SB(b, h) + boff + n * 2048 + k * 1024); } while (0)
#define PG8_MMA(ai, bj, At, Bt) do { __builtin_amdgcn_s_setprio(1); _Pragma("unroll") for (int m = 0; m < 4; ++m) _Pragma("unroll") for (int n = 0; n < 2; ++n) _Pragma("unroll") for (int k = 0; k < 2; ++k) \
        acc[ai][bj][m][n] = __builtin_amdgcn_mfma_f32_16x16x32_bf16(Bt[n][k], At[m][k], acc[ai][bj][m][n], 0, 0, 0); __builtin_amdgcn_s_setprio(0); } while (0)
#define PG8_WAIT_V(n) asm volatile("s_waitcnt vmcnt(" #n ")" ::: "memory")
#define PG8_WAIT_L(n) asm volatile("s_waitcnt lgkmcnt(" #n ")" ::: "memory")
#define PG8_BAR __builtin_amdgcn_s_barrier()
#define PG8_SCHED __builtin_amdgcn_sched_barrier(0)
    Unit cur, nxt; int ui = 0;
    if (!S.next(0, cur)) return;
    f32x4 acc[2][2][4][2];
#pragma unroll
    for (int a = 0; a < 2; ++a)
#pragma unroll
        for (int b = 0; b < 2; ++b)
#pragma unroll
            for (int m = 0; m < 4; ++m)
#pragma unroll
                for (int n = 0; n < 2; ++n) acc[a][b][m][n] = (f32x4){0.f, 0.f, 0.f, 0.f};
    bf16x8 At[4][2], B0[2][2], B1[2][2];
    const char* cA = (const char*)g.A + (size_t)cur.pm * tstepA; const char* cB = (const char*)g.Bt + (size_t)cur.pn * tstepB;
    S.a_ready(cur);
    if constexpr (SP2) {
        PG8_STAGE(PG8_SB(0, 0), cB, voffB); PG8_STAGE(PG8_SB(0, 1), cB + hstepB, voffB); PG8_STAGE(PG8_SA(0, 0), cA, voffA); PG8_STAGE(PG8_SA(0, 1), cA + hstepA, voffA);
        if (wr == 1) PG8_BAR;
        PG8_WAIT_V(2); PG8_BAR;
        PG8_STAGE(PG8_SB(1, 0), cB + kstepB, voffB); PG8_STAGE(PG8_SA(1, 0), cA + kstepA, voffA); PG8_STAGE(PG8_SB(1, 1), cB + hstepB + kstepB, voffB);
        PG8_WAIT_V(6); PG8_BAR;
    } else {
        PG8_STAGE(PG8_SB(0, 0), cB, voffB); PG8_STAGE(PG8_SA(0, 0), cA, voffA); PG8_STAGE(PG8_SB(0, 1), cB + hstepB, voffB); PG8_STAGE(PG8_SA(0, 1), cA + hstepA, voffA);
        if (wr == 1) PG8_BAR;
        PG8_WAIT_V(4); PG8_BAR;
        PG8_STAGE(PG8_SB(1, 0), cB + kstepB, voffB); PG8_STAGE(PG8_SA(1, 0), cA + kstepA, voffA); PG8_STAGE(PG8_SB(1, 1), cB + hstepB + kstepB, voffB);
        PG8_WAIT_V(6); PG8_BAR;
    }
    for (;;) {
        const bool has_next = S.next(ui + 1, nxt);
        const char* nA = has_next ? (const char*)g.A + (size_t)nxt.pm * tstepA : cA; const char* nB = has_next ? (const char*)g.Bt + (size_t)nxt.pn * tstepB : cB;
        for (int t = 0; t < nt; t += 2) {
            const bool last = (t == nt - 2);
            const char* a1 = cA + (size_t)(t + 1) * kstepA;
            const char* a2 = last ? nA : cA + (size_t)(t + 2) * kstepA; const char* b2 = last ? nB : cB + (size_t)(t + 2) * kstepB;
            const char* a3 = a2 + kstepA; const char* b3 = b2 + kstepB;
            if (last && has_next) S.a_ready(nxt);
            if constexpr (SP2) {
            PG8_LDB(B0, 0, 0); PG8_LDB(B1, 0, 1); PG8_SCHED; PG8_LDA(At, 0, 0); PG8_STAGE(PG8_SA(1, 1), a1 + hstepA, voffA);
            PG8_WAIT_V(8); PG8_WAIT_L(0); PG8_BAR; PG8_MMA(0, 0, At, B0); PG8_MMA(0, 1, At, B1); PG8_BAR; PG8_SCHED;
            PG8_LDA(At, 0, 1); PG8_STAGE(PG8_SB(0, 0), b2, voffB); PG8_STAGE(PG8_SB(0, 1), b2 + hstepB, voffB); PG8_STAGE(PG8_SA(0, 0), a2, voffA);
            PG8_WAIT_V(8); PG8_WAIT_L(0); PG8_BAR; PG8_MMA(1, 0, At, B0); PG8_MMA(1, 1, At, B1); PG8_BAR; PG8_SCHED;
            PG8_LDB(B0, 1, 0); PG8_LDB(B1, 1, 1); PG8_SCHED; PG8_LDA(At, 1, 0); PG8_STAGE(PG8_SA(0, 1), a2 + hstepA, voffA);
            PG8_WAIT_V(8); PG8_WAIT_L(0); PG8_BAR; PG8_MMA(0, 0, At, B0); PG8_MMA(0, 1, At, B1); PG8_BAR; PG8_SCHED;
            PG8_LDA(At, 1, 1); PG8_STAGE(PG8_SB(1, 0), b3, voffB); PG8_STAGE(PG8_SB(1, 1), b3 + hstepB, voffB); PG8_STAGE(PG8_SA(1, 0), a3, voffA);
            PG8_WAIT_V(8); PG8_WAIT_L(0); PG8_BAR; PG8_MMA(1, 0, At, B0); PG8_MMA(1, 1, At, B1); PG8_BAR; PG8_SCHED;
            } else {
            PG8_LDB(B0, 0, 0); PG8_SCHED; PG8_LDA(At, 0, 0); PG8_STAGE(PG8_SA(1, 1), a1 + hstepA, voffA);
            PG8_WAIT_L(8); PG8_BAR; PG8_WAIT_L(0); PG8_MMA(0, 0, At, B0); PG8_BAR; PG8_SCHED;
            PG8_LDB(B1, 0, 1); PG8_STAGE(PG8_SB(0, 0), b2, voffB);
            PG8_BAR; PG8_WAIT_L(0); PG8_MMA(0, 1, At, B1); PG8_BAR;
            PG8_LDA(At, 0, 1); PG8_STAGE(PG8_SA(0, 0), a2, voffA);
            PG8_BAR; PG8_WAIT_L(0); PG8_MMA(1, 0, At, B0); PG8_BAR; PG8_SCHED;
            PG8_STAGE(PG8_SB(0, 1), b2 + hstepB, voffB);
            PG8_WAIT_V(6); PG8_BAR; PG8_MMA(1, 1, At, B1); PG8_BAR;
            PG8_LDB(B0, 1, 0); PG8_SCHED; PG8_LDA(At, 1, 0); PG8_STAGE(PG8_SA(0, 1), a2 + hstepA, voffA);
            PG8_WAIT_L(8); PG8_BAR; PG8_WAIT_L(0); PG8_MMA(0, 0, At, B0); PG8_BAR; PG8_SCHED;
            PG8_LDB(B1, 1, 1); PG8_STAGE(PG8_SB(1, 0), b3, voffB);
            PG8_BAR; PG8_WAIT_L(0); PG8_MMA(0, 1, At, B1); PG8_BAR;
            PG8_LDA(At, 1, 1); PG8_STAGE(PG8_SA(1, 0), a3, voffA);
            PG8_BAR; PG8_WAIT_L(0); PG8_MMA(1, 0, At, B0); PG8_BAR; PG8_SCHED;
            PG8_STAGE(PG8_SB(1, 1), b3 + hstepB, voffB);
            PG8_WAIT_V(6); PG8_BAR; PG8_MMA(1, 1, At, B1); PG8_BAR;
            }
        }
        if constexpr (ALIGN_EPI) { if (wr == 0) PG8_BAR; }
        if constexpr (!Epi::AFTER_DRAIN) { E(acc, cur, wr, wc, fr, fq); S.done(cur); }
        if (!has_next) break;
#pragma unroll
        for (int a = 0; a < 2; ++a)
#pragma unroll
            for (int b = 0; b < 2; ++b)
#pragma unroll
                for (int m = 0; m < 4; ++m)
#pragma unroll
                    for (int n = 0; n < 2; ++n) acc[a][b][m][n] = (f32x4){0.f, 0.f, 0.f, 0.f};
        cur = nxt; cA = nA; cB = nB; ++ui;
        if constexpr (ALIGN_EPI) { if (wr == 1) PG8_BAR; }
    }
    PG8_WAIT_V(0);
    if constexpr (!ALIGN_EPI) { if (wr == 0) PG8_BAR; }
    PG8_BAR;
    if constexpr (Epi::AFTER_DRAIN) { E.fused(acc, cur, wr, wc, fr, fq, lds, wid, lane); S.done(cur); }
#undef PG8_SA
#undef PG8_SB
#undef PG8_STAGE
#undef PG8_LDA
#undef PG8_LDB
#undef PG8_MMA
#undef PG8_WAIT_V
#undef PG8_WAIT_L
#undef PG8_BAR
#undef PG8_SCHED
}
struct MUnit { int pm, pn, b, g; };
template <class Epi>
__device__ __forceinline__ void gemm_phase_merge(PG8_LAS unsigned char* lds, const unsigned char* ws, const bf16_t* XBp, const StaticOrder& S, const Epi& E) {
    int tid_ = threadIdx.x; asm volatile("" : "+v"(tid_));
    const int tid = tid_, wid = __builtin_amdgcn_readfirstlane(tid >> 6), lane = tid & 63, wr = wid >> 2, wc = wid & 3, fr = lane & 15, fq = lane >> 4;
    unsigned vY0, vGd;
    { int R, C; stage_rc(tid * 16, R, C); vY0 = (unsigned)(R * 512 + C) * 2u; vGd = (unsigned)(R * 512) * 2u; }
    constexpr size_t kstep = (size_t)(BK * 2), hY = (size_t)HALF * 512 * 2, hG = (size_t)HALF * 1024 * 2;
    const unsigned ldsw = (unsigned)wid * 1024u;
    const int aoff = lds_byte(wr * 64 + fr, fq * 8), boff = lds_byte(wc * 32 + fr, fq * 8);
#define PG8_SA(b, h) (((b) * 2 + (h)) * HTB)
#define PG8_SB(b, h) ((4 + (b) * 2 + (h)) * HTB)
#define PG8_STAGE(bufoff, gbase, voff, q64) do { const char* gb0_ = (const char*)(gbase); const char* gb1_ = gb0_ + (q64); unsigned vo_ = (voff); \
        asm volatile("" : "+s"(gb0_)); asm volatile("" : "+s"(gb1_)); asm volatile("" : "+v"(vo_));        \
        __builtin_amdgcn_global_load_lds((const unsigned*)(gb0_ + vo_), (PG8_LAS unsigned*)(lds + (bufoff) + ldsw), 16, 0, 0); \
        __builtin_amdgcn_global_load_lds((const unsigned*)(gb1_ + vo_), (PG8_LAS unsigned*)(lds + (bufoff) + ldsw + 8192), 16, 0, 0); } while (0)
#define PG8_LDA(dst, b, h) do { _Pragma("unroll") for (int m = 0; m < 4; ++m) _Pragma("unroll") for (int k = 0; k < 2; ++k) dst[m][k] = *(const PG8_LAS bf16x8*)(lds + PG8_SA(b, h) + aoff + m * 2048 + k * 1024); } while (0)
#define PG8_LDB(dst, b, h) do { _Pragma("unroll") for (int n = 0; n < 2; ++n) _Pragma("unroll") for (int k = 0; k < 2; ++k) dst[n][k] = *(const PG8_LAS bf16x8*)(lds + PG8_SB(b, h) + boff + n * 2048 + k * 1024); } while (0)
#define PG8_MMA(ai, bj, At, Bt) do { __builtin_amdgcn_s_setprio(1); _Pragma("unroll") for (int m = 0; m < 4; ++m) _Pragma("unroll") for (int n = 0; n < 2; ++n) _Pragma("unroll") for (int k = 0; k < 2; ++k) \
        acc[ai][bj][m][n] = __builtin_amdgcn_mfma_f32_16x16x32_bf16(Bt[n][k], At[m][k], acc[ai][bj][m][n], 0, 0, 0); __builtin_amdgcn_s_setprio(0); } while (0)
#define PG8_WAIT_V(n) asm volatile("s_waitcnt vmcnt(" #n ")" ::: "memory")
#define PG8_WAIT_L(n) asm volatile("s_waitcnt lgkmcnt(" #n ")" ::: "memory")
#define PG8_BAR __builtin_amdgcn_s_barrier()
#define PG8_SCHED __builtin_amdgcn_sched_barrier(0)
#define MU_NEXT(i, u, ok) do { Unit t_; const int ti_ = (i) / 6, sub_ = (i) - 6 * ti_; ok = S.next(ti_, t_); u.pm = t_.pm; u.pn = t_.pn; u.b = sub_ >> 1; u.g = sub_ & 1; } while (0)
#define MU_BASEA(u) ((u).g ? (const char*)XBp + (size_t)(u).pm * (2 * hG) : (const char*)ws + ((u).b == 0 ? OFF_AO : ((u).b == 1 ? OFF_CB : OFF_XQ)) + (size_t)(u).pm * (2 * hY))
#define MU_BASEB(u) ((u).g ? (const char*)ws + OFF_W_GATE + ((size_t)(u).b * 1024 + (size_t)(u).pn * 256) * 2048 : (const char*)ws + OFF_W_OMLA + (size_t)(u).b * 1048576 + (size_t)(u).pn * (2 * hY))
    MUnit cur, nxt; int ui = 0; bool ok0;
    MU_NEXT(0, cur, ok0);
    if (!ok0) return;
    f32x4 acc[2][2][4][2];
#pragma unroll
    for (int a = 0; a < 2; ++a)
#pragma unroll
        for (int b = 0; b < 2; ++b)
#pragma unroll
            for (int m = 0; m < 4; ++m)
#pragma unroll
                for (int n = 0; n < 2; ++n) acc[a][b][m][n] = (f32x4){0.f, 0.f, 0.f, 0.f};
    bf16x8 At[4][2], B0[2][2], B1[2][2];
    const char* cA = MU_BASEA(cur); const char* cB = MU_BASEB(cur);
    {
        const unsigned vc = cur.g ? vY0 + vGd : vY0; const size_t hc = cur.g ? hG : hY, qc = hc >> 1;
        PG8_STAGE(PG8_SB(0, 0), cB, vc, qc); PG8_STAGE(PG8_SB(0, 1), cB + hc, vc, qc); PG8_STAGE(PG8_SA(0, 0), cA, vc, qc); PG8_STAGE(PG8_SA(0, 1), cA + hc, vc, qc);
        if (wr == 1) PG8_BAR;
        PG8_WAIT_V(2); PG8_BAR;
        PG8_STAGE(PG8_SB(1, 0), cB + kstep, vc, qc); PG8_STAGE(PG8_SA(1, 0), cA + kstep, vc, qc); PG8_STAGE(PG8_SB(1, 1), cB + hc + kstep, vc, qc);
        PG8_WAIT_V(6); PG8_BAR;
    }
    for (;;) {
        bool has_next; MU_NEXT(ui + 1, nxt, has_next);
        const char* nA = has_next ? MU_BASEA(nxt) : cA; const char* nB = has_next ? MU_BASEB(nxt) : cB;
        const int ng = has_next ? nxt.g : cur.g;
        const unsigned vc = cur.g ? vY0 + vGd : vY0, vn = ng ? vY0 + vGd : vY0;
        const size_t hc = cur.g ? hG : hY, hn = ng ? hG : hY, qc = hc >> 1;
        const int nt = cur.g ? 16 : 8;
        for (int t = 0; t < nt; t += 2) {
            const bool last = (t == nt - 2);
            const char* a1 = cA + (size_t)(t + 1) * kstep;
            const char* a2 = last ? nA : cA + (size_t)(t + 2) * kstep; const char* b2 = last ? nB : cB + (size_t)(t + 2) * kstep;
            const char* a3 = a2 + kstep; const char* b3 = b2 + kstep;
            const unsigned v2 = last ? vn : vc; const size_t h2 = last ? hn : hc, q2 = h2 >> 1;
            PG8_LDB(B0, 0, 0); PG8_LDB(B1, 0, 1); PG8_SCHED; PG8_LDA(At, 0, 0); PG8_STAGE(PG8_SA(1, 1), a1 + hc, vc, qc);
            PG8_WAIT_V(8); PG8_WAIT_L(0); PG8_BAR; PG8_MMA(0, 0, At, B0); PG8_MMA(0, 1, At, B1); PG8_BAR; PG8_SCHED;
            PG8_LDA(At, 0, 1); PG8_STAGE(PG8_SB(0, 0), b2, v2, q2); PG8_STAGE(PG8_SB(0, 1), b2 + h2, v2, q2); PG8_STAGE(PG8_SA(0, 0), a2, v2, q2);
            PG8_WAIT_V(8); PG8_WAIT_L(0); PG8_BAR; PG8_MMA(1, 0, At, B0); PG8_MMA(1, 1, At, B1); PG8_BAR; PG8_SCHED;
            PG8_LDB(B0, 1, 0); PG8_LDB(B1, 1, 1); PG8_SCHED; PG8_LDA(At, 1, 0); PG8_STAGE(PG8_SA(0, 1), a2 + h2, v2, q2);
            PG8_WAIT_V(8); PG8_WAIT_L(0); PG8_BAR; PG8_MMA(0, 0, At, B0); PG8_MMA(0, 1, At, B1); PG8_BAR; PG8_SCHED;
            PG8_LDA(At, 1, 1); PG8_STAGE(PG8_SB(1, 0), b3, v2, q2); PG8_STAGE(PG8_SB(1, 1), b3 + h2, v2, q2); PG8_STAGE(PG8_SA(1, 0), a3, v2, q2);
            PG8_WAIT_V(8); PG8_WAIT_L(0); PG8_BAR; PG8_MMA(1, 0, At, B0); PG8_MMA(1, 1, At, B1); PG8_BAR; PG8_SCHED;
        }
        if (wr == 0) PG8_BAR;
        E(acc, cur, wr, wc, fr, fq);
        if (!has_next) break;
#pragma unroll
        for (int a = 0; a < 2; ++a)
#pragma unroll
            for (int b = 0; b < 2; ++b)
#pragma unroll
                for (int m = 0; m < 4; ++m)
#pragma unroll
                    for (int n = 0; n < 2; ++n) acc[a][b][m][n] = (f32x4){0.f, 0.f, 0.f, 0.f};
        cur = nxt; cA = nA; cB = nB; ++ui;
        if (wr == 1) PG8_BAR;
    }
    PG8_WAIT_V(0);
    PG8_BAR;
#undef MU_NEXT
#undef MU_BASEA
#undef MU_BASEB
#undef PG8_SA
#undef PG8_SB
#undef PG8_STAGE
#undef PG8_LDA
#undef PG8_LDB
#undef PG8_MMA
#undef PG8_WAIT_V
#undef PG8_WAIT_L
#undef PG8_BAR
#undef PG8_SCHED
}
struct EpiMerge {
    uint4* ytile; uint4* stile; const float* rs1; bf16_t* MERGED;
    __device__ __forceinline__ void operator()(const f32x4 (&acc)[2][2][4][2], const MUnit& u, int wr, int wc, int fr, int fq) const {
        asm volatile("" : "+v"(fr), "+v"(fq));
        const int slot = (wr * 4 + wc) * 16 * 64 + fq * 16 + fr;
#pragma unroll
        for (int ai = 0; ai < 2; ++ai) {
            if (!u.g) {
#pragma unroll
                for (int m = 0; m < 4; ++m)
#pragma unroll
                    for (int bj = 0; bj < 2; ++bj) {
                        const f32x4 v0 = acc[ai][bj][m][0], v1 = acc[ai][bj][m][1]; uint4 w;
                        w.x = ::pk2(v0[0], v0[1]); w.y = ::pk2(v0[2], v0[3]); w.z = ::pk2(v1[0], v1[1]); w.w = ::pk2(v1[2], v1[3]);
                        ytile[slot + ((ai * 4 + m) * 2 + bj) * 64] = w;
                    }
            } else {
                uint4 ys[4][2], ss[4][2]; float ri[4];
#pragma unroll
                for (int m = 0; m < 4; ++m) {
                    ri[m] = rs1[u.pm * BM + ai * HALF + wr * 64 + m * 16 + fr];
#pragma unroll
                    for (int bj = 0; bj < 2; ++bj) {
                        ys[m][bj] = ytile[slot + ((ai * 4 + m) * 2 + bj) * 64];
                        if (u.b > 0) ss[m][bj] = stile[slot + ((ai * 4 + m) * 2 + bj) * 64]; else ss[m][bj] = make_uint4(0u, 0u, 0u, 0u);
                    }
                }
#pragma unroll
                for (int m = 0; m < 4; ++m) {
                    const float rinv = rsqrtf(ri[m] * (1.f / 1024.f) + EPS);
                    bf16_t* mp = MERGED + ((size_t)(u.pn * 4 + (wc >> 1)) * NTOK + (size_t)(u.pm * 2 + ai) * 128) * 64 + ((wr * 4 + m) * 4 + (wc & 1) * 2) * 256 + fr * 16 + fq * 4;
#pragma unroll
                    for (int bj = 0; bj < 2; ++bj) {
                        const uint4 yw = ys[m][bj], sw = ss[m][bj];
                        const f32x4 g0 = acc[ai][bj][m][0] * rinv, g1 = acc[ai][bj][m][1] * rinv;
                        const f32x4 y0 = {::bflo(yw.x), ::bfhi(yw.x), ::bflo(yw.y), ::bfhi(yw.y)}, y1 = {::bflo(yw.z), ::bfhi(yw.z), ::bflo(yw.w), ::bfhi(yw.w)};
                        f32x4 v0 = {::bflo(sw.x), ::bfhi(sw.x), ::bflo(sw.y), ::bfhi(sw.y)}, v1 = {::bflo(sw.z), ::bfhi(sw.z), ::bflo(sw.w), ::bfhi(sw.w)};
#pragma unroll
                        for (int j = 0; j < 4; ++j) { v0[j] += y0[j] * __builtin_amdgcn_rcpf(1.f + __expf(-g0[j])); v1[j] += y1[j] * __builtin_amdgcn_rcpf(1.f + __expf(-g1[j])); }
                        if (u.b < 2) {
                            uint4 w; w.x = ::pk2(v0[0], v0[1]); w.y = ::pk2(v0[2], v0[3]); w.z = ::pk2(v1[0], v1[1]); w.w = ::pk2(v1[2], v1[3]);
                            stile[slot + ((ai * 4 + m) * 2 + bj) * 64] = w;
                        } else { ::st_bf4(mp + (size_t)bj * 2 * NTOK * 64, v0); ::st_bf4(mp + (size_t)bj * 2 * NTOK * 64 + 256, v1); }
                    }
                }
            }
        }
    }
};
}

DEVI void copy_rows_bf16(const float* x0, const float* x1, bf16_t* dst, float* rs, int gw, int nw, int lane) {
    for (int row = gw; row < NTOK; row += nw) {
        const float* src = row < 16384 ? x0 + (size_t)row * 1024 : x1 + (size_t)(row - 16384) * 1024;
        f32x4 v[4]; float s = 0.f;
#pragma unroll
        for (int i = 0; i < 4; ++i) { v[i] = ld_f4(src + lane * 4 + 256 * i); s += dot4(v[i]); }
        s += __shfl_xor(s, 1); s += __shfl_xor(s, 2); s += __shfl_xor(s, 4); s += __shfl_xor(s, 8); s += __shfl_xor(s, 16); s += __shfl_xor(s, 32);
        if (lane == 0) rs[row] = s;
#pragma unroll
        for (int i = 0; i < 4; ++i) st_bf4(dst + (size_t)row * 1024 + lane * 4 + 256 * i, v[i]);
    }
}

#define W1GU ((bf16_t*)(ws + OFF_W1GU))
#define W1DN ((bf16_t*)(ws + OFF_W1DN))
#define W2DN ((bf16_t*)(ws + OFF_W2DN))
#define W2GU ((bf16_t*)((unsigned char*)p.out + D1_W2GU))
#define W_OUT ((bf16_t*)((unsigned char*)p.out + D1_WOUT))
#define RS2 ((float*)((unsigned char*)p.out + D1_RS2))
#define RS0 ((float*)(ws + OFF_RS0))
#define RS1 ((float*)(ws + OFF_RS1))
#define XB ((bf16_t*)p.out)
#define XB0 ((bf16_t*)((unsigned char*)p.out + D1_OFF))
#define X2B ((bf16_t*)(ws + OFF_X2B))
#define HID2 ((bf16_t*)(ws + OFF_HID2))
#define W_IN1 ((bf16_t*)(ws + OFF_W_IN1))
#define W_IN2 ((bf16_t*)(ws + OFF_W_IN2))
#define W_GATE ((bf16_t*)(ws + OFF_W_GATE))
#define W_UQ ((bf16_t*)(ws + OFF_W_UQ))
#define W_UK ((bf16_t*)(ws + OFF_W_UK))
#define W_UV ((bf16_t*)(ws + OFF_W_UV))
#define W_OMLA ((bf16_t*)(ws + OFF_W_OMLA))
#define W_OCONV ((bf16_t*)(ws + OFF_W_OCONV))
#define W_OMEM ((bf16_t*)(ws + OFF_W_OMEM))
#define W_MEMK ((bf16_t*)(ws + OFF_W_MEMK))
#define W_MEMV ((bf16_t*)(ws + OFF_W_MEMV))
#define MK ((bf16_t*)(ws + OFF_MK))
#define MVT ((bf16_t*)(ws + OFF_MVT))
#define ROPE ((float*)(ws + OFF_ROPE))
#define RSQ ((float*)(ws + OFF_RSQ))
#define RSKV ((float*)(ws + OFF_RSKV))
#define MN ((bf16_t*)(ws + OFF_MN))
#define XQ ((bf16_t*)(ws + OFF_XQ))
#define CQ ((bf16_t*)(ws + OFF_CQ))
#define CKV ((bf16_t*)(ws + OFF_CKV))
#define Qb ((bf16_t*)(ws + OFF_Q))
#define Kb ((bf16_t*)(ws + OFF_K))
#define VT ((bf16_t*)(ws + OFF_VT))
#define HID ((bf16_t*)(ws + OFF_HID))
#define AO ((bf16_t*)(ws + OFF_AO))
#define CB ((bf16_t*)(ws + OFF_CB))
#define Ub ((bf16_t*)(ws + OFF_U))
#define MERGED ((bf16_t*)(ws + OFF_MERGED))
#define LAS __attribute__((address_space(3)))
#define XB_TMO      128
#define XB_XCNT(j)  (256  + 64 * (j))
#define XB_XSUB(j)  (1280 + 64 * (j))
#define XB_XGEN(j)  (2304 + 64 * (j))
#define XB_TOP      3328
#define XB_TOPGEN   3392
#define XCD_BAR_WORDS 3456
#define XB_SPIN_CAP (1u << 18)

__device__ __forceinline__ unsigned xb_ld(unsigned* p)              { return __hip_atomic_load(p, __ATOMIC_RELAXED, __HIP_MEMORY_SCOPE_AGENT); }
__device__ __forceinline__ unsigned xb_add(unsigned* p, unsigned v) { return __hip_atomic_fetch_add(p, v, __ATOMIC_RELAXED, __HIP_MEMORY_SCOPE_AGENT); }
__device__ __forceinline__ unsigned xb_xcc_id() { return (unsigned)__builtin_amdgcn_s_getreg((3 << 11) | 20) & 0xFu; }
#define XB_SPIN(cond, bar) do { unsigned _sp = 0; while (cond) { __builtin_amdgcn_s_sleep(1); \
    if ((++_sp & 255u) == 0u) { if (xb_ld(&(bar)[XB_TMO])) break; if (_sp > XB_SPIN_CAP) { atomicAdd(&(bar)[XB_TMO], 1u); break; } } } } while (0)

struct XcdBarrier {
    unsigned* bar; unsigned x;
    volatile LAS unsigned* st;
};

__device__ __forceinline__ XcdBarrier xcd_barrier_post(unsigned* bar, volatile LAS unsigned* st) {
    XcdBarrier b; b.bar = bar; b.x = xb_xcc_id(); b.st = st;
    if (threadIdx.x == 0) (void)xb_add(&bar[XB_XCNT(b.x)], 1u);
    return b;
}
__device__ __forceinline__ void xcd_barrier_complete(unsigned* bar, unsigned x, unsigned& nloc, unsigned& nx) {
    const unsigned G = gridDim.x * gridDim.y * gridDim.z;
    unsigned sum, cnt, mine, sp = 0u;
    for (;;) {
        sum = 0u; cnt = 0u; mine = 0u;
#pragma unroll
        for (unsigned j = 0; j < 16; ++j) { const unsigned c = xb_ld(&bar[XB_XCNT(j)]); sum += c; cnt += (c > 0u) ? 1u : 0u; mine = (j == x) ? c : mine; }
        if (sum == G) break;
        __builtin_amdgcn_s_sleep(1);
        if ((++sp & 255u) == 0u) { if (xb_ld(&bar[XB_TMO])) break; if (sp > XB_SPIN_CAP) { atomicAdd(&bar[XB_TMO], 1u); break; } }
    }
    nloc = mine > 0u ? mine : 1u; nx = cnt > 0u ? cnt : 1u;
}

__device__ __forceinline__ void xcd_barrier(const XcdBarrier& b) {
    asm volatile("s_waitcnt vmcnt(0)" ::: "memory");
    __syncthreads();
    if (threadIdx.x == 0) {
        unsigned* bar = b.bar;
        __builtin_amdgcn_s_waitcnt(0);
        unsigned nloc = b.st[0], nx = b.st[1];
        if (nloc == 0u) { xcd_barrier_complete(bar, b.x, nloc, nx); b.st[0] = nloc; b.st[1] = nx; }
        const unsigned old = xb_add(&bar[XB_XSUB(b.x)], 1u);
        const unsigned gen = old / nloc;
        if (old + 1u == (gen + 1u) * nloc) {
            __builtin_amdgcn_fence(__ATOMIC_RELEASE, "agent");
            asm volatile("s_waitcnt vmcnt(0)" ::: "memory");
            const unsigned og = xb_add(&bar[XB_TOP], 1u);
            const unsigned tg = og / nx;
            if (og + 1u == (tg + 1u) * nx) xb_add(&bar[XB_TOPGEN], 1u);
            else XB_SPIN(xb_ld(&bar[XB_TOPGEN]) == tg, bar);
            __builtin_amdgcn_fence(__ATOMIC_ACQUIRE, "agent");
            xb_add(&bar[XB_XGEN(b.x)], 1u);
            asm volatile("s_waitcnt vmcnt(0)" ::: "memory");
        } else {
            XB_SPIN(xb_ld(&bar[XB_XGEN(b.x)]) == gen, bar);
            __builtin_amdgcn_fence(__ATOMIC_ACQUIRE, "agent");
            asm volatile("s_waitcnt vmcnt(0)" ::: "memory");
        }
    }
    __syncthreads();
}

#define PHASE_VARS \
    int tx_ = threadIdx.x; asm volatile("" : "+v"(tx_)); \
    const int vh = __builtin_amdgcn_readfirstlane(tx_ >> 8); \
    unsigned char* const smem = smem_all + vh * SM_TOTAL; \
    const int tid = tx_ & 255, lane = tid & 63, wid = tid >> 6, wr = wid >> 1, wc = wid & 1, fr = lane & 15, fq = lane >> 4; \
    const int G = gridDim.x * 2, bid = blockIdx.x * 2 + vh; \
    (void)smem; (void)tid; (void)lane; (void)wid; (void)wr; (void)wc; (void)fr; (void)fq; (void)G; (void)bid;
__global__ void __launch_bounds__(512, 2) mega(Params p) {
    extern __shared__ __attribute__((aligned(16))) unsigned char smem_all[];

    cg::grid_group grid = cg::this_grid();
    unsigned char* ws = p.ws;
    volatile LAS unsigned* bst = (volatile LAS unsigned*)((LAS unsigned char*)smem_all + 2 * SM_TOTAL);
    if (threadIdx.x == 0) { bst[0] = 0u; bst[1] = 0u; }
    __syncthreads();
    const XcdBarrier xbar = xcd_barrier_post((unsigned*)(ws + OFF_BAR), bst);

    { PHASE_VARS
    { int cbase = 0; for (int id = 0; id < 13; ++id) { const WSpec s = get_spec(p, id); convert_spec(s, smem, bid, G, tid, cbase); } }
    for (int i = bid * 256 + tid; i < 3 * NTOK; i += G * 256) RSQ[i] = 0.f;
    for (int i = bid * 256 + tid; i < 8192 * 16; i += G * 256) {
        const int s = i >> 4, f = i & 15, a = f >> 2, b = f & 3;
        const double fa = a == 0 ? 1.0 : (a == 1 ? 0.1 : (a == 2 ? 0.01 : 0.001));
        const double fb = b == 0 ? 1.0 : (b == 1 ? 0.5623413251903491 : (b == 2 ? 0.31622776601683794 : 0.1778279410038923));
        double rev = (double)s * fa * fb * 0.15915494309189535; rev -= floor(rev);
        const float rv = (float)rev;
        ROPE[2 * i] = __builtin_amdgcn_cosf(rv); ROPE[2 * i + 1] = __builtin_amdgcn_sinf(rv);
    }
    for (int row = bid * 4 + wid; row < 1536; row += G * 4) {
        const float* src = row < 512 ? p.memp + (size_t)row * 1024 : p.mems + (size_t)(row - 512) * 1024;
        f32x4 v[4]; float s = 0.f;
#pragma unroll
        for (int i = 0; i < 4; ++i) { v[i] = ld_f4(src + lane * 4 + 256 * i); s += dot4(v[i]); }
        s += __shfl_xor(s, 1); s += __shfl_xor(s, 2); s += __shfl_xor(s, 4); s += __shfl_xor(s, 8); s += __shfl_xor(s, 16); s += __shfl_xor(s, 32);
        const float inv = rsqrtf(s * (1.f / 1024.f) + EPS);
#pragma unroll
        for (int i = 0; i < 4; ++i) st_bf4(MN + (size_t)row * 1024 + lane * 4 + 256 * i, v[i] * inv);
    }
    copy_rows_bf16(p.xp, p.xs, XB0, RS0, bid * 4 + wid, G * 4, lane);
    }
    grid.sync();
    { PHASE_VARS
    { pg8::Gemm g{XB0, W1GU, NTOK, 5632, 1024, 1024, 1024, 128, 128}; pg8::StaticOrder so; so.init(NTOK, 5632, gridDim.x, blockIdx.x);
      pg8::gemm_phase<pg8::EpiGU, pg8::StaticOrder, true, true>((PG8_LAS unsigned char*)smem_all, g, so, pg8::EpiGU{HID, RS0}); }
    }
    xcd_barrier(xbar);
    { PHASE_VARS
    { pg8::Gemm g{HID, W1DN, NTOK, 1024, 2816, 0, 2816, (size_t)NTOK * 128, 128}; pg8::StaticOrder so; so.init(NTOK, 1024, gridDim.x, blockIdx.x);
      pg8::gemm_phase<pg8::EpiRes<1>, pg8::StaticOrder, true, true>((PG8_LAS unsigned char*)smem_all, g, so, pg8::EpiRes<1>{nullptr, nullptr, XB0, XB, RS1, 0.5f}); }
    }
    xcd_barrier(xbar);
    { PHASE_VARS
    { int cbase = 0; for (int id = 13; id < 16; ++id) { const WSpec s = get_spec(p, id); convert_spec(s, smem, bid, G, tid, cbase); } }
    for (int i = bid * 256 + tid; i < NTOK; i += G * 256) RS2[i] = 0.f;
    __syncthreads();
    { pg8::Gemm g{XB, W_IN1, NTOK, 1280, 1024, 1024, 1024, 128, 128}; pg8::StaticOrder so; so.init(NTOK, 1280, gridDim.x, blockIdx.x);
      pg8::gemm_phase<pg8::EpiIn1, pg8::StaticOrder, true, true>((PG8_LAS unsigned char*)smem_all, g, so, pg8::EpiIn1{RS1, CQ, CKV, XQ, RSQ, RSKV}); }
    __syncthreads();
    for (int u = bid - 256; u >= 0 && u < 96; u += 1 << 30) {
        f32x4 acc[4][4]; zero_acc(acc);
        if (u < 48) {
            const int tm = u >> 2, hh = u & 3;
            gemm_tile<false>(acc, MN + (size_t)tm * 128 * 1024, 1024, W_MEMK + (size_t)hh * 128 * 1024, 1024, 16, smem);
            float tot[4]; tile_row_ss(acc, tot, smem, wr, wc, fr, fq);
#pragma unroll
            for (int m = 0; m < 4; ++m) {
                const int row = tm * 128 + wr * 64 + m * 16 + fr; const float inv = rsqrtf(tot[m] * (1.f / 128.f) + EPS);
#pragma unroll
                for (int n = 0; n < 4; ++n) { const int c = wc * 64 + n * 16 + fq * 4; st_bf4(MK + (size_t)row * 512 + hh * 128 + c, acc[m][n] * inv * ld_f4(p.xa_k_norm + c)); }
            }
        } else {
            const int v = u - 48, tm = v / 12, tn = v % 12;
            gemm_tile<false>(acc, W_MEMV + (size_t)tm * 128 * 1024, 1024, MN + (size_t)tn * 128 * 1024, 1024, 16, smem);
#pragma unroll
            for (int m = 0; m < 4; ++m) {
                const int d = wr * 64 + m * 16 + fr;
#pragma unroll
                for (int n = 0; n < 4; ++n) { const int col = tn * 128 + wc * 64 + n * 16 + fq * 4, b = col >> 8, mm = col & 255; st_bf4(MVT + ((size_t)(b * 4 + tm) * 128 + d) * 256 + mm, acc[m][n]); }
            }
        }
    }
    }
    xcd_barrier(xbar);
    { PHASE_VARS
    { pg8::Gemm g{CQ, W_UQ, NTOK, 768, 384, 384, 384, 128, 128}; pg8::StaticOrder so; so.init(NTOK, 768, gridDim.x, blockIdx.x);
      pg8::gemm_phase<pg8::EpiQ, pg8::StaticOrder, true, true>((PG8_LAS unsigned char*)smem_all, g, so, pg8::EpiQ{RSQ, Qb}); }
    { pg8::Gemm g{CKV, W_UK, NTOK, 512, 256, 288, 288, 128, 128}; pg8::StaticOrder so; so.init(NTOK, 512, gridDim.x, blockIdx.x);
      pg8::gemm_phase<pg8::EpiK, pg8::StaticOrder, true, true>((PG8_LAS unsigned char*)smem_all, g, so, pg8::EpiK{RSKV, CKV, p.mla_k_norm, ROPE, Kb}); }
    { pg8::Gemm g{W_UV, CKV, 512, NTOK, 256, 288, 288, 128, 128}; pg8::StaticOrder so; so.init(512, NTOK, gridDim.x, blockIdx.x);
      pg8::gemm_phase<pg8::EpiVt, pg8::StaticOrder, true, true>((PG8_LAS unsigned char*)smem_all, g, so, pg8::EpiVt{RSKV, VT}); }
    }
    xcd_barrier(xbar);
    { PHASE_VARS
    for (int j = blockIdx.x; j < 1024; j += gridDim.x) {
        int tok0i, pair, qt, nk, vtoff;
        if (j < 512) { const int r = j >> 8, i = j & 255; pair = (i & 7) + 8 * r; qt = i >> 3; tok0i = (pair >> 3) * 8192; nk = 8192; vtoff = 0; }
        else { const int jj = j - 512, r = jj >> 8, i = jj & 255, slot = i >> 3; pair = (i & 7) + 8 * (2 * r + (slot >> 4)); qt = slot & 15; tok0i = 16384 + (pair >> 3) * 4096; nk = 4096; vtoff = 8388608; }
        const int h = pair & 7;
        const size_t tok0 = (size_t)tok0i;
        attn_mla_item(p.mla_q_norm, ROPE, qt * 256, Qb + ((tok0 + qt * 256) * 8 + h) * 96, Kb + (tok0 * 8 + h) * 96, VT + (size_t)vtoff + (size_t)pair * 64 * nk, nk, nk, AO + (tok0 + qt * 256) * 512 + h * 64, smem_all, tx_);
    }
    __syncthreads();
    for (int jj = bid; jj < 1024; jj += G) {
        const int tile = jj >> 2, hh = jj & 3, tok0 = tile * 128;
        const int mb = tok0 < 16384 ? (tok0 >> 13) : 2 + ((tok0 - 16384) >> 12);
        bf16_t* qp = XQ + (size_t)tok0 * 512 + hh * 128;
        attn_item<128, 128, false, true>(p.xa_q_norm, QSCALE_XA, qp, 512, MK + (size_t)mb * 256 * 512 + hh * 128, 512, MVT + (size_t)(mb * 4 + hh) * 128 * 256, 256, 256, qp, 512, smem);
    }
    }
    xcd_barrier(xbar);
    { PHASE_VARS
    { pg8::Gemm g{XB, W_IN2, NTOK, 1536, 1024, 1024, 1024, 128, 128}; pg8::StaticOrder so; so.init(NTOK, 1536, gridDim.x, blockIdx.x);
      pg8::gemm_phase<pg8::EpiIn2, pg8::StaticOrder, true, true>((PG8_LAS unsigned char*)smem_all, g, so, pg8::EpiIn2{RS1, CB, Ub}); }
    }
    xcd_barrier(xbar);
    { PHASE_VARS
    for (int i = bid * 256 + tid; i < NTOK * 64; i += G * 256) {
        const int tok = i >> 6, c0 = (i & 63) * 8, pos = tok_pos(tok), slen = tok < 16384 ? 8192 : 4096;
        const bf16_t* up = Ub + (size_t)tok * 512 + c0;
        const uint4 z = {0u, 0u, 0u, 0u};
        const uint4 u0 = pos > 0 ? *(const uint4*)(up - 512) : z, u1 = *(const uint4*)up, u2 = pos < slen - 1 ? *(const uint4*)(up + 512) : z;
        const uint4 cb = *(const uint4*)(CB + (size_t)tok * 512 + c0);
        const unsigned a0[4] = {u0.x, u0.y, u0.z, u0.w}, a1[4] = {u1.x, u1.y, u1.z, u1.w}, a2[4] = {u2.x, u2.y, u2.z, u2.w}, ab[4] = {cb.x, cb.y, cb.z, cb.w};
        unsigned o[4];
#pragma unroll
        for (int q = 0; q < 4; ++q) {
            const int c = c0 + 2 * q;
            const float w0l = p.conv_w[c], w0h = p.conv_w[c + 1], w1l = p.conv_w[512 + c], w1h = p.conv_w[512 + c + 1], w2l = p.conv_w[1024 + c], w2h = p.conv_w[1024 + c + 1];
            const float yl = bflo(a0[q]) * w0l + bflo(a1[q]) * w1l + bflo(a2[q]) * w2l, yh = bfhi(a0[q]) * w0h + bfhi(a1[q]) * w1h + bfhi(a2[q]) * w2h;
            o[q] = pk2(bflo(ab[q]) * yl, bfhi(ab[q]) * yh);
        }
        uint4 ov; ov.x = o[0]; ov.y = o[1]; ov.z = o[2]; ov.w = o[3];
        *(uint4*)(CB + (size_t)tok * 512 + c0) = ov;
    }
    }
    xcd_barrier(xbar);
    { PHASE_VARS
    { pg8::StaticOrder so; so.init(NTOK, 1024, gridDim.x, blockIdx.x);
      pg8::gemm_phase_merge<pg8::EpiMerge>((PG8_LAS unsigned char*)smem_all, ws, XB, so, pg8::EpiMerge{(uint4*)Ub + (size_t)blockIdx.x * 8192, (uint4*)((unsigned char*)p.out + D1_STILE) + (size_t)blockIdx.x * 8192, RS1, MERGED}); }
    }
    xcd_barrier(xbar);
    { PHASE_VARS
    { pg8::Gemm g{MERGED, W_OUT, NTOK, 1024, 1024, 0, 1024, (size_t)NTOK * 128, 128}; pg8::StaticOrder so; so.init(NTOK, 1024, gridDim.x, blockIdx.x);
      pg8::gemm_phase<pg8::EpiRes<1>, pg8::StaticOrder, true, true>((PG8_LAS unsigned char*)smem_all, g, so, pg8::EpiRes<1>{nullptr, nullptr, XB, X2B, RS2, 1.0f}); }
    }
    xcd_barrier(xbar);
    { PHASE_VARS
    { pg8::Gemm g{X2B, W2GU, NTOK, 5632, 1024, 1024, 1024, 128, 128}; pg8::StaticOrder so; so.init(NTOK, 5632, gridDim.x, blockIdx.x);
      pg8::gemm_phase<pg8::EpiGU, pg8::StaticOrder, true, true>((PG8_LAS unsigned char*)smem_all, g, so, pg8::EpiGU{HID2, RS2}); }
    }
    xcd_barrier(xbar);
    { PHASE_VARS
    { pg8::Gemm g{HID2, W2DN, NTOK, 1024, 2816, 0, 2816, (size_t)NTOK * 128, 128}; pg8::StaticOrder so; so.init(NTOK, 1024, gridDim.x, blockIdx.x);
      pg8::gemm_phase<pg8::EpiFinal, pg8::StaticOrder, true, true>((PG8_LAS unsigned char*)smem_all, g, so, pg8::EpiFinal{X2B, p.out}); }
    }
}

extern "C" void kernel_launch(void* const* d_in, const int* in_sizes, int n_in, void* d_out, int out_size, void* d_ws, size_t ws_size, hipStream_t stream) {
    (void)in_sizes; (void)n_in; (void)out_size;
    static int grid_blocks = 0;
    if (!grid_blocks) {
        int dev = 0, cus = 0, per_cu = 0;
        (void)hipGetDevice(&dev);
        (void)hipDeviceGetAttribute(&cus, hipDeviceAttributeMultiprocessorCount, dev);
        (void)hipFuncSetAttribute((const void*)mega, hipFuncAttributeMaxDynamicSharedMemorySize, 2 * SM_TOTAL + 16);
        (void)hipOccupancyMaxActiveBlocksPerMultiprocessor(&per_cu, (const void*)mega, 512, 2 * SM_TOTAL + 16);
        if (per_cu > 1) per_cu = 1;
        if (per_cu < 1) per_cu = 1;
        grid_blocks = cus * per_cu;
        if (grid_blocks > 256) grid_blocks = 256;
    }
    if (ws_size < WS_SIZE) { fprintf(stderr, "workspace too small: %zu < %zu\n", ws_size, (size_t)WS_SIZE); return; }
    Params p{};
    const float* const* in = (const float* const*)d_in;
    p.xp = in[0]; p.xs = in[1]; p.memp = in[2]; p.mems = in[3];
    p.ffn1_norm = in[4]; p.ffn1_gu = in[5]; p.ffn1_down = in[6]; p.mix_norm = in[7]; p.w_in = in[8]; p.q_lora_norm = in[9]; p.w_uq = in[10];
    p.kv_lora_norm = in[11]; p.w_uk = in[12]; p.w_uv = in[13]; p.mla_q_norm = in[14]; p.mla_k_norm = in[15]; p.w_o_mla = in[16]; p.conv_w = in[17];
    p.w_o_conv = in[18]; p.mem_norm = in[19]; p.w_mem_kv = in[20]; p.xa_q_norm = in[21]; p.xa_k_norm = in[22]; p.w_o_mem = in[23]; p.w_out = in[24];
    p.ffn2_norm = in[25]; p.ffn2_gu = in[26]; p.ffn2_down = in[27];
    p.out = (float*)d_out; p.ws = (unsigned char*)d_ws;
    if (hipMemsetAsync((unsigned char*)d_ws + OFF_BAR, 0, 16384, stream) != hipSuccess) { fprintf(stderr, "memset of the barrier words failed\n"); return; }
    void* args[] = {&p};
    hipError_t e = hipLaunchCooperativeKernel((const void*)mega, dim3(grid_blocks), dim3(512), args, 2 * SM_TOTAL + 16, stream);
    if (e != hipSuccess) fprintf(stderr, "cooperative launch failed: %s (grid %d)\n", hipGetErrorString(e), grid_blocks);
}
```

```cpp
#include <hip/hip_runtime.h>
#include <hip/hip_cooperative_groups.h>
#include <cstdio>
#include <cstdint>
namespace cg = cooperative_groups;

#define DEVI __device__ __forceinline__
typedef unsigned short bf16_t;
typedef short bf16x8 __attribute__((ext_vector_type(8)));
typedef float f32x4 __attribute__((ext_vector_type(4)));
typedef float f32x16 __attribute__((ext_vector_type(16)));
typedef __bf16 bf16x2n __attribute__((ext_vector_type(2)));
typedef float f32x2n __attribute__((ext_vector_type(2)));

constexpr float EPS = 1e-6f;
constexpr int NTOK = 32768;
constexpr float QSCALE_MLA = 0.10206207261596575f * 1.4426950408889634f;
constexpr float QSCALE_XA = 0.08838834764831845f * 1.4426950408889634f;


constexpr size_t SZ_W_FFNGU = (size_t)5632 * 1024 * 2, SZ_W_FFNDN = (size_t)1024 * 2816 * 2;
constexpr size_t D1_OFF = (size_t)NTOK * 1024 * 2;
constexpr size_t D1_W2GU = D1_OFF, D1_WOUT = D1_W2GU + SZ_W_FFNGU, D1_RS2 = D1_WOUT + (size_t)1024 * 1024 * 2;
constexpr size_t OFF_W1GU = 0;
constexpr size_t OFF_W1DN = OFF_W1GU + SZ_W_FFNGU;
constexpr size_t OFF_W2DN = 0;
constexpr size_t OFF_W_IN1 = OFF_W1DN + SZ_W_FFNDN;
constexpr size_t OFF_W_IN2 = OFF_W_IN1 + (size_t)1280 * 1024 * 2;
constexpr size_t OFF_W_GATE = OFF_W_IN2 + (size_t)1536 * 1024 * 2;
constexpr size_t OFF_W_UQ = OFF_W_GATE + (size_t)3072 * 1024 * 2;
constexpr size_t OFF_W_UK = OFF_W_UQ + (size_t)1024 * 384 * 2;
constexpr size_t OFF_W_UV = OFF_W_UK + (size_t)512 * 288 * 2;
constexpr size_t OFF_W_OMLA = OFF_W_UV + (size_t)512 * 288 * 2;
constexpr size_t OFF_W_OCONV = OFF_W_OMLA + (size_t)1024 * 512 * 2;
constexpr size_t OFF_W_OMEM = OFF_W_OCONV + (size_t)1024 * 512 * 2;
constexpr size_t OFF_W_MEMK = OFF_W_OMEM + (size_t)1024 * 512 * 2;
constexpr size_t OFF_W_MEMV = OFF_W_MEMK + (size_t)512 * 1024 * 2;
constexpr size_t OFF_MK = OFF_W_MEMV + (size_t)512 * 1024 * 2;
constexpr size_t OFF_MVT = OFF_MK + (size_t)1536 * 512 * 2;
constexpr size_t OFF_ROPE = OFF_MVT + (size_t)1536 * 512 * 2;
constexpr size_t OFF_RSQ = OFF_ROPE + (size_t)8192 * 16 * 2 * 4;
constexpr size_t OFF_RSKV = OFF_RSQ + (size_t)NTOK * 4;
constexpr size_t OFF_RS1 = OFF_RSKV + (size_t)NTOK * 4;
constexpr size_t OFF_RS0 = OFF_RS1 + (size_t)NTOK * 4;
constexpr size_t OFF_MN = OFF_RS0 + (size_t)NTOK * 4;
constexpr size_t OFF_ACT = OFF_MN + (size_t)1536 * 1024 * 2;
constexpr size_t OFF_XQ = OFF_ACT;
constexpr size_t OFF_CQ = OFF_XQ + (size_t)NTOK * 512 * 2;
constexpr size_t OFF_CKV = OFF_CQ + (size_t)NTOK * 384 * 2;
constexpr size_t OFF_Q = OFF_CKV + (size_t)NTOK * 288 * 2;
constexpr size_t OFF_K = OFF_Q + (size_t)NTOK * 768 * 2;
constexpr size_t OFF_VT = OFF_K + (size_t)NTOK * 768 * 2;
constexpr size_t WS_NEEDED = OFF_VT + (size_t)NTOK * 512 * 2;
constexpr size_t WS_SIZE = (size_t)256 * 1024 * 1024;
constexpr size_t OFF_HID = OFF_ACT;
constexpr size_t OFF_AO = OFF_CQ;
constexpr size_t OFF_CB = OFF_Q;
constexpr size_t OFF_U = OFF_CB + (size_t)NTOK * 512 * 2;
constexpr size_t OFF_MERGED = OFF_U + (size_t)NTOK * 512 * 2;
constexpr size_t OFF_X2B = OFF_W2DN + SZ_W_FFNDN;
constexpr size_t OFF_BAR = WS_SIZE - 16384;
constexpr size_t OFF_HID2 = OFF_BAR - (size_t)NTOK * 2816 * 2;
static_assert(OFF_HID + (size_t)NTOK * 2816 * 2 <= WS_SIZE, "hid");
static_assert(OFF_AO + (size_t)NTOK * 512 * 2 <= OFF_Q, "ao");
static_assert(OFF_MERGED + (size_t)NTOK * 1024 * 2 <= WS_NEEDED, "merged");
static_assert(WS_NEEDED <= OFF_BAR && OFF_HID + (size_t)NTOK * 2816 * 2 <= OFF_BAR, "ws");
static_assert(OFF_X2B + (size_t)NTOK * 1024 * 2 <= OFF_HID2, "x2b");
static_assert(OFF_X2B + (size_t)NTOK * 1024 * 2 <= OFF_MERGED, "x2b/merged");
constexpr size_t D1_STILE = D1_RS2 + (size_t)NTOK * 4;
static_assert(D1_STILE + (size_t)256 * 131072 <= 2 * D1_OFF, "d1");

constexpr int TILE_BYTES = 128 * 144;
constexpr int SM_A = 0, SM_B = 2 * TILE_BYTES, SM_RSS = 4 * TILE_BYTES, SM_XCH = SM_RSS + 512, SM_TOTAL = SM_XCH + 1024;

struct Params {
    const float *xp, *xs, *memp, *mems;
    const float *ffn1_norm, *ffn1_gu, *ffn1_down, *mix_norm, *w_in, *q_lora_norm, *w_uq, *kv_lora_norm, *w_uk, *w_uv;
    const float *mla_q_norm, *mla_k_norm, *w_o_mla, *conv_w, *w_o_conv, *mem_norm, *w_mem_kv, *xa_q_norm, *xa_k_norm;
    const float *w_o_mem, *w_out, *ffn2_norm, *ffn2_gu, *ffn2_down;
    float* out;
    unsigned char* ws;
};

DEVI unsigned pk2(float lo, float hi) { f32x2n v = {lo, hi}; bf16x2n b = __builtin_convertvector(v, bf16x2n); return __builtin_bit_cast(unsigned, b); }
DEVI float bflo(unsigned w) { return __uint_as_float(w << 16); }
DEVI float bfhi(unsigned w) { return __uint_as_float(w & 0xffff0000u); }
DEVI void st_bf4(bf16_t* p, f32x4 v) { uint2 w; w.x = pk2(v[0], v[1]); w.y = pk2(v[2], v[3]); *(uint2*)p = w; }
DEVI f32x4 ld_bf4(const bf16_t* p) { uint2 w = *(const uint2*)p; f32x4 r = {bflo(w.x), bfhi(w.x), bflo(w.y), bfhi(w.y)}; return r; }
DEVI f32x4 ld_f4(const float* p) { float4 t = *(const float4*)p; f32x4 r = {t.x, t.y, t.z, t.w}; return r; }
DEVI float dot4(f32x4 v) { return v[0] * v[0] + v[1] * v[1] + v[2] * v[2] + v[3] * v[3]; }
DEVI float sigm(float x) { return __builtin_amdgcn_rcpf(1.f + __expf(-x)); }
DEVI int tok_pos(int tok) { return tok < 16384 ? (tok & 8191) : (tok & 4095); }
DEVI float red4q(float s) { s += __shfl_xor(s, 16); s += __shfl_xor(s, 32); return s; }

template <bool AF32>
DEVI void gemm_tile(f32x4 (&acc)[4][4], const void* Aptr, int lda, const bf16_t* Bptr, int ldb, int nk, unsigned char* smem) {
    int tid_ = threadIdx.x & 255; asm volatile("" : "+v"(tid_)); const int tid = tid_, lane = tid & 63, wid = tid >> 6, wr = wid >> 1, wc = wid & 1, fr = lane & 15, fq = lane >> 4;
    float4 af[8]; uint4 ab[4]; uint4 bb[4]; float ss[8];
#pragma unroll
    for (int i = 0; i < 8; ++i) ss[i] = 0.f;
    const float* Af = (const float*)Aptr + (size_t)(tid >> 4) * lda + (tid & 15) * 4;
    const bf16_t* Ab = (const bf16_t*)Aptr + (size_t)(tid >> 3) * lda + (tid & 7) * 8;
    const bf16_t* Bb = Bptr + (size_t)(tid >> 3) * ldb + (tid & 7) * 8;
    const int awf = (tid >> 4) * 144 + (tid & 15) * 8;
    const int awb = (tid >> 3) * 144 + (tid & 7) * 16;
    const int aro = (wr * 64 + fr) * 144 + fq * 16;
    const int bro = (wc * 64 + fr) * 144 + fq * 16;
#define GT_LOAD(kt) do { \
        if (AF32) { _Pragma("unroll") for (int i = 0; i < 8; ++i) af[i] = *(const float4*)(Af + (size_t)(16 * i) * lda + (kt) * 64); } \
        else      { _Pragma("unroll") for (int i = 0; i < 4; ++i) ab[i] = *(const uint4*)(Ab + (size_t)(32 * i) * lda + (kt) * 64); } \
        _Pragma("unroll") for (int i = 0; i < 4; ++i) bb[i] = *(const uint4*)(Bb + (size_t)(32 * i) * ldb + (kt) * 64); } while (0)
#define GT_STORE(buf) do { \
        unsigned char* As_ = smem + SM_A + (buf) * TILE_BYTES; unsigned char* Bs_ = smem + SM_B + (buf) * TILE_BYTES; \
        if (AF32) { _Pragma("unroll") for (int i = 0; i < 8; ++i) { float4 v = af[i]; ss[i] += v.x * v.x + v.y * v.y + v.z * v.z + v.w * v.w; \
                        uint2 w; w.x = pk2(v.x, v.y); w.y = pk2(v.z, v.w); *(uint2*)(As_ + awf + i * 16 * 144) = w; } } \
        else      { _Pragma("unroll") for (int i = 0; i < 4; ++i) *(uint4*)(As_ + awb + i * 32 * 144) = ab[i]; } \
        _Pragma("unroll") for (int i = 0; i < 4; ++i) *(uint4*)(Bs_ + awb + i * 32 * 144) = bb[i]; } while (0)
    GT_LOAD(0);
    GT_STORE(0);
    __syncthreads();
    for (int kt = 0; kt < nk; ++kt) {
        const bool more = kt + 1 < nk;
        if (more) GT_LOAD(kt + 1);
        const unsigned char* As = smem + SM_A + (kt & 1) * TILE_BYTES;
        const unsigned char* Bs = smem + SM_B + (kt & 1) * TILE_BYTES;
#pragma unroll
        for (int ks = 0; ks < 2; ++ks) {
            bf16x8 a[4], b[4];
#pragma unroll
            for (int m = 0; m < 4; ++m) a[m] = *(const bf16x8*)(As + aro + m * 16 * 144 + ks * 64);
#pragma unroll
            for (int n = 0; n < 4; ++n) b[n] = *(const bf16x8*)(Bs + bro + n * 16 * 144 + ks * 64);
#pragma unroll
            for (int m = 0; m < 4; ++m)
#pragma unroll
                for (int n = 0; n < 4; ++n) acc[m][n] = __builtin_amdgcn_mfma_f32_16x16x32_bf16(b[n], a[m], acc[m][n], 0, 0, 0);
        }
        if (more) GT_STORE((kt + 1) & 1);
        __syncthreads();
    }
    if (AF32) {
        float* rowss = (float*)(smem + SM_RSS);
#pragma unroll
        for (int i = 0; i < 8; ++i) {
            float s = ss[i];
            s += __shfl_xor(s, 1); s += __shfl_xor(s, 2); s += __shfl_xor(s, 4); s += __shfl_xor(s, 8);
            if ((tid & 15) == 0) rowss[(tid >> 4) + 16 * i] = s;
        }
        __syncthreads();
    }
#undef GT_LOAD
#undef GT_STORE
}
DEVI void zero_acc(f32x4 (&acc)[4][4]) {
#pragma unroll
    for (int m = 0; m < 4; ++m)
#pragma unroll
        for (int n = 0; n < 4; ++n) acc[m][n] = (f32x4){0.f, 0.f, 0.f, 0.f};
}
DEVI void tile_row_ss(const f32x4 (&acc)[4][4], float (&tot)[4], unsigned char* smem, int wr, int wc, int fr, int fq) {
    float* xch = (float*)(smem + SM_XCH);
#pragma unroll
    for (int m = 0; m < 4; ++m) {
        float s = 0.f;
#pragma unroll
        for (int n = 0; n < 4; ++n) s += dot4(acc[m][n]);
        s = red4q(s);
        if (fq == 0) xch[wc * 128 + wr * 64 + m * 16 + fr] = s;
    }
    __syncthreads();
#pragma unroll
    for (int m = 0; m < 4; ++m) { const int r = wr * 64 + m * 16 + fr; tot[m] = xch[r] + xch[128 + r]; }
}


enum { KD_ID = 0, KD_GU, KD_IN1, KD_IN2, KD_UK };
struct WSpec { const float* src; const float* gain; bf16_t* dst; int src_ld, K, Np, kind, coff, dld; };
DEVI int map_col(int kind, int coff, int np) {
    const int c2 = np & 255, pr = (c2 >> 7) * 64 + ((c2 >> 5) & 3) * 16 + (c2 & 15), n = (c2 >> 4) & 1;
    switch (kind) {
        case KD_GU: return n * 2816 + (np >> 8) * 128 + pr;
        case KD_IN1: return np < 672 ? np : (np < 768 ? -1 : 2208 + (np - 768));
        case KD_IN2: return np < 512 ? 672 + np : 1184 + n * 512 + ((np >> 8) - 2) * 128 + pr;
        case KD_UK: return ((np >> 8) * 4 + ((c2 >> 5) & 3)) * 64 + (c2 >> 7) * 32 + n * 16 + (c2 & 15);
        default: return coff + np;
    }
}
DEVI WSpec get_spec(const Params& p, int id) {
    unsigned char* ws = p.ws; unsigned char* d1 = (unsigned char*)p.out; WSpec s;
    switch (id) {
        case 0: s = {p.ffn1_gu, p.ffn1_norm, (bf16_t*)(ws + OFF_W1GU), 5632, 1024, 5632, KD_GU, 0, 1024}; break;
        case 1: s = {p.ffn1_down, nullptr, (bf16_t*)(ws + OFF_W1DN), 1024, 2816, 1024, KD_ID, 0, 2816}; break;
        case 2: s = {p.w_in, p.mix_norm, (bf16_t*)(ws + OFF_W_IN1), 5792, 1024, 1280, KD_IN1, 0, 1024}; break;
        case 3: s = {p.w_in, p.mix_norm, (bf16_t*)(ws + OFF_W_IN2), 5792, 1024, 1536, KD_IN2, 0, 1024}; break;
        case 4: s = {p.w_in, p.mix_norm, (bf16_t*)(ws + OFF_W_GATE), 5792, 1024, 3072, KD_ID, 2720, 1024}; break;
        case 5: s = {p.w_uq, p.q_lora_norm, (bf16_t*)(ws + OFF_W_UQ), 768, 384, 768, KD_ID, 0, 384}; break;
        case 6: s = {p.w_uk, p.kv_lora_norm, (bf16_t*)(ws + OFF_W_UK), 512, 256, 512, KD_UK, 0, 288}; break;
        case 7: s = {p.w_uv, p.kv_lora_norm, (bf16_t*)(ws + OFF_W_UV), 512, 256, 512, KD_ID, 0, 288}; break;
        case 8: s = {p.w_o_mla, nullptr, (bf16_t*)(ws + OFF_W_OMLA), 1024, 512, 1024, KD_ID, 0, 512}; break;
        case 9: s = {p.w_o_conv, nullptr, (bf16_t*)(ws + OFF_W_OCONV), 1024, 512, 1024, KD_ID, 0, 512}; break;
        case 10: s = {p.w_o_mem, nullptr, (bf16_t*)(ws + OFF_W_OMEM), 1024, 512, 1024, KD_ID, 0, 512}; break;
        case 11: s = {p.w_mem_kv, p.mem_norm, (bf16_t*)(ws + OFF_W_MEMK), 1024, 1024, 512, KD_ID, 0, 1024}; break;
        case 12: s = {p.w_mem_kv, p.mem_norm, (bf16_t*)(ws + OFF_W_MEMV), 1024, 1024, 512, KD_ID, 512, 1024}; break;
        case 13: s = {p.w_out, nullptr, (bf16_t*)(d1 + D1_WOUT), 1024, 1024, 1024, KD_ID, 0, 1024}; break;
        case 14: s = {p.ffn2_gu, p.ffn2_norm, (bf16_t*)(d1 + D1_W2GU), 5632, 1024, 5632, KD_GU, 0, 1024}; break;
        default: s = {p.ffn2_down, nullptr, (bf16_t*)(ws + OFF_W2DN), 1024, 2816, 1024, KD_ID, 0, 2816}; break;
    }
    return s;
}
DEVI void convert_spec(const WSpec& s, unsigned char* smem, int bid, int G, int tid, int& base) {
    float* T = (float*)smem;
    const int nkt = s.K >> 6, ntiles = (s.Np >> 6) * nkt;
    int first = (bid - base) % G; if (first < 0) first += G;
    base += ntiles;
    for (int t = first; t < ntiles; t += G) {
        const int n0 = (t / nkt) << 6, k0 = (t % nkt) << 6;
        const int c4 = (tid & 15) * 4, col = map_col(s.kind, s.coff, n0 + c4);
#pragma unroll
        for (int i = 0; i < 4; ++i) {
            const int r = (tid >> 4) + 16 * i;
            float4 v = make_float4(0.f, 0.f, 0.f, 0.f);
            if (col >= 0) { v = *(const float4*)(s.src + (size_t)(k0 + r) * s.src_ld + col); if (s.gain) { const float g = s.gain[k0 + r]; v.x *= g; v.y *= g; v.z *= g; v.w *= g; } }
            T[r * 65 + c4] = v.x; T[r * 65 + c4 + 1] = v.y; T[r * 65 + c4 + 2] = v.z; T[r * 65 + c4 + 3] = v.w;
        }
        __syncthreads();
#pragma unroll
        for (int i = 0; i < 2; ++i) {
            const int idx = tid + 256 * i, cn = idx >> 3, kc = idx & 7;
            uint4 w;
            w.x = pk2(T[(kc * 8 + 0) * 65 + cn], T[(kc * 8 + 1) * 65 + cn]);
            w.y = pk2(T[(kc * 8 + 2) * 65 + cn], T[(kc * 8 + 3) * 65 + cn]);
            w.z = pk2(T[(kc * 8 + 4) * 65 + cn], T[(kc * 8 + 5) * 65 + cn]);
            w.w = pk2(T[(kc * 8 + 6) * 65 + cn], T[(kc * 8 + 7) * 65 + cn]);
            *(uint4*)(s.dst + (size_t)(n0 + cn) * s.dld + k0 + kc * 8) = w;
        }
        __syncthreads();
    }
}

template <int DQK, int DV, bool PIPE, bool QNORM>
DEVI void attn_item(const float* qgain, float qscale, const bf16_t* Qp, int q_rs, const bf16_t* Kp, int k_rs, const bf16_t* Vtp, int vt_rs, int nkeys, bf16_t* Op, int o_rs, unsigned char* smem) {
    constexpr int KROW = (DQK + 8) * 2, VROW = 136, KT_BYTES = 64 * KROW, VT_BYTES = DV * VROW, STAGE = KT_BYTES + VT_BYTES;
    constexpr int KCH = DQK / 8, NKC = 64 * KCH / 256, NVC = DV * 8 / 256, NKK = DQK / 16, NDB = DV / 32;
    static_assert(2 * STAGE <= SM_TOTAL, "attn lds");
    int tid_ = threadIdx.x & 255; asm volatile("" : "+v"(tid_)); const int tid = tid_, lane = tid & 63, wid = tid >> 6, ql = lane & 31, half = lane >> 5;
    __syncthreads();
    bf16x8 qf[NKK];
    {
        const bf16_t* qrow = Qp + (size_t)(wid * 32 + ql) * q_rs + half * 8;
#pragma unroll
        for (int kk = 0; kk < NKK; ++kk) qf[kk] = *(const bf16x8*)(qrow + kk * 16);
    }
    if (QNORM) {
        float ss = 0.f;
#pragma unroll
        for (int kk = 0; kk < NKK; ++kk) { const uint4 w = __builtin_bit_cast(uint4, qf[kk]);
            ss += bflo(w.x) * bflo(w.x) + bfhi(w.x) * bfhi(w.x) + bflo(w.y) * bflo(w.y) + bfhi(w.y) * bfhi(w.y) + bflo(w.z) * bflo(w.z) + bfhi(w.z) * bfhi(w.z) + bflo(w.w) * bflo(w.w) + bfhi(w.w) * bfhi(w.w); }
        ss += __shfl_xor(ss, 32);
        const float inv = rsqrtf(ss * (1.f / DQK) + EPS) * qscale;
#pragma unroll
        for (int kk = 0; kk < NKK; ++kk) { const uint4 w = __builtin_bit_cast(uint4, qf[kk]);
            const f32x4 g0 = ld_f4(qgain + kk * 16 + half * 8), g1 = ld_f4(qgain + kk * 16 + half * 8 + 4); uint4 o;
            o.x = pk2(bflo(w.x) * inv * g0[0], bfhi(w.x) * inv * g0[1]); o.y = pk2(bflo(w.y) * inv * g0[2], bfhi(w.y) * inv * g0[3]);
            o.z = pk2(bflo(w.z) * inv * g1[0], bfhi(w.z) * inv * g1[1]); o.w = pk2(bflo(w.w) * inv * g1[2], bfhi(w.w) * inv * g1[3]);
            qf[kk] = __builtin_bit_cast(bf16x8, o); }
    }
    f32x16 accO[NDB];
#pragma unroll
    for (int db = 0; db < NDB; ++db)
#pragma unroll
        for (int r = 0; r < 16; ++r) accO[db][r] = 0.f;
    float m_run = -INFINITY, l_run = 0.f;
    uint4 kreg[NKC], vreg[NVC];
#define AT_LOAD(t) do { const int s0_ = (t) * 64; \
        _Pragma("unroll") for (int i = 0; i < NKC; ++i) { const int c = tid + 256 * i, row = c / KCH, kc = c % KCH; kreg[i] = *(const uint4*)(Kp + (size_t)(s0_ + row) * k_rs + kc * 8); } \
        _Pragma("unroll") for (int i = 0; i < NVC; ++i) { const int c = tid + 256 * i, d = c >> 3, kc = c & 7; vreg[i] = *(const uint4*)(Vtp + (size_t)d * vt_rs + s0_ + kc * 8); } } while (0)
#define AT_STORE(buf) do { unsigned char* Ks_ = smem + (buf) * STAGE; unsigned char* Vs_ = Ks_ + KT_BYTES; \
        _Pragma("unroll") for (int i = 0; i < NKC; ++i) { const int c = tid + 256 * i, row = c / KCH, kc = c % KCH; *(uint4*)(Ks_ + row * KROW + kc * 16) = kreg[i]; } \
        _Pragma("unroll") for (int i = 0; i < NVC; ++i) { const int c = tid + 256 * i, d = c >> 3, kc = c & 7; uint2 lo_, hi_; lo_.x = vreg[i].x; lo_.y = vreg[i].y; hi_.x = vreg[i].z; hi_.y = vreg[i].w; \
            *(uint2*)(Vs_ + d * VROW + kc * 16) = lo_; *(uint2*)(Vs_ + d * VROW + kc * 16 + 8) = hi_; } } while (0)
    const int nt = nkeys >> 6;
    if (PIPE) { AT_LOAD(0); AT_STORE(0); __syncthreads(); }
    for (int t = 0; t < nt; ++t) {
        const bool more = PIPE && (t + 1 < nt);
        if (PIPE) { if (more) AT_LOAD(t + 1); }
        else { AT_LOAD(t); AT_STORE(t & 1); __syncthreads(); }
        const unsigned char* Ks = smem + (t & 1) * STAGE;
        const unsigned char* Vs = Ks + KT_BYTES;
        f32x16 s[2];
#pragma unroll
        for (int kb = 0; kb < 2; ++kb) {
#pragma unroll
            for (int r = 0; r < 16; ++r) s[kb][r] = 0.f;
#pragma unroll
            for (int kk = 0; kk < NKK; ++kk) {
                const bf16x8 kf = *(const bf16x8*)(Ks + (kb * 32 + ql) * KROW + kk * 32 + half * 16);
                s[kb] = __builtin_amdgcn_mfma_f32_32x32x16_bf16(kf, qf[kk], s[kb], 0, 0, 0);
            }
        }
        float mx = s[0][0];
#pragma unroll
        for (int r = 1; r < 16; ++r) mx = fmaxf(mx, s[0][r]);
#pragma unroll
        for (int r = 0; r < 16; ++r) mx = fmaxf(mx, s[1][r]);
        mx = fmaxf(mx, __shfl_xor(mx, 32));
        const float m_new = fmaxf(m_run, mx);
        const float alpha = __builtin_amdgcn_exp2f(m_run - m_new);
        m_run = m_new;
        float psum = 0.f;
#pragma unroll
        for (int kb = 0; kb < 2; ++kb)
#pragma unroll
            for (int r = 0; r < 16; ++r) { const float pv = __builtin_amdgcn_exp2f(s[kb][r] - m_new); s[kb][r] = pv; psum += pv; }
        l_run = l_run * alpha + psum;
#pragma unroll
        for (int db = 0; db < NDB; ++db)
#pragma unroll
            for (int r = 0; r < 16; ++r) accO[db][r] *= alpha;
#pragma unroll
        for (int kb = 0; kb < 2; ++kb)
#pragma unroll
            for (int p2 = 0; p2 < 2; ++p2) {
                uint4 pw;
                pw.x = pk2(s[kb][8 * p2 + 0], s[kb][8 * p2 + 1]); pw.y = pk2(s[kb][8 * p2 + 2], s[kb][8 * p2 + 3]);
                pw.z = pk2(s[kb][8 * p2 + 4], s[kb][8 * p2 + 5]); pw.w = pk2(s[kb][8 * p2 + 6], s[kb][8 * p2 + 7]);
                const bf16x8 pf = __builtin_bit_cast(bf16x8, pw);
#pragma unroll
                for (int db = 0; db < NDB; ++db) {
                    const unsigned char* vp = Vs + (db * 32 + ql) * VROW + (kb * 32 + 16 * p2 + half * 4) * 2;
                    const uint2 vlo = *(const uint2*)vp, vhi = *(const uint2*)(vp + 16);
                    uint4 vw; vw.x = vlo.x; vw.y = vlo.y; vw.z = vhi.x; vw.w = vhi.y;
                    accO[db] = __builtin_amdgcn_mfma_f32_32x32x16_bf16(__builtin_bit_cast(bf16x8, vw), pf, accO[db], 0, 0, 0);
                }
            }
        if (PIPE) { if (more) AT_STORE((t + 1) & 1); __syncthreads(); }
    }
#undef AT_LOAD
#undef AT_STORE
    const float l = l_run + __shfl_xor(l_run, 32);
    const float inv = 1.f / l;
    bf16_t* orow = Op + (size_t)(wid * 32 + ql) * o_rs + half * 4;
#pragma unroll
    for (int db = 0; db < NDB; ++db)
#pragma unroll
        for (int g = 0; g < 4; ++g) {
            f32x4 v = {accO[db][4 * g] * inv, accO[db][4 * g + 1] * inv, accO[db][4 * g + 2] * inv, accO[db][4 * g + 3] * inv};
            st_bf4(orow + db * 32 + 8 * g, v);
        }
}


DEVI void attn_mla_item(const float* gq, const float* ROPEp, int pos0, const bf16_t* Qp, const bf16_t* Kp, const bf16_t* Vtp, int vt_rs, int nkeys, bf16_t* Op, unsigned char* smem, int tx) {
    constexpr int KROW = 208, VROW = 264, KT_BYTES = 128 * KROW, VT_BYTES = 64 * VROW, STAGE = KT_BYTES + VT_BYTES;
    static_assert(2 * STAGE <= 2 * SM_TOTAL, "attn lds");
    const int lane = tx & 63, wid = tx >> 6, ql = lane & 31, half = lane >> 5;
    __syncthreads();
    bf16x8 qf[6];
    {
        const bf16_t* qrow = Qp + (size_t)(wid * 32 + ql) * 768 + half * 8;
#pragma unroll
        for (int kk = 0; kk < 6; ++kk) qf[kk] = *(const bf16x8*)(qrow + kk * 16);
    }
    {
        float ss = 0.f;
#pragma unroll
        for (int kk = 0; kk < 6; ++kk) { const uint4 w = __builtin_bit_cast(uint4, qf[kk]);
            ss += bflo(w.x) * bflo(w.x) + bfhi(w.x) * bfhi(w.x) + bflo(w.y) * bflo(w.y) + bfhi(w.y) * bfhi(w.y) + bflo(w.z) * bflo(w.z) + bfhi(w.z) * bfhi(w.z) + bflo(w.w) * bflo(w.w) + bfhi(w.w) * bfhi(w.w); }
        ss += __shfl_xor(ss, 32);
        const float inv = rsqrtf(ss * (1.f / 96.f) + EPS) * QSCALE_MLA;
#pragma unroll
        for (int kk = 0; kk < 4; ++kk) { const uint4 w = __builtin_bit_cast(uint4, qf[kk]);
            const f32x4 g0 = ld_f4(gq + kk * 16 + half * 8), g1 = ld_f4(gq + kk * 16 + half * 8 + 4); uint4 o;
            o.x = pk2(bflo(w.x) * inv * g0[0], bfhi(w.x) * inv * g0[1]); o.y = pk2(bflo(w.y) * inv * g0[2], bfhi(w.y) * inv * g0[3]);
            o.z = pk2(bflo(w.z) * inv * g1[0], bfhi(w.z) * inv * g1[1]); o.w = pk2(bflo(w.w) * inv * g1[2], bfhi(w.w) * inv * g1[3]);
            qf[kk] = __builtin_bit_cast(bf16x8, o); }
        const uint4 wa = __builtin_bit_cast(uint4, qf[4]), wb = __builtin_bit_cast(uint4, qf[5]);
        const float* rp = ROPEp + ((size_t)(pos0 + wid * 32 + ql) * 16 + half * 8) * 2;
        const float* ga = gq + 64 + half * 8; const float* gb = gq + 80 + half * 8;
        float x1[8] = {bflo(wa.x), bfhi(wa.x), bflo(wa.y), bfhi(wa.y), bflo(wa.z), bfhi(wa.z), bflo(wa.w), bfhi(wa.w)};
        float x2[8] = {bflo(wb.x), bfhi(wb.x), bflo(wb.y), bfhi(wb.y), bflo(wb.z), bfhi(wb.z), bflo(wb.w), bfhi(wb.w)};
        float r1[8], r2[8];
#pragma unroll
        for (int q4 = 0; q4 < 2; ++q4) {
            const f32x4 g1v = ld_f4(ga + q4 * 4), g2v = ld_f4(gb + q4 * 4), csA = ld_f4(rp + q4 * 8), csB = ld_f4(rp + q4 * 8 + 4);
            const float co[4] = {csA[0], csA[2], csB[0], csB[2]}, si[4] = {csA[1], csA[3], csB[1], csB[3]};
#pragma unroll
            for (int j = 0; j < 4; ++j) { const float a = x1[q4 * 4 + j] * inv * g1v[j], b = x2[q4 * 4 + j] * inv * g2v[j]; r1[q4 * 4 + j] = a * co[j] - b * si[j]; r2[q4 * 4 + j] = b * co[j] + a * si[j]; }
        }
        uint4 oa, ob;
        oa.x = pk2(r1[0], r1[1]); oa.y = pk2(r1[2], r1[3]); oa.z = pk2(r1[4], r1[5]); oa.w = pk2(r1[6], r1[7]);
        ob.x = pk2(r2[0], r2[1]); ob.y = pk2(r2[2], r2[3]); ob.z = pk2(r2[4], r2[5]); ob.w = pk2(r2[6], r2[7]);
        qf[4] = __builtin_bit_cast(bf16x8, oa); qf[5] = __builtin_bit_cast(bf16x8, ob);
    }
    f32x16 accO[2];
#pragma unroll
    for (int db = 0; db < 2; ++db)
#pragma unroll
        for (int r = 0; r < 16; ++r) accO[db][r] = 0.f;
    float m_run = -INFINITY, l_run = 0.f;
    uint4 kreg[3], vreg[2];
#define AM_LOAD(t) do { const int s0_ = (t) * 128; \
        _Pragma("unroll") for (int i = 0; i < 3; ++i) { const int c = tx + 512 * i, row = c / 12, kc = c % 12; kreg[i] = *(const uint4*)(Kp + (size_t)(s0_ + row) * 768 + kc * 8); } \
        _Pragma("unroll") for (int i = 0; i < 2; ++i) { const int c = tx + 512 * i, d = c >> 4, kc = c & 15; vreg[i] = *(const uint4*)(Vtp + (size_t)d * vt_rs + s0_ + kc * 8); } } while (0)
#define AM_STORE(buf) do { unsigned char* Ks_ = smem + (buf) * STAGE; unsigned char* Vs_ = Ks_ + KT_BYTES; \
        _Pragma("unroll") for (int i = 0; i < 3; ++i) { const int c = tx + 512 * i, row = c / 12, kc = c % 12; *(uint4*)(Ks_ + row * KROW + kc * 16) = kreg[i]; } \
        _Pragma("unroll") for (int i = 0; i < 2; ++i) { const int c = tx + 512 * i, d = c >> 4, kc = c & 15; uint2 lo_, hi_; lo_.x = vreg[i].x; lo_.y = vreg[i].y; hi_.x = vreg[i].z; hi_.y = vreg[i].w; \
            *(uint2*)(Vs_ + d * VROW + kc * 16) = lo_; *(uint2*)(Vs_ + d * VROW + kc * 16 + 8) = hi_; } } while (0)
    const int nt = nkeys >> 7;
    AM_LOAD(0); AM_STORE(0); __syncthreads();
    for (int t = 0; t < nt; ++t) {
        const bool more = t + 1 < nt;
        if (more) AM_LOAD(t + 1);
        const unsigned char* Ks = smem + (t & 1) * STAGE;
        const unsigned char* Vs = Ks + KT_BYTES;
        f32x16 s[4];
#pragma unroll
        for (int kb = 0; kb < 4; ++kb)
#pragma unroll
            for (int r = 0; r < 16; ++r) s[kb][r] = 0.f;
#pragma unroll
        for (int kk = 0; kk < 6; ++kk)
#pragma unroll
            for (int kb = 0; kb < 4; ++kb) {
                const bf16x8 kf = *(const bf16x8*)(Ks + (kb * 32 + ql) * KROW + kk * 32 + half * 16);
                s[kb] = __builtin_amdgcn_mfma_f32_32x32x16_bf16(kf, qf[kk], s[kb], 0, 0, 0);
            }
        float mx = -INFINITY;
#pragma unroll
        for (int kb = 0; kb < 4; ++kb)
#pragma unroll
            for (int r = 0; r < 16; r += 2) mx = fmaxf(fmaxf(mx, s[kb][r]), s[kb][r + 1]);
        mx = fmaxf(mx, __shfl_xor(mx, 32));
        const float m_new = fmaxf(m_run, mx);
        if (__any(m_new > m_run)) {
            const float alpha = __builtin_amdgcn_exp2f(m_run - m_new);
            l_run *= alpha;
#pragma unroll
            for (int db = 0; db < 2; ++db)
#pragma unroll
                for (int r = 0; r < 16; ++r) accO[db][r] *= alpha;
        }
        m_run = m_new;
        float psum = 0.f;
#pragma unroll
        for (int kb = 0; kb < 4; ++kb)
#pragma unroll
            for (int r = 0; r < 16; ++r) { const float pv = __builtin_amdgcn_exp2f(s[kb][r] - m_new); s[kb][r] = pv; psum += pv; }
        l_run += psum;
#pragma unroll
        for (int kb = 0; kb < 4; ++kb)
#pragma unroll
            for (int p2 = 0; p2 < 2; ++p2) {
                uint4 pw;
                pw.x = pk2(s[kb][8 * p2 + 0], s[kb][8 * p2 + 1]); pw.y = pk2(s[kb][8 * p2 + 2], s[kb][8 * p2 + 3]);
                pw.z = pk2(s[kb][8 * p2 + 4], s[kb][8 * p2 + 5]); pw.w = pk2(s[kb][8 * p2 + 6], s[kb][8 * p2 + 7]);
                const bf16x8 pf = __builtin_bit_cast(bf16x8, pw);
#pragma unroll
                for (int db = 0; db < 2; ++db) {
                    const unsigned char* vp = Vs + (db * 32 + ql) * VROW + (kb * 32 + 16 * p2 + half * 4) * 2;
                    const uint2 vlo = *(const uint2*)vp, vhi = *(const uint2*)(vp + 16);
                    uint4 vw; vw.x = vlo.x; vw.y = vlo.y; vw.z = vhi.x; vw.w = vhi.y;
                    accO[db] = __builtin_amdgcn_mfma_f32_32x32x16_bf16(__builtin_bit_cast(bf16x8, vw), pf, accO[db], 0, 0, 0);
                }
            }
        if (more) AM_STORE((t + 1) & 1);
        __syncthreads();
    }
#undef AM_LOAD
#undef AM_STORE
    const float l = l_run + __shfl_xor(l_run, 32);
    const float inv = 1.f / l;
    bf16_t* orow = Op + (size_t)(wid * 32 + ql) * 512 + half * 4;
#pragma unroll
    for (int db = 0; db < 2; ++db)
#pragma unroll
        for (int g = 0; g < 4; ++g) {
            f32x4 v = {accO[db][4 * g] * inv, accO[db][4 * g + 1] * inv, accO[db][4 * g + 2] * inv, accO[db][4 * g + 3] * inv};
            st_bf4(orow + db * 32 + 8 * g, v);
        }
}

namespace pg8 {
#define PG8_LAS __attribute__((address_space(3)))
typedef unsigned short bf16_t;
typedef short bf16x8 __attribute__((ext_vector_type(8)));
typedef float f32x4 __attribute__((ext_vector_type(4)));
typedef unsigned u32x4 __attribute__((ext_vector_type(4)));
constexpr int BM = 256, BK = 64, HALF = 128, HTB = HALF * BK * 2  , STAGE_BYTES = 8 * HTB, NXCD = 8, WGM = 8;

__host__ __device__ __forceinline__ int lds_byte(int r, int c) { const int st = (r >> 4) * 2 + (c >> 5), rr = r & 15, cc = c & 31, ob = rr * 64 + cc * 2; return st * 1024 + (ob ^ (((ob >> 9) & 1) << 5)); }
__host__ __device__ __forceinline__ void stage_rc(int b, int& R, int& C) { const int st = b / 1024, sb = b % 1024, swz = sb ^ (((sb >> 9) & 1) << 5); R = (st >> 1) * 16 + swz / 64; C = (st & 1) * 32 + (swz % 64) / 2; }
__host__ __device__ __forceinline__ int perm32(int rho) { const int n = rho >> 4, i = rho & 15; return 8 * (i >> 2) + 4 * n + (i & 3); }

struct Unit { int pm, pn; };
struct Gemm { const bf16_t* A; const bf16_t* Bt; int M, N, K, lda, ldb; size_t kstepA, kstepB; };

struct StaticOrder {
    int nM, nN, nwg, G, c;
    __host__ __device__ void init(int M, int N, int G_, int c_) { nM = M / BM; nN = N / BM; nwg = nM * nN; G = G_; c = c_; }
    __host__ __device__ bool next(int i, Unit& u) const {
        const long L = (long)i * G + c; if (L >= nwg) return false;
        int wgid = (int)L; { const int q = nwg / NXCD, r = nwg % NXCD, xcd = wgid % NXCD, off = wgid / NXCD; wgid = (xcd < r ? xcd * (q + 1) : r * (q + 1) + (xcd - r) * q) + off; }
        const int nig = WGM * nN, gid = wgid / nig, fm = gid * WGM, gsz = (nM - fm) < WGM ? (nM - fm) : WGM;
        u.pm = fm + ((wgid % nig) % gsz); u.pn = (wgid % nig) / gsz; return true;
    }
    __device__ __forceinline__ void a_ready(const Unit&) const {}
    __device__ __forceinline__ void done(const Unit&) const {}
};


DEVI float rs_inv(const float* rs, int row) { return rsqrtf(rs[row] * (1.f / 1024.f) + EPS); }
struct EpiGU {
    static constexpr bool PERM = false, AFTER_DRAIN = false;
    bf16_t* HID; const float* rs;
    __device__ __forceinline__ void operator()(const f32x4 (&acc)[2][2][4][2], const Unit& u, int wr, int wc, int fr, int fq) const {
        asm volatile("" : "+v"(fr), "+v"(fq));
#pragma unroll
        for (int ai = 0; ai < 2; ++ai)
#pragma unroll
            for (int m = 0; m < 4; ++m) {
                const int row = u.pm * BM + ai * HALF + wr * 64 + m * 16 + fr; const float ri = rs_inv(rs, row);
                bf16_t* rowp = HID + ((size_t)(u.pn * 2) * NTOK + (size_t)(u.pm * 2 + ai) * 128) * 64 + ((wr * 4 + m) * 4 + wc) * 256 + fr * 16 + fq * 4;
#pragma unroll
                for (int bj = 0; bj < 2; ++bj) {
                    const f32x4 g = acc[ai][bj][m][0] * ri, up = acc[ai][bj][m][1] * ri; f32x4 h;
#pragma unroll
                    for (int j = 0; j < 4; ++j) h[j] = g[j] * __builtin_amdgcn_rcpf(1.f + __expf(-g[j])) * up[j];
                    ::st_bf4(rowp + (size_t)bj * NTOK * 64, h);
                }
            }
    }
};
template <int RES> struct EpiRes {
    static constexpr bool PERM = false, AFTER_DRAIN = false;
    const float* rf0; const float* rf1; const bf16_t* rb; bf16_t* out; float* rs; float scale;
    __device__ __forceinline__ void operator()(const f32x4 (&acc)[2][2][4][2], const Unit& u, int wr, int wc, int fr, int fq) const {
        asm volatile("" : "+v"(fr), "+v"(fq));
#pragma unroll
        for (int ai = 0; ai < 2; ++ai) {
            const int row0 = u.pm * BM + ai * HALF + wr * 64 + fr, col0 = u.pn * BM + wc * 32 + fq * 4;
            f32x4 r[4][2][2];
#pragma unroll
            for (int m = 0; m < 4; ++m) {
                const int row = row0 + m * 16;
                const float* rp = (row < 16384 ? rf0 + (size_t)row * 1024 : rf1 + (size_t)(row - 16384) * 1024) + col0;
#pragma unroll
                for (int bj = 0; bj < 2; ++bj)
#pragma unroll
                    for (int n = 0; n < 2; ++n) r[m][bj][n] = RES == 0 ? ::ld_f4(rp + bj * HALF + n * 16) : ::ld_bf4(rb + (size_t)row * 1024 + col0 + bj * HALF + n * 16);
            }
#pragma unroll
            for (int m = 0; m < 4; ++m) {
                const int row = row0 + m * 16;
                float ss = 0.f;
#pragma unroll
                for (int bj = 0; bj < 2; ++bj)
#pragma unroll
                    for (int n = 0; n < 2; ++n) {
                        const f32x4 o = r[m][bj][n] + acc[ai][bj][m][n] * scale;
                        ss += ::dot4(o);
                        ::st_bf4(out + (size_t)row * 1024 + col0 + bj * HALF + n * 16, o);
                    }
                ss = ::red4q(ss);
                if (fq == 0) atomicAdd(rs + row, ss);
            }
        }
    }
};
struct EpiFinal {
    static constexpr bool PERM = false, AFTER_DRAIN = false;
    const bf16_t* rb; float* out;
    __device__ __forceinline__ void operator()(const f32x4 (&acc)[2][2][4][2], const Unit& u, int wr, int wc, int fr, int fq) const {
        asm volatile("" : "+v"(fr), "+v"(fq));
#pragma unroll
        for (int ai = 0; ai < 2; ++ai)
#pragma unroll
            for (int m = 0; m < 4; ++m) {
                const size_t off = (size_t)(u.pm * BM + ai * HALF + wr * 64 + m * 16 + fr) * 1024 + u.pn * BM + wc * 32 + fq * 4;
#pragma unroll
                for (int bj = 0; bj < 2; ++bj)
#pragma unroll
                    for (int n = 0; n < 2; ++n) { const f32x4 o = ::ld_bf4(rb + off + bj * HALF + n * 16) + acc[ai][bj][m][n] * 0.5f; *(float4*)(out + off + bj * HALF + n * 16) = make_float4(o[0], o[1], o[2], o[3]); }
            }
    }
};

struct EpiQ {
    static constexpr bool PERM = false, AFTER_DRAIN = false;
    const float* RSQ; bf16_t* Q;
    __device__ __forceinline__ void operator()(const f32x4 (&acc)[2][2][4][2], const Unit& u, int wr, int wc, int fr, int fq) const {
        asm volatile("" : "+v"(fr), "+v"(fq));
#pragma unroll
        for (int ai = 0; ai < 2; ++ai)
#pragma unroll
            for (int m = 0; m < 4; ++m) {
                const int row = u.pm * BM + ai * HALF + wr * 64 + m * 16 + fr; const float ri = rsqrtf(RSQ[row] * (1.f / 384.f) + EPS);
                bf16_t* d = Q + (size_t)row * 768 + u.pn * BM + wc * 32 + fq * 4;
#pragma unroll
                for (int bj = 0; bj < 2; ++bj)
#pragma unroll
                    for (int n = 0; n < 2; ++n) ::st_bf4(d + bj * HALF + n * 16, acc[ai][bj][m][n] * ri);
            }
    }
};
struct EpiK {
    static constexpr bool PERM = false, AFTER_DRAIN = false;
    const float* RSKV; const bf16_t* CKV; const float* gk; const float* ROPE; bf16_t* K;
    __device__ __forceinline__ void operator()(const f32x4 (&acc)[2][2][4][2], const Unit& u, int wr, int wc, int fr, int fq) const {
        asm volatile("" : "+v"(fr), "+v"(fq));
        const int h = u.pn * 4 + wc;
#pragma unroll
        for (int ai = 0; ai < 2; ++ai)
#pragma unroll
            for (int m = 0; m < 4; ++m) {
                const int row = u.pm * BM + ai * HALF + wr * 64 + m * 16 + fr; const float ri = rsqrtf(RSKV[row] * (1.f / 256.f) + EPS);
                f32x4 v[2][2]; float s = 0.f;
#pragma unroll
                for (int bj = 0; bj < 2; ++bj)
#pragma unroll
                    for (int n = 0; n < 2; ++n) { v[bj][n] = acc[ai][bj][m][n] * ri; s += ::dot4(v[bj][n]); }
                const f32x4 kr1 = ::ld_bf4(CKV + (size_t)row * 288 + 256 + fq * 4), kr2 = ::ld_bf4(CKV + (size_t)row * 288 + 272 + fq * 4);
                s += ::dot4(kr1) + ::dot4(kr2);
                s = ::red4q(s);
                const float inv = rsqrtf(s * (1.f / 96.f) + EPS);
                bf16_t* dst = K + ((size_t)row * 8 + h) * 96;
#pragma unroll
                for (int bj = 0; bj < 2; ++bj)
#pragma unroll
                    for (int n = 0; n < 2; ++n) { const int c = bj * 32 + n * 16 + fq * 4; ::st_bf4(dst + c, v[bj][n] * inv * ::ld_f4(gk + c)); }
                const int pos = ::tok_pos(row);
                const f32x4 x1 = kr1 * inv * ::ld_f4(gk + 64 + fq * 4), x2 = kr2 * inv * ::ld_f4(gk + 80 + fq * 4);
                const f32x4 cs0 = ::ld_f4(ROPE + ((size_t)pos * 16 + fq * 4) * 2), cs1 = ::ld_f4(ROPE + ((size_t)pos * 16 + fq * 4) * 2 + 4);
                const f32x4 co = {cs0[0], cs0[2], cs1[0], cs1[2]}, si = {cs0[1], cs0[3], cs1[1], cs1[3]};
                ::st_bf4(dst + 64 + fq * 4, x1 * co - x2 * si);
                ::st_bf4(dst + 80 + fq * 4, x2 * co + x1 * si);
            }
    }
};
struct EpiVt {
    static constexpr bool PERM = false, AFTER_DRAIN = false;
    const float* RSKV; bf16_t* VT;
    __device__ __forceinline__ void operator()(const f32x4 (&acc)[2][2][4][2], const Unit& u, int wr, int wc, int fr, int fq) const {
        asm volatile("" : "+v"(fr), "+v"(fq));
#pragma unroll
        for (int bj = 0; bj < 2; ++bj)
#pragma unroll
            for (int n = 0; n < 2; ++n) {
                const int tok0 = u.pn * BM + bj * HALF + wc * 32 + n * 16 + fq * 4;
                f32x4 ric = ::ld_f4(RSKV + tok0);
#pragma unroll
                for (int j = 0; j < 4; ++j) ric[j] = rsqrtf(ric[j] * (1.f / 256.f) + EPS);
#pragma unroll
                for (int ai = 0; ai < 2; ++ai)
#pragma unroll
                    for (int m = 0; m < 4; ++m) {
                        const int hd = u.pm * BM + ai * HALF + wr * 64 + m * 16 + fr, h = hd >> 6, d = hd & 63;
                        size_t off;
                        if (tok0 < 16384) off = ((size_t)((tok0 >> 13) * 8 + h) * 64 + d) * 8192 + (tok0 & 8191);
                        else { const int tt = tok0 - 16384; off = (size_t)8388608 + ((size_t)((tt >> 12) * 8 + h) * 64 + d) * 4096 + (tt & 4095); }
                        ::st_bf4(VT + off, acc[ai][bj][m][n] * ric);
                    }
            }
    }
};
struct EpiIn1 {
    static constexpr bool PERM = false, AFTER_DRAIN = false;
    const float* rs1; bf16_t* CQ; bf16_t* CKV; bf16_t* XQ; float* RSQ; float* RSKV;
    __device__ __forceinline__ void operator()(const f32x4 (&acc)[2][2][4][2], const Unit& u, int wr, int wc, int fr, int fq) const {
        asm volatile("" : "+v"(fr), "+v"(fq));
#pragma unroll
        for (int bj = 0; bj < 2; ++bj) {
            const int cg = u.pn * BM + bj * HALF + wc * 32;
            bf16_t* dst; int ld, c0; float* rs = nullptr;
            if (cg < 384) { dst = CQ; ld = 384; c0 = cg; rs = RSQ; }
            else if (cg < 640) { dst = CKV; ld = 288; c0 = cg - 384; rs = RSKV; }
            else if (cg < 672) { dst = CKV; ld = 288; c0 = 256 + (cg - 640); }
            else if (cg < 768) continue;
            else { dst = XQ; ld = 512; c0 = cg - 768; }
#pragma unroll
            for (int ai = 0; ai < 2; ++ai)
#pragma unroll
                for (int m = 0; m < 4; ++m) {
                    const int row = u.pm * BM + ai * HALF + wr * 64 + m * 16 + fr; const float ri = rs_inv(rs1, row);
                    const f32x4 v0 = acc[ai][bj][m][0] * ri, v1 = acc[ai][bj][m][1] * ri;
                    ::st_bf4(dst + (size_t)row * ld + c0 + fq * 4, v0); ::st_bf4(dst + (size_t)row * ld + c0 + 16 + fq * 4, v1);
                    if (rs) { const float s = ::red4q(::dot4(v0) + ::dot4(v1)); if (fq == 0) atomicAdd(rs + row, s); }
                }
        }
    }
};
struct EpiIn2 {
    static constexpr bool PERM = false, AFTER_DRAIN = false;
    const float* rs1; bf16_t* CB; bf16_t* U;
    __device__ __forceinline__ void operator()(const f32x4 (&acc)[2][2][4][2], const Unit& u, int wr, int wc, int fr, int fq) const {
        asm volatile("" : "+v"(fr), "+v"(fq));
#pragma unroll
        for (int ai = 0; ai < 2; ++ai)
#pragma unroll
            for (int m = 0; m < 4; ++m) {
                const int row = u.pm * BM + ai * HALF + wr * 64 + m * 16 + fr; const float ri = rs_inv(rs1, row);
#pragma unroll
                for (int bj = 0; bj < 2; ++bj) {
                    const f32x4 v0 = acc[ai][bj][m][0] * ri, v1 = acc[ai][bj][m][1] * ri;
                    if (u.pn < 2) { bf16_t* d = CB + (size_t)row * 512 + u.pn * BM + bj * HALF + wc * 32 + fq * 4; ::st_bf4(d, v0); ::st_bf4(d + 16, v1); }
                    else ::st_bf4(U + (size_t)row * 512 + (u.pn - 2) * 128 + bj * 64 + wc * 16 + fq * 4, v0 * v1);
                }
            }
    }
};
template <class Epi, class Sched, bool ALIGN_EPI = false, bool SP2 = false>
__device__ __forceinline__ void gemm_phase(PG8_LAS unsigned char* lds, const Gemm g, const Sched& S, const Epi& E) {
    int tid_ = threadIdx.x; asm volatile("" : "+v"(tid_));
    const int tid = tid_, wid = __builtin_amdgcn_readfirstlane(tid >> 6), lane = tid & 63, wr = wid >> 2, wc = wid & 3, fr = lane & 15, fq = lane >> 4;
    const int K = g.K, nt = K / BK;
    unsigned voffA[2], voffB[2];
#pragma unroll
    for (int i = 0; i < 2; ++i) { int R, C; stage_rc(tid * 16 + i * 8192, R, C); const int Rb = Epi::PERM ? ((R & ~31) + perm32(R & 31)) : R;
        voffA[i] = g.lda ? (unsigned)(R * g.lda + C) * 2u : (unsigned)(((R >> 4) * 4 + (C >> 4)) * 512 + (R & 15) * 32 + ((C >> 3) & 1) * 16);
        voffB[i] = (unsigned)(Rb * g.ldb + C) * 2u; }
    const size_t kstepA = g.kstepA, kstepB = g.kstepB;
    const size_t hstepA = (size_t)HALF * (g.lda ? g.lda : 64) * 2, hstepB = (size_t)HALF * g.ldb * 2;
    const size_t tstepA = 2 * hstepA, tstepB = 2 * hstepB;
    const unsigned ldsw = (unsigned)wid * 1024u;
    const int aoff = lds_byte(wr * 64 + fr, fq * 8), boff = lds_byte(wc * 32 + fr, fq * 8);
#define PG8_SA(b, h) (((b) * 2 + (h)) * HTB)
#define PG8_SB(b, h) ((4 + (b) * 2 + (h)) * HTB)
#define PG8_STAGE(bufoff, gbase, voff) do { _Pragma("unroll") for (int _i = 0; _i < 2; ++_i) \
        __builtin_amdgcn_global_load_lds((const unsigned*)((const char*)(gbase) + (voff)[_i]), (PG8_LAS unsigned*)(lds + (bufoff) + ldsw + _i * 8192), 16, 0, 0); } while (0)
#define PG8_LDA(dst, b, h) do { _Pragma("unroll") for (int m = 0; m < 4; ++m) _Pragma("unroll") for (int k = 0; k < 2; ++k) dst[m][k] = *(const PG8_LAS bf16x8*)(lds + PG8_SA(b, h) + aoff + m * 2048 + k * 1024); } while (0)
#define PG8_LDB(dst, b, h) do { _Pragma("unroll") for (int n = 0; n < 2; ++n) _Pragma("unroll") for (int k = 0; k < 2; ++k) dst[n][k] = *(const PG8_LAS bf16x8*)(lds + PG8_SB(b, h) + boff + n * 2048 + k * 1024); } while (0)
#define PG8_MMA(ai, bj, At, Bt) do { __builtin_amdgcn_s_setprio(1); _Pragma("unroll") for (int m = 0; m < 4; ++m) _Pragma("unroll") for (int n = 0; n < 2; ++n) _Pragma("unroll") for (int k = 0; k < 2; ++k) \
        acc[ai][bj][m][n] = __builtin_amdgcn_mfma_f32_16x16x32_bf16(Bt[n][k], At[m][k], acc[ai][bj][m][n], 0, 0, 0); __builtin_amdgcn_s_setprio(0); } while (0)
#define PG8_WAIT_V(n) asm volatile("s_waitcnt vmcnt(" #n ")" ::: "memory")
#define PG8_WAIT_L(n) asm volatile("s_waitcnt lgkmcnt(" #n ")" ::: "memory")
#define PG8_BAR __builtin_amdgcn_s_barrier()
#define PG8_SCHED __builtin_amdgcn_sched_barrier(0)
    Unit cur, nxt; int ui = 0;
    if (!S.next(0, cur)) return;
    f32x4 acc[2][2][4][2];
#pragma unroll
    for (int a = 0; a < 2; ++a)
#pragma unroll
        for (int b = 0; b < 2; ++b)
#pragma unroll
            for (int m = 0; m < 4; ++m)
#pragma unroll
                for (int n = 0; n < 2; ++n) acc[a][b][m][n] = (f32x4){0.f, 0.f, 0.f, 0.f};
    bf16x8 At[4][2], B0[2][2], B1[2][2];
    const char* cA = (const char*)g.A + (size_t)cur.pm * tstepA; const char* cB = (const char*)g.Bt + (size_t)cur.pn * tstepB;
    S.a_ready(cur);
    if constexpr (SP2) {
        PG8_STAGE(PG8_SB(0, 0), cB, voffB); PG8_STAGE(PG8_SB(0, 1), cB + hstepB, voffB); PG8_STAGE(PG8_SA(0, 0), cA, voffA); PG8_STAGE(PG8_SA(0, 1), cA + hstepA, voffA);
        if (wr == 1) PG8_BAR;
        PG8_WAIT_V(2); PG8_BAR;
        PG8_STAGE(PG8_SB(1, 0), cB + kstepB, voffB); PG8_STAGE(PG8_SA(1, 0), cA + kstepA, voffA); PG8_STAGE(PG8_SB(1, 1), cB + hstepB + kstepB, voffB);
        PG8_WAIT_V(6); PG8_BAR;
    } else {
        PG8_STAGE(PG8_SB(0, 0), cB, voffB); PG8_STAGE(PG8_SA(0, 0), cA, voffA); PG8_STAGE(PG8_SB(0, 1), cB + hstepB, voffB); PG8_STAGE(PG8_SA(0, 1), cA + hstepA, voffA);
        if (wr == 1) PG8_BAR;
        PG8_WAIT_V(4); PG8_BAR;
        PG8_STAGE(PG8_SB(1, 0), cB + kstepB, voffB); PG8_STAGE(PG8_SA(1, 0), cA + kstepA, voffA); PG8_STAGE(PG8_SB(1, 1), cB + hstepB + kstepB, voffB);
        PG8_WAIT_V(6); PG8_BAR;
    }
    for (;;) {
        const bool has_next = S.next(ui + 1, nxt);
        const char* nA = has_next ? (const char*)g.A + (size_t)nxt.pm * tstepA : cA; const char* nB = has_next ? (const char*)g.Bt + (size_t)nxt.pn * tstepB : cB;
        for (int t = 0; t < nt; t += 2) {
            const bool last = (t == nt - 2);
            const char* a1 = cA + (size_t)(t + 1) * kstepA;
            const char* a2 = last ? nA : cA + (size_t)(t + 2) * kstepA; const char* b2 = last ? nB : cB + (size_t)(t + 2) * kstepB;
            const char* a3 = a2 + kstepA; const char* b3 = b2 + kstepB;
            if (last && has_next) S.a_ready(nxt);
            if constexpr (SP2) {
            PG8_LDB(B0, 0, 0); PG8_LDB(B1, 0, 1); PG8_SCHED; PG8_LDA(At, 0, 0); PG8_STAGE(PG8_SA(1, 1), a1 + hstepA, voffA);
            PG8_WAIT_V(8); PG8_WAIT_L(0); PG8_BAR; PG8_MMA(0, 0, At, B0); PG8_MMA(0, 1, At, B1); PG8_BAR; PG8_SCHED;
            PG8_LDA(At, 0, 1); PG8_STAGE(PG8_SB(0, 0), b2, voffB); PG8_STAGE(PG8_SB(0, 1), b2 + hstepB, voffB); PG8_STAGE(PG8_SA(0, 0), a2, voffA);
            PG8_WAIT_V(8); PG8_WAIT_L(0); PG8_BAR; PG8_MMA(1, 0, At, B0); PG8_MMA(1, 1, At, B1); PG8_BAR; PG8_SCHED;
            PG8_LDB(B0, 1, 0); PG8_LDB(B1, 1, 1); PG8_SCHED; PG8_LDA(At, 1, 0); PG8_STAGE(PG8_SA(0, 1), a2 + hstepA, voffA);
            PG8_WAIT_V(8); PG8_WAIT_L(0); PG8_BAR; PG8_MMA(0, 0, At, B0); PG8_MMA(0, 1, At, B1); PG8_BAR; PG8_SCHED;
            PG8_LDA(At, 1, 1); PG8_STAGE(PG8_SB(1, 0), b3, voffB); PG8_STAGE(PG8_SB(1, 1), b3 + hstepB, voffB); PG8_STAGE(PG8_SA(1, 0), a3, voffA);
            PG8_WAIT_V(8); PG8_WAIT_L(0); PG8_BAR; PG8_MMA(1, 0, At, B0); PG8_MMA(1, 1, At, B1); PG8_BAR; PG8_SCHED;
            } else {
            PG8_LDB(B0, 0, 0); PG8_SCHED; PG8_LDA(At, 0, 0); PG8_STAGE(PG8_SA(1, 1), a1 + hstepA, voffA);
            PG8_WAIT_L(8); PG8_BAR; PG8_WAIT_L(0); PG8_MMA(0, 0, At, B0); PG8_BAR; PG8_SCHED;
            PG8_LDB(B1, 0, 1); PG8_STAGE(PG8_SB(0, 0), b2, voffB);
            PG8_BAR; PG8_WAIT_L(0); PG8_MMA(0, 1, At, B1); PG8_BAR;
            PG8_LDA(At, 0, 1); PG8_STAGE(PG8_SA(0, 0), a2, voffA);
            PG8_BAR; PG8_WAIT_L(0); PG8_MMA(1, 0, At, B0); PG8_BAR; PG8_SCHED;
            PG8_STAGE(PG8_SB(0, 1), b2 + hstepB, voffB);
            PG8_WAIT_V(6); PG8_BAR; PG8_MMA(1, 1, At, B1); PG8_BAR;
            PG8_LDB(B0, 1, 0); PG8_SCHED; PG8_LDA(At, 1, 0); PG8_STAGE(PG8_SA(0, 1), a2 + hstepA, voffA);
            PG8_WAIT_L(8); PG8_BAR; PG8_WAIT_L(0); PG8_MMA(0, 0, At, B0); PG8_BAR; PG8_SCHED;
            PG8_LDB(B1, 1, 1); PG8_STAGE(PG8_SB(1, 0), b3, voffB);
            PG8_BAR; PG8_WAIT_L(0); PG8_MMA(0, 1, At, B1); PG8_BAR;
            PG8_LDA(At, 1, 1); PG8_STAGE(PG8_SA(1, 0), a3, voffA);
            PG8_BAR; PG8_WAIT_L(0); PG8_MMA(1, 0, At, B0); PG8_BAR; PG8_SCHED;
            PG8_STAGE(PG8_SB(1, 1), b3 + hstepB, voffB);
            PG8_WAIT_V(6); PG8_BAR; PG8_MMA(1, 1, At, B1); PG8_BAR;
            }
        }
        if constexpr (ALIGN_EPI) { if (wr == 0) PG8_BAR; }
        if constexpr (!Epi::AFTER_DRAIN) { E(acc, cur, wr, wc, fr, fq); S.done(cur); }
        if (!has_next) break;
#pragma unroll
        for (int a = 0; a < 2; ++a)
#pragma unroll
            for (int b = 0; b < 2; ++b)
#pragma unroll
                for (int m = 0; m < 4; ++m)
#pragma unroll
                    for (int n = 0; n < 2; ++n) acc[a][b][m][n] = (f32x4){0.f, 0.f, 0.f, 0.f};
        cur = nxt; cA = nA; cB = nB; ++ui;
        if constexpr (ALIGN_EPI) { if (wr == 1) PG8_BAR; }
    }
    PG8_WAIT_V(0);
    if constexpr (!ALIGN_EPI) { if (wr == 0) PG8_BAR; }
    PG8_BAR;
    if constexpr (Epi::AFTER_DRAIN) { E.fused(acc, cur, wr, wc, fr, fq, lds, wid, lane); S.done(cur); }
#undef PG8_SA
#undef PG8_SB
#undef PG8_STAGE
#undef PG8_LDA
#undef PG8_LDB
#undef PG8_MMA
#undef PG8_WAIT_V
#undef PG8_WAIT_L
#undef PG8_BAR
#undef PG8_SCHED
}
struct MUnit { int pm, pn, b, g; };
template <class Epi>
__device__ __forceinline__ void gemm_phase_merge(PG8_LAS unsigned char* lds, const unsigned char* ws, const bf16_t* XBp, const StaticOrder& S, const Epi& E) {
    int tid_ = threadIdx.x; asm volatile("" : "+v"(tid_));
    const int tid = tid_, wid = __builtin_amdgcn_readfirstlane(tid >> 6), lane = tid & 63, wr = wid >> 2, wc = wid & 3, fr = lane & 15, fq = lane >> 4;
    unsigned vY0, vGd;
    { int R, C; stage_rc(tid * 16, R, C); vY0 = (unsigned)(R * 512 + C) * 2u; vGd = (unsigned)(R * 512) * 2u; }
    constexpr size_t kstep = (size_t)(BK * 2), hY = (size_t)HALF * 512 * 2, hG = (size_t)HALF * 1024 * 2;
    const unsigned ldsw = (unsigned)wid * 1024u;
    const int aoff = lds_byte(wr * 64 + fr, fq * 8), boff = lds_byte(wc * 32 + fr, fq * 8);
#define PG8_SA(b, h) (((b) * 2 + (h)) * HTB)
#define PG8_SB(b, h) ((4 + (b) * 2 + (h)) * HTB)
#define PG8_STAGE(bufoff, gbase, voff, q64) do { const char* gb0_ = (const char*)(gbase); const char* gb1_ = gb0_ + (q64); unsigned vo_ = (voff); \
        asm volatile("" : "+s"(gb0_)); asm volatile("" : "+s"(gb1_)); asm volatile("" : "+v"(vo_));        \
        __builtin_amdgcn_global_load_lds((const unsigned*)(gb0_ + vo_), (PG8_LAS unsigned*)(lds + (bufoff) + ldsw), 16, 0, 0); \
        __builtin_amdgcn_global_load_lds((const unsigned*)(gb1_ + vo_), (PG8_LAS unsigned*)(lds + (bufoff) + ldsw + 8192), 16, 0, 0); } while (0)
#define PG8_LDA(dst, b, h) do { _Pragma("unroll") for (int m = 0; m < 4; ++m) _Pragma("unroll") for (int k = 0; k < 2; ++k) dst[m][k] = *(const PG8_LAS bf16x8*)(lds + PG8_SA(b, h) + aoff + m * 2048 + k * 1024); } while (0)
#define PG8_LDB(dst, b, h) do { _Pragma("unroll") for (int n = 0; n < 2; ++n) _Pragma("unroll") for (int k = 0; k < 2; ++k) dst[n][k] = *(const PG8_LAS bf16x8*)(lds + PG8_SB(b, h) + boff + n * 2048 + k * 1024); } while (0)
#define PG8_MMA(ai, bj, At, Bt) do { __builtin_amdgcn_s_setprio(1); _Pragma("unroll") for (int m = 0; m < 4; ++m) _Pragma("unroll") for (int n = 0; n < 2; ++n) _Pragma("unroll") for (int k = 0; k < 2; ++k) \
        acc[ai][bj][m][n] = __builtin_amdgcn_mfma_f32_16x16x32_bf16(Bt[n][k], At[m][k], acc[ai][bj][m][n], 0, 0, 0); __builtin_amdgcn_s_setprio(0); } while (0)
#define PG8_WAIT_V(n) asm volatile("s_waitcnt vmcnt(" #n ")" ::: "memory")
#define PG8_WAIT_L(n) asm volatile("s_waitcnt lgkmcnt(" #n ")" ::: "memory")
#define PG8_BAR __builtin_amdgcn_s_barrier()
#define PG8_SCHED __builtin_amdgcn_sched_barrier(0)
#define MU_NEXT(i, u, ok) do { Unit t_; const int ti_ = (i) / 6, sub_ = (i) - 6 * ti_; ok = S.next(ti_, t_); u.pm = t_.pm; u.pn = t_.pn; u.b = sub_ >> 1; u.g = sub_ & 1; } while (0)
#define MU_BASEA(u) ((u).g ? (const char*)XBp + (size_t)(u).pm * (2 * hG) : (const char*)ws + ((u).b == 0 ? OFF_AO : ((u).b == 1 ? OFF_CB : OFF_XQ)) + (size_t)(u).pm * (2 * hY))
#define MU_BASEB(u) ((u).g ? (const char*)ws + OFF_W_GATE + ((size_t)(u).b * 1024 + (size_t)(u).pn * 256) * 2048 : (const char*)ws + OFF_W_OMLA + (size_t)(u).b * 1048576 + (size_t)(u).pn * (2 * hY))
    MUnit cur, nxt; int ui = 0; bool ok0;
    MU_NEXT(0, cur, ok0);
    if (!ok0) return;
    f32x4 acc[2][2][4][2];
#pragma unroll
    for (int a = 0; a < 2; ++a)
#pragma unroll
        for (int b = 0; b < 2; ++b)
#pragma unroll
            for (int m = 0; m < 4; ++m)
#pragma unroll
                for (int n = 0; n < 2; ++n) acc[a][b][m][n] = (f32x4){0.f, 0.f, 0.f, 0.f};
    bf16x8 At[4][2], B0[2][2], B1[2][2];
    const char* cA = MU_BASEA(cur); const char* cB = MU_BASEB(cur);
    {
        const unsigned vc = cur.g ? vY0 + vGd : vY0; const size_t hc = cur.g ? hG : hY, qc = hc >> 1;
        PG8_STAGE(PG8_SB(0, 0), cB, vc, qc); PG8_STAGE(PG8_SB(0, 1), cB + hc, vc, qc); PG8_STAGE(PG8_SA(0, 0), cA, vc, qc); PG8_STAGE(PG8_SA(0, 1), cA + hc, vc, qc);
        if (wr == 1) PG8_BAR;
        PG8_WAIT_V(2); PG8_BAR;
        PG8_STAGE(PG8_SB(1, 0), cB + kstep, vc, qc); PG8_STAGE(PG8_SA(1, 0), cA + kstep, vc, qc); PG8_STAGE(PG8_SB(1, 1), cB + hc + kstep, vc, qc);
        PG8_WAIT_V(6); PG8_BAR;
    }
    for (;;) {
        bool has_next; MU_NEXT(ui + 1, nxt, has_next);
        const char* nA = has_next ? MU_BASEA(nxt) : cA; const char* nB = has_next ? MU_BASEB(nxt) : cB;
        const int ng = has_next ? nxt.g : cur.g;
        const unsigned vc = cur.g ? vY0 + vGd : vY0, vn = ng ? vY0 + vGd : vY0;
        const size_t hc = cur.g ? hG : hY, hn = ng ? hG : hY, qc = hc >> 1;
        const int nt = cur.g ? 16 : 8;
        for (int t = 0; t < nt; t += 2) {
            const bool last = (t == nt - 2);
            const char* a1 = cA + (size_t)(t + 1) * kstep;
            const char* a2 = last ? nA : cA + (size_t)(t + 2) * kstep; const char* b2 = last ? nB : cB + (size_t)(t + 2) * kstep;
            const char* a3 = a2 + kstep; const char* b3 = b2 + kstep;
            const unsigned v2 = last ? vn : vc; const size_t h2 = last ? hn : hc, q2 = h2 >> 1;
            PG8_LDB(B0, 0, 0); PG8_LDB(B1, 0, 1); PG8_SCHED; PG8_LDA(At, 0, 0); PG8_STAGE(PG8_SA(1, 1), a1 + hc, vc, qc);
            PG8_WAIT_V(8); PG8_WAIT_L(0); PG8_BAR; PG8_MMA(0, 0, At, B0); PG8_MMA(0, 1, At, B1); PG8_BAR; PG8_SCHED;
            PG8_LDA(At, 0, 1); PG8_STAGE(PG8_SB(0, 0), b2, v2, q2); PG8_STAGE(PG8_SB(0, 1), b2 + h2, v2, q2); PG8_STAGE(PG8_SA(0, 0), a2, v2, q2);
            PG8_WAIT_V(8); PG8_WAIT_L(0); PG8_BAR; PG8_MMA(1, 0, At, B0); PG8_MMA(1, 1, At, B1); PG8_BAR; PG8_SCHED;
            PG8_LDB(B0, 1, 0); PG8_LDB(B1, 1, 1); PG8_SCHED; PG8_LDA(At, 1, 0); PG8_STAGE(PG8_SA(0, 1), a2 + h2, v2, q2);
            PG8_WAIT_V(8); PG8_WAIT_L(0); PG8_BAR; PG8_MMA(0, 0, At, B0); PG8_MMA(0, 1, At, B1); PG8_BAR; PG8_SCHED;
            PG8_LDA(At, 1, 1); PG8_STAGE(PG8_SB(1, 0), b3, v2, q2); PG8_STAGE(PG8_SB(1, 1), b3 + h2, v2, q2); PG8_STAGE(PG8_SA(1, 0), a3, v2, q2);
            PG8_WAIT_V(8); PG8_WAIT_L(0); PG8_BAR; PG8_MMA(1, 0, At, B0); PG8_MMA(1, 1, At, B1); PG8_BAR; PG8_SCHED;
        }
        if (wr == 0) PG8_BAR;
        E(acc, cur, wr, wc, fr, fq);
        if (!has_next) break;
#pragma unroll
        for (int a = 0; a < 2; ++a)
#pragma unroll
            for (int b = 0; b < 2; ++b)
#pragma unroll
                for (int m = 0; m < 4; ++m)
#pragma unroll
                    for (int n = 0; n < 2; ++n) acc[a][b][m][n] = (f32x4){0.f, 0.f, 0.f, 0.f};
        cur = nxt; cA = nA; cB = nB; ++ui;
        if (wr == 1) PG8_BAR;
    }
    PG8_WAIT_V(0);
    PG8_BAR;
#undef MU_NEXT
#undef MU_BASEA
#undef MU_BASEB
#undef PG8_SA
#undef PG8_SB
#undef PG8_STAGE
#undef PG8_LDA
#undef PG8_LDB
#undef PG8_MMA
#undef PG8_WAIT_V
#undef PG8_WAIT_L
#undef PG8_BAR
#undef PG8_SCHED
}
struct EpiMerge {
    uint4* ytile; uint4* stile; const float* rs1; bf16_t* MERGED;
    __device__ __forceinline__ void operator()(const f32x4 (&acc)[2][2][4][2], const MUnit& u, int wr, int wc, int fr, int fq) const {
        asm volatile("" : "+v"(fr), "+v"(fq));
        const int slot = (wr * 4 + wc) * 16 * 64 + fq * 16 + fr;
#pragma unroll
        for (int ai = 0; ai < 2; ++ai) {
            if (!u.g) {
#pragma unroll
                for (int m = 0; m < 4; ++m)
#pragma unroll
                    for (int bj = 0; bj < 2; ++bj) {
                        const f32x4 v0 = acc[ai][bj][m][0], v1 = acc[ai][bj][m][1]; uint4 w;
                        w.x = ::pk2(v0[0], v0[1]); w.y = ::pk2(v0[2], v0[3]); w.z = ::pk2(v1[0], v1[1]); w.w = ::pk2(v1[2], v1[3]);
                        ytile[slot + ((ai * 4 + m) * 2 + bj) * 64] = w;
                    }
            } else {
                uint4 ys[4][2], ss[4][2]; float ri[4];
#pragma unroll
                for (int m = 0; m < 4; ++m) {
                    ri[m] = rs1[u.pm * BM + ai * HALF + wr * 64 + m * 16 + fr];
#pragma unroll
                    for (int bj = 0; bj < 2; ++bj) {
                        ys[m][bj] = ytile[slot + ((ai * 4 + m) * 2 + bj) * 64];
                        if (u.b > 0) ss[m][bj] = stile[slot + ((ai * 4 + m) * 2 + bj) * 64]; else ss[m][bj] = make_uint4(0u, 0u, 0u, 0u);
                    }
                }
#pragma unroll
                for (int m = 0; m < 4; ++m) {
                    const float rinv = rsqrtf(ri[m] * (1.f / 1024.f) + EPS);
                    bf16_t* mp = MERGED + ((size_t)(u.pn * 4 + (wc >> 1)) * NTOK + (size_t)(u.pm * 2 + ai) * 128) * 64 + ((wr * 4 + m) * 4 + (wc & 1) * 2) * 256 + fr * 16 + fq * 4;
#pragma unroll
                    for (int bj = 0; bj < 2; ++bj) {
                        const uint4 yw = ys[m][bj], sw = ss[m][bj];
                        const f32x4 g0 = acc[ai][bj][m][0] * rinv, g1 = acc[ai][bj][m][1] * rinv;
                        const f32x4 y0 = {::bflo(yw.x), ::bfhi(yw.x), ::bflo(yw.y), ::bfhi(yw.y)}, y1 = {::bflo(yw.z), ::bfhi(yw.z), ::bflo(yw.w), ::bfhi(yw.w)};
                        f32x4 v0 = {::bflo(sw.x), ::bfhi(sw.x), ::bflo(sw.y), ::bfhi(sw.y)}, v1 = {::bflo(sw.z), ::bfhi(sw.z), ::bflo(sw.w), ::bfhi(sw.w)};
#pragma unroll
                        for (int j = 0; j < 4; ++j) { v0[j] += y0[j] * __builtin_amdgcn_rcpf(1.f + __expf(-g0[j])); v1[j] += y1[j] * __builtin_amdgcn_rcpf(1.f + __expf(-g1[j])); }
                        if (u.b < 2) {
                            uint4 w; w.x = ::pk2(v0[0], v0[1]); w.y = ::pk2(v0[2], v0[3]); w.z = ::pk2(v1[0], v1[1]); w.w = ::pk2(v1[2], v1[3]);
                            stile[slot + ((ai * 4 + m) * 2 + bj) * 64] = w;
                        } else { ::st_bf4(mp + (size_t)bj * 2 * NTOK * 64, v0); ::st_bf4(mp + (size_t)bj * 2 * NTOK * 64 + 256, v1); }
                    }
                }
            }
        }
    }
};
}

DEVI void copy_rows_bf16(const float* x0, const float* x1, bf16_t* dst, float* rs, int gw, int nw, int lane) {
    for (int row = gw; row < NTOK; row += nw) {
        const float* src = row < 16384 ? x0 + (size_t)row * 1024 : x1 + (size_t)(row - 16384) * 1024;
        f32x4 v[4]; float s = 0.f;
#pragma unroll
        for (int i = 0; i < 4; ++i) { v[i] = ld_f4(src + lane * 4 + 256 * i); s += dot4(v[i]); }
        s += __shfl_xor(s, 1); s += __shfl_xor(s, 2); s += __shfl_xor(s, 4); s += __shfl_xor(s, 8); s += __shfl_xor(s, 16); s += __shfl_xor(s, 32);
        if (lane == 0) rs[row] = s;
#pragma unroll
        for (int i = 0; i < 4; ++i) st_bf4(dst + (size_t)row * 1024 + lane * 4 + 256 * i, v[i]);
    }
}

#define W1GU ((bf16_t*)(ws + OFF_W1GU))
#define W1DN ((bf16_t*)(ws + OFF_W1DN))
#define W2DN ((bf16_t*)(ws + OFF_W2DN))
#define W2GU ((bf16_t*)((unsigned char*)p.out + D1_W2GU))
#define W_OUT ((bf16_t*)((unsigned char*)p.out + D1_WOUT))
#define RS2 ((float*)((unsigned char*)p.out + D1_RS2))
#define RS0 ((float*)(ws + OFF_RS0))
#define RS1 ((float*)(ws + OFF_RS1))
#define XB ((bf16_t*)p.out)
#define XB0 ((bf16_t*)((unsigned char*)p.out + D1_OFF))
#define X2B ((bf16_t*)(ws + OFF_X2B))
#define HID2 ((bf16_t*)(ws + OFF_HID2))
#define W_IN1 ((bf16_t*)(ws + OFF_W_IN1))
#define W_IN2 ((bf16_t*)(ws + OFF_W_IN2))
#define W_GATE ((bf16_t*)(ws + OFF_W_GATE))
#define W_UQ ((bf16_t*)(ws + OFF_W_UQ))
#define W_UK ((bf16_t*)(ws + OFF_W_UK))
#define W_UV ((bf16_t*)(ws + OFF_W_UV))
#define W_OMLA ((bf16_t*)(ws + OFF_W_OMLA))
#define W_OCONV ((bf16_t*)(ws + OFF_W_OCONV))
#define W_OMEM ((bf16_t*)(ws + OFF_W_OMEM))
#define W_MEMK ((bf16_t*)(ws + OFF_W_MEMK))
#define W_MEMV ((bf16_t*)(ws + OFF_W_MEMV))
#define MK ((bf16_t*)(ws + OFF_MK))
#define MVT ((bf16_t*)(ws + OFF_MVT))
#define ROPE ((float*)(ws + OFF_ROPE))
#define RSQ ((float*)(ws + OFF_RSQ))
#define RSKV ((float*)(ws + OFF_RSKV))
#define MN ((bf16_t*)(ws + OFF_MN))
#define XQ ((bf16_t*)(ws + OFF_XQ))
#define CQ ((bf16_t*)(ws + OFF_CQ))
#define CKV ((bf16_t*)(ws + OFF_CKV))
#define Qb ((bf16_t*)(ws + OFF_Q))
#define Kb ((bf16_t*)(ws + OFF_K))
#define VT ((bf16_t*)(ws + OFF_VT))
#define HID ((bf16_t*)(ws + OFF_HID))
#define AO ((bf16_t*)(ws + OFF_AO))
#define CB ((bf16_t*)(ws + OFF_CB))
#define Ub ((bf16_t*)(ws + OFF_U))
#define MERGED ((bf16_t*)(ws + OFF_MERGED))
#define LAS __attribute__((address_space(3)))
#define XB_TMO      128
#define XB_XCNT(j)  (256  + 64 * (j))
#define XB_XSUB(j)  (1280 + 64 * (j))
#define XB_XGEN(j)  (2304 + 64 * (j))
#define XB_TOP      3328
#define XB_TOPGEN   3392
#define XCD_BAR_WORDS 3456
#define XB_SPIN_CAP (1u << 18)

__device__ __forceinline__ unsigned xb_ld(unsigned* p)              { return __hip_atomic_load(p, __ATOMIC_RELAXED, __HIP_MEMORY_SCOPE_AGENT); }
__device__ __forceinline__ unsigned xb_add(unsigned* p, unsigned v) { return __hip_atomic_fetch_add(p, v, __ATOMIC_RELAXED, __HIP_MEMORY_SCOPE_AGENT); }
__device__ __forceinline__ unsigned xb_xcc_id() { return (unsigned)__builtin_amdgcn_s_getreg((3 << 11) | 20) & 0xFu; }
#define XB_SPIN(cond, bar) do { unsigned _sp = 0; while (cond) { __builtin_amdgcn_s_sleep(1); \
    if ((++_sp & 255u) == 0u) { if (xb_ld(&(bar)[XB_TMO])) break; if (_sp > XB_SPIN_CAP) { atomicAdd(&(bar)[XB_TMO], 1u); break; } } } } while (0)

struct XcdBarrier {
    unsigned* bar; unsigned x;
    volatile LAS unsigned* st;
};

__device__ __forceinline__ XcdBarrier xcd_barrier_post(unsigned* bar, volatile LAS unsigned* st) {
    XcdBarrier b; b.bar = bar; b.x = xb_xcc_id(); b.st = st;
    if (threadIdx.x == 0) (void)xb_add(&bar[XB_XCNT(b.x)], 1u);
    return b;
}
__device__ __forceinline__ void xcd_barrier_complete(unsigned* bar, unsigned x, unsigned& nloc, unsigned& nx) {
    const unsigned G = gridDim.x * gridDim.y * gridDim.z;
    unsigned sum, cnt, mine, sp = 0u;
    for (;;) {
        sum = 0u; cnt = 0u; mine = 0u;
#pragma unroll
        for (unsigned j = 0; j < 16; ++j) { const unsigned c = xb_ld(&bar[XB_XCNT(j)]); sum += c; cnt += (c > 0u) ? 1u : 0u; mine = (j == x) ? c : mine; }
        if (sum == G) break;
        __builtin_amdgcn_s_sleep(1);
        if ((++sp & 255u) == 0u) { if (xb_ld(&bar[XB_TMO])) break; if (sp > XB_SPIN_CAP) { atomicAdd(&bar[XB_TMO], 1u); break; } }
    }
    nloc = mine > 0u ? mine : 1u; nx = cnt > 0u ? cnt : 1u;
}

__device__ __forceinline__ void xcd_barrier(const XcdBarrier& b) {
    asm volatile("s_waitcnt vmcnt(0)" ::: "memory");
    __syncthreads();
    if (threadIdx.x == 0) {
        unsigned* bar = b.bar;
        __builtin_amdgcn_s_waitcnt(0);
        unsigned nloc = b.st[0], nx = b.st[1];
        if (nloc == 0u) { xcd_barrier_complete(bar, b.x, nloc, nx); b.st[0] = nloc; b.st[1] = nx; }
        const unsigned old = xb_add(&bar[XB_XSUB(b.x)], 1u);
        const unsigned gen = old / nloc;
        if (old + 1u == (gen + 1u) * nloc) {
            __builtin_amdgcn_fence(__ATOMIC_RELEASE, "agent");
            asm volatile("s_waitcnt vmcnt(0)" ::: "memory");
            const unsigned og = xb_add(&bar[XB_TOP], 1u);
            const unsigned tg = og / nx;
            if (og + 1u == (tg + 1u) * nx) xb_add(&bar[XB_TOPGEN], 1u);
            else XB_SPIN(xb_ld(&bar[XB_TOPGEN]) == tg, bar);
            __builtin_amdgcn_fence(__ATOMIC_ACQUIRE, "agent");
            xb_add(&bar[XB_XGEN(b.x)], 1u);
            asm volatile("s_waitcnt vmcnt(0)" ::: "memory");
        } else {
            XB_SPIN(xb_ld(&bar[XB_XGEN(b.x)]) == gen, bar);
            __builtin_amdgcn_fence(__ATOMIC_ACQUIRE, "agent");
            asm volatile("s_waitcnt vmcnt(0)" ::: "memory");
        }
    }
    __syncthreads();
}

#define PHASE_VARS \
    int tx_ = threadIdx.x; asm volatile("" : "+v"(tx_)); \
    const int vh = __builtin_amdgcn_readfirstlane(tx_ >> 8); \
    unsigned char* const smem = smem_all + vh * SM_TOTAL; \
    const int tid = tx_ & 255, lane = tid & 63, wid = tid >> 6, wr = wid >> 1, wc = wid & 1, fr = lane & 15, fq = lane >> 4; \
    const int G = gridDim.x * 2, bid = blockIdx.x * 2 + vh; \
    (void)smem; (void)tid; (void)lane; (void)wid; (void)wr; (void)wc; (void)fr; (void)fq; (void)G; (void)bid;
__global__ void __launch_bounds__(512, 2) mega(Params p) {
    extern __shared__ __attribute__((aligned(16))) unsigned char smem_all[];

    unsigned char* ws = p.ws;
    volatile LAS unsigned* bst = (volatile LAS unsigned*)((LAS unsigned char*)smem_all + 2 * SM_TOTAL);
    if (threadIdx.x == 0) { bst[0] = 0u; bst[1] = 0u; }
    __syncthreads();
    const XcdBarrier xbar = xcd_barrier_post((unsigned*)(ws + OFF_BAR), bst);

    { PHASE_VARS
    { int cbase = 0; for (int id = 0; id < 13; ++id) { const WSpec s = get_spec(p, id); convert_spec(s, smem, bid, G, tid, cbase); } }
    for (int i = bid * 256 + tid; i < 3 * NTOK; i += G * 256) RSQ[i] = 0.f;
    for (int i = bid * 256 + tid; i < 8192 * 16; i += G * 256) {
        const int s = i >> 4, f = i & 15, a = f >> 2, b = f & 3;
        const double fa = a == 0 ? 1.0 : (a == 1 ? 0.1 : (a == 2 ? 0.01 : 0.001));
        const double fb = b == 0 ? 1.0 : (b == 1 ? 0.5623413251903491 : (b == 2 ? 0.31622776601683794 : 0.1778279410038923));
        double rev = (double)s * fa * fb * 0.15915494309189535; rev -= floor(rev);
        const float rv = (float)rev;
        ROPE[2 * i] = __builtin_amdgcn_cosf(rv); ROPE[2 * i + 1] = __builtin_amdgcn_sinf(rv);
    }
    for (int row = bid * 4 + wid; row < 1536; row += G * 4) {
        const float* src = row < 512 ? p.memp + (size_t)row * 1024 : p.mems + (size_t)(row - 512) * 1024;
        f32x4 v[4]; float s = 0.f;
#pragma unroll
        for (int i = 0; i < 4; ++i) { v[i] = ld_f4(src + lane * 4 + 256 * i); s += dot4(v[i]); }
        s += __shfl_xor(s, 1); s += __shfl_xor(s, 2); s += __shfl_xor(s, 4); s += __shfl_xor(s, 8); s += __shfl_xor(s, 16); s += __shfl_xor(s, 32);
        const float inv = rsqrtf(s * (1.f / 1024.f) + EPS);
#pragma unroll
        for (int i = 0; i < 4; ++i) st_bf4(MN + (size_t)row * 1024 + lane * 4 + 256 * i, v[i] * inv);
    }
    copy_rows_bf16(p.xp, p.xs, XB0, RS0, bid * 4 + wid, G * 4, lane);
    }
    xcd_barrier(xbar);
    { PHASE_VARS
    { pg8::Gemm g{XB0, W1GU, NTOK, 5632, 1024, 1024, 1024, 128, 128}; pg8::StaticOrder so; so.init(NTOK, 5632, gridDim.x, blockIdx.x);
      pg8::gemm_phase<pg8::EpiGU, pg8::StaticOrder, true, true>((PG8_LAS unsigned char*)smem_all, g, so, pg8::EpiGU{HID, RS0}); }
    }
    xcd_barrier(xbar);
    { PHASE_VARS
    { pg8::Gemm g{HID, W1DN, NTOK, 1024, 2816, 0, 2816, (size_t)NTOK * 128, 128}; pg8::StaticOrder so; so.init(NTOK, 1024, gridDim.x, blockIdx.x);
      pg8::gemm_phase<pg8::EpiRes<1>, pg8::StaticOrder, true, true>((PG8_LAS unsigned char*)smem_all, g, so, pg8::EpiRes<1>{nullptr, nullptr, XB0, XB, RS1, 0.5f}); }
    }
    xcd_barrier(xbar);
    { PHASE_VARS
    { int cbase = 0; for (int id = 13; id < 16; ++id) { const WSpec s = get_spec(p, id); convert_spec(s, smem, bid, G, tid, cbase); } }
    for (int i = bid * 256 + tid; i < NTOK; i += G * 256) RS2[i] = 0.f;
    __syncthreads();
    { pg8::Gemm g{XB, W_IN1, NTOK, 1280, 1024, 1024, 1024, 128, 128}; pg8::StaticOrder so; so.init(NTOK, 1280, gridDim.x, blockIdx.x);
      pg8::gemm_phase<pg8::EpiIn1, pg8::StaticOrder, true, true>((PG8_LAS unsigned char*)smem_all, g, so, pg8::EpiIn1{RS1, CQ, CKV, XQ, RSQ, RSKV}); }
    __syncthreads();
    for (int u = bid - 256; u >= 0 && u < 96; u += 1 << 30) {
        f32x4 acc[4][4]; zero_acc(acc);
        if (u < 48) {
            const int tm = u >> 2, hh = u & 3;
            gemm_tile<false>(acc, MN + (size_t)tm * 128 * 1024, 1024, W_MEMK + (size_t)hh * 128 * 1024, 1024, 16, smem);
            float tot[4]; tile_row_ss(acc, tot, smem, wr, wc, fr, fq);
#pragma unroll
            for (int m = 0; m < 4; ++m) {
                const int row = tm * 128 + wr * 64 + m * 16 + fr; const float inv = rsqrtf(tot[m] * (1.f / 128.f) + EPS);
#pragma unroll
                for (int n = 0; n < 4; ++n) { const int c = wc * 64 + n * 16 + fq * 4; st_bf4(MK + (size_t)row * 512 + hh * 128 + c, acc[m][n] * inv * ld_f4(p.xa_k_norm + c)); }
            }
        } else {
            const int v = u - 48, tm = v / 12, tn = v % 12;
            gemm_tile<false>(acc, W_MEMV + (size_t)tm * 128 * 1024, 1024, MN + (size_t)tn * 128 * 1024, 1024, 16, smem);
#pragma unroll
            for (int m = 0; m < 4; ++m) {
                const int d = wr * 64 + m * 16 + fr;
#pragma unroll
                for (int n = 0; n < 4; ++n) { const int col = tn * 128 + wc * 64 + n * 16 + fq * 4, b = col >> 8, mm = col & 255; st_bf4(MVT + ((size_t)(b * 4 + tm) * 128 + d) * 256 + mm, acc[m][n]); }
            }
        }
    }
    }
    xcd_barrier(xbar);
    { PHASE_VARS
    { pg8::Gemm g{CQ, W_UQ, NTOK, 768, 384, 384, 384, 128, 128}; pg8::StaticOrder so; so.init(NTOK, 768, gridDim.x, blockIdx.x);
      pg8::gemm_phase<pg8::EpiQ, pg8::StaticOrder, true, true>((PG8_LAS unsigned char*)smem_all, g, so, pg8::EpiQ{RSQ, Qb}); }
    { pg8::Gemm g{CKV, W_UK, NTOK, 512, 256, 288, 288, 128, 128}; pg8::StaticOrder so; so.init(NTOK, 512, gridDim.x, blockIdx.x);
      pg8::gemm_phase<pg8::EpiK, pg8::StaticOrder, true, true>((PG8_LAS unsigned char*)smem_all, g, so, pg8::EpiK{RSKV, CKV, p.mla_k_norm, ROPE, Kb}); }
    { pg8::Gemm g{W_UV, CKV, 512, NTOK, 256, 288, 288, 128, 128}; pg8::StaticOrder so; so.init(512, NTOK, gridDim.x, blockIdx.x);
      pg8::gemm_phase<pg8::EpiVt, pg8::StaticOrder, true, true>((PG8_LAS unsigned char*)smem_all, g, so, pg8::EpiVt{RSKV, VT}); }
    }
    xcd_barrier(xbar);
    { PHASE_VARS
    for (int j = blockIdx.x; j < 1024; j += gridDim.x) {
        int tok0i, pair, qt, nk, vtoff;
        if (j < 512) { const int r = j >> 8, i = j & 255; pair = (i & 7) + 8 * r; qt = i >> 3; tok0i = (pair >> 3) * 8192; nk = 8192; vtoff = 0; }
        else { const int jj = j - 512, r = jj >> 8, i = jj & 255, slot = i >> 3; pair = (i & 7) + 8 * (2 * r + (slot >> 4)); qt = slot & 15; tok0i = 16384 + (pair >> 3) * 4096; nk = 4096; vtoff = 8388608; }
        const int h = pair & 7;
        const size_t tok0 = (size_t)tok0i;
        attn_mla_item(p.mla_q_norm, ROPE, qt * 256, Qb + ((tok0 + qt * 256) * 8 + h) * 96, Kb + (tok0 * 8 + h) * 96, VT + (size_t)vtoff + (size_t)pair * 64 * nk, nk, nk, AO + (tok0 + qt * 256) * 512 + h * 64, smem_all, tx_);
    }
    __syncthreads();
    for (int jj = bid; jj < 1024; jj += G) {
        const int tile = jj >> 2, hh = jj & 3, tok0 = tile * 128;
        const int mb = tok0 < 16384 ? (tok0 >> 13) : 2 + ((tok0 - 16384) >> 12);
        bf16_t* qp = XQ + (size_t)tok0 * 512 + hh * 128;
        attn_item<128, 128, false, true>(p.xa_q_norm, QSCALE_XA, qp, 512, MK + (size_t)mb * 256 * 512 + hh * 128, 512, MVT + (size_t)(mb * 4 + hh) * 128 * 256, 256, 256, qp, 512, smem);
    }
    }
    xcd_barrier(xbar);
    { PHASE_VARS
    { pg8::Gemm g{XB, W_IN2, NTOK, 1536, 1024, 1024, 1024, 128, 128}; pg8::StaticOrder so; so.init(NTOK, 1536, gridDim.x, blockIdx.x);
      pg8::gemm_phase<pg8::EpiIn2, pg8::StaticOrder, true, true>((PG8_LAS unsigned char*)smem_all, g, so, pg8::EpiIn2{RS1, CB, Ub}); }
    }
    xcd_barrier(xbar);
    { PHASE_VARS
    for (int i = bid * 256 + tid; i < NTOK * 64; i += G * 256) {
        const int tok = i >> 6, c0 = (i & 63) * 8, pos = tok_pos(tok), slen = tok < 16384 ? 8192 : 4096;
        const bf16_t* up = Ub + (size_t)tok * 512 + c0;
        const uint4 z = {0u, 0u, 0u, 0u};
        const uint4 u0 = pos > 0 ? *(const uint4*)(up - 512) : z, u1 = *(const uint4*)up, u2 = pos < slen - 1 ? *(const uint4*)(up + 512) : z;
        const uint4 cb = *(const uint4*)(CB + (size_t)tok * 512 + c0);
        const unsigned a0[4] = {u0.x, u0.y, u0.z, u0.w}, a1[4] = {u1.x, u1.y, u1.z, u1.w}, a2[4] = {u2.x, u2.y, u2.z, u2.w}, ab[4] = {cb.x, cb.y, cb.z, cb.w};
        unsigned o[4];
#pragma unroll
        for (int q = 0; q < 4; ++q) {
            const int c = c0 + 2 * q;
            const float w0l = p.conv_w[c], w0h = p.conv_w[c + 1], w1l = p.conv_w[512 + c], w1h = p.conv_w[512 + c + 1], w2l = p.conv_w[1024 + c], w2h = p.conv_w[1024 + c + 1];
            const float yl = bflo(a0[q]) * w0l + bflo(a1[q]) * w1l + bflo(a2[q]) * w2l, yh = bfhi(a0[q]) * w0h + bfhi(a1[q]) * w1h + bfhi(a2[q]) * w2h;
            o[q] = pk2(bflo(ab[q]) * yl, bfhi(ab[q]) * yh);
        }
        uint4 ov; ov.x = o[0]; ov.y = o[1]; ov.z = o[2]; ov.w = o[3];
        *(uint4*)(CB + (size_t)tok * 512 + c0) = ov;
    }
    }
    xcd_barrier(xbar);
    { PHASE_VARS
    { pg8::StaticOrder so; so.init(NTOK, 1024, gridDim.x, blockIdx.x);
      pg8::gemm_phase_merge<pg8::EpiMerge>((PG8_LAS unsigned char*)smem_all, ws, XB, so, pg8::EpiMerge{(uint4*)Ub + (size_t)blockIdx.x * 8192, (uint4*)((unsigned char*)p.out + D1_STILE) + (size_t)blockIdx.x * 8192, RS1, MERGED}); }
    }
    xcd_barrier(xbar);
    { PHASE_VARS
    { pg8::Gemm g{MERGED, W_OUT, NTOK, 1024, 1024, 0, 1024, (size_t)NTOK * 128, 128}; pg8::StaticOrder so; so.init(NTOK, 1024, gridDim.x, blockIdx.x);
      pg8::gemm_phase<pg8::EpiRes<1>, pg8::StaticOrder, true, true>((PG8_LAS unsigned char*)smem_all, g, so, pg8::EpiRes<1>{nullptr, nullptr, XB, X2B, RS2, 1.0f}); }
    }
    xcd_barrier(xbar);
    { PHASE_VARS
    { pg8::Gemm g{X2B, W2GU, NTOK, 5632, 1024, 1024, 1024, 128, 128}; pg8::StaticOrder so; so.init(NTOK, 5632, gridDim.x, blockIdx.x);
      pg8::gemm_phase<pg8::EpiGU, pg8::StaticOrder, true, true>((PG8_LAS unsigned char*)smem_all, g, so, pg8::EpiGU{HID2, RS2}); }
    }
    xcd_barrier(xbar);
    { PHASE_VARS
    { pg8::Gemm g{HID2, W2DN, NTOK, 1024, 2816, 0, 2816, (size_t)NTOK * 128, 128}; pg8::StaticOrder so; so.init(NTOK, 1024, gridDim.x, blockIdx.x);
      pg8::gemm_phase<pg8::EpiFinal, pg8::StaticOrder, true, true>((PG8_LAS unsigned char*)smem_all, g, so, pg8::EpiFinal{X2B, p.out}); }
    }
}

extern "C" void kernel_launch(void* const* d_in, const int* in_sizes, int n_in, void* d_out, int out_size, void* d_ws, size_t ws_size, hipStream_t stream) {
    (void)in_sizes; (void)n_in; (void)out_size;
    static int grid_blocks = 0;
    if (!grid_blocks) {
        int dev = 0, cus = 0, per_cu = 0;
        (void)hipGetDevice(&dev);
        (void)hipDeviceGetAttribute(&cus, hipDeviceAttributeMultiprocessorCount, dev);
        (void)hipFuncSetAttribute((const void*)mega, hipFuncAttributeMaxDynamicSharedMemorySize, 2 * SM_TOTAL + 16);
        (void)hipOccupancyMaxActiveBlocksPerMultiprocessor(&per_cu, (const void*)mega, 512, 2 * SM_TOTAL + 16);
        if (per_cu > 1) per_cu = 1;
        if (per_cu < 1) per_cu = 1;
        grid_blocks = cus * per_cu;
        if (grid_blocks > 256) grid_blocks = 256;
    }
    if (ws_size < WS_SIZE) { fprintf(stderr, "workspace too small: %zu < %zu\n", ws_size, (size_t)WS_SIZE); return; }
    Params p{};
    const float* const* in = (const float* const*)d_in;
    p.xp = in[0]; p.xs = in[1]; p.memp = in[2]; p.mems = in[3];
    p.ffn1_norm = in[4]; p.ffn1_gu = in[5]; p.ffn1_down = in[6]; p.mix_norm = in[7]; p.w_in = in[8]; p.q_lora_norm = in[9]; p.w_uq = in[10];
    p.kv_lora_norm = in[11]; p.w_uk = in[12]; p.w_uv = in[13]; p.mla_q_norm = in[14]; p.mla_k_norm = in[15]; p.w_o_mla = in[16]; p.conv_w = in[17];
    p.w_o_conv = in[18]; p.mem_norm = in[19]; p.w_mem_kv = in[20]; p.xa_q_norm = in[21]; p.xa_k_norm = in[22]; p.w_o_mem = in[23]; p.w_out = in[24];
    p.ffn2_norm = in[25]; p.ffn2_gu = in[26]; p.ffn2_down = in[27];
    p.out = (float*)d_out; p.ws = (unsigned char*)d_ws;
    if (hipMemsetAsync((unsigned char*)d_ws + OFF_BAR, 0, 16384, stream) != hipSuccess) { fprintf(stderr, "memset of the barrier words failed\n"); return; }
    void* args[] = {&p};
    hipError_t e = hipLaunchCooperativeKernel((const void*)mega, dim3(grid_blocks), dim3(512), args, 2 * SM_TOTAL + 16, stream);
    if (e != hipSuccess) fprintf(stderr, "cooperative launch failed: %s (grid %d)\n", hipGetErrorString(e), grid_blocks);
}
```

```cpp
#include <hip/hip_runtime.h>
#include <hip/hip_cooperative_groups.h>
#include <cstdio>
#include <cstdint>
namespace cg = cooperative_groups;

#define DEVI __device__ __forceinline__
typedef unsigned short bf16_t;
typedef short bf16x8 __attribute__((ext_vector_type(8)));
typedef float f32x4 __attribute__((ext_vector_type(4)));
typedef float f32x16 __attribute__((ext_vector_type(16)));
typedef __bf16 bf16x2n __attribute__((ext_vector_type(2)));
typedef float f32x2n __attribute__((ext_vector_type(2)));

constexpr float EPS = 1e-6f;
constexpr int NTOK = 32768;
constexpr float QSCALE_MLA = 0.10206207261596575f * 1.4426950408889634f;
constexpr float QSCALE_XA = 0.08838834764831845f * 1.4426950408889634f;


constexpr size_t SZ_W_FFNGU = (size_t)5632 * 1024 * 2, SZ_W_FFNDN = (size_t)1024 * 2816 * 2;
constexpr size_t D1_OFF = (size_t)NTOK * 1024 * 2;
constexpr size_t D1_W2GU = D1_OFF, D1_WOUT = D1_W2GU + SZ_W_FFNGU, D1_RS2 = D1_WOUT + (size_t)1024 * 1024 * 2;
constexpr size_t OFF_W1GU = 0;
constexpr size_t OFF_W1DN = OFF_W1GU + SZ_W_FFNGU;
constexpr size_t OFF_W2DN = 0;
constexpr size_t OFF_W_IN1 = OFF_W1DN + SZ_W_FFNDN;
constexpr size_t OFF_W_IN2 = OFF_W_IN1 + (size_t)1280 * 1024 * 2;
constexpr size_t OFF_W_GATE = OFF_W_IN2 + (size_t)1536 * 1024 * 2;
constexpr size_t OFF_W_UQ = OFF_W_GATE + (size_t)3072 * 1024 * 2;
constexpr size_t OFF_W_UK = OFF_W_UQ + (size_t)1024 * 384 * 2;
constexpr size_t OFF_W_UV = OFF_W_UK + (size_t)512 * 288 * 2;
constexpr size_t OFF_W_OMLA = OFF_W_UV + (size_t)512 * 288 * 2;
constexpr size_t OFF_W_OCONV = OFF_W_OMLA + (size_t)1024 * 512 * 2;
constexpr size_t OFF_W_OMEM = OFF_W_OCONV + (size_t)1024 * 512 * 2;
constexpr size_t OFF_W_MEMK = OFF_W_OMEM + (size_t)1024 * 512 * 2;
constexpr size_t OFF_W_MEMV = OFF_W_MEMK + (size_t)512 * 1024 * 2;
constexpr size_t OFF_MK = OFF_W_MEMV + (size_t)512 * 1024 * 2;
constexpr size_t OFF_MVT = OFF_MK + (size_t)1536 * 512 * 2;
constexpr size_t OFF_ROPE = OFF_MVT + (size_t)1536 * 512 * 2;
constexpr size_t OFF_RSQ = OFF_ROPE + (size_t)8192 * 16 * 2 * 4;
constexpr size_t OFF_RSKV = OFF_RSQ + (size_t)NTOK * 4;
constexpr size_t OFF_RS1 = OFF_RSKV + (size_t)NTOK * 4;
constexpr size_t OFF_RS0 = OFF_RS1 + (size_t)NTOK * 4;
constexpr size_t OFF_MN = OFF_RS0 + (size_t)NTOK * 4;
constexpr size_t OFF_ACT = OFF_MN + (size_t)1536 * 1024 * 2;
constexpr size_t OFF_XQ = OFF_ACT;
constexpr size_t OFF_CQ = OFF_XQ + (size_t)NTOK * 512 * 2;
constexpr size_t OFF_CKV = OFF_CQ + (size_t)NTOK * 384 * 2;
constexpr size_t OFF_Q = OFF_CKV + (size_t)NTOK * 288 * 2;
constexpr size_t OFF_K = OFF_Q + (size_t)NTOK * 768 * 2;
constexpr size_t OFF_VT = OFF_K + (size_t)NTOK * 768 * 2;
constexpr size_t WS_NEEDED = OFF_VT + (size_t)NTOK * 512 * 2;
constexpr size_t WS_SIZE = (size_t)256 * 1024 * 1024;
constexpr size_t OFF_HID = OFF_ACT;
constexpr size_t OFF_AO = OFF_CQ;
constexpr size_t OFF_CB = OFF_Q;
constexpr size_t OFF_U = OFF_CB + (size_t)NTOK * 512 * 2;
constexpr size_t OFF_MERGED = OFF_U + (size_t)NTOK * 512 * 2;
constexpr size_t OFF_X2B = OFF_W2DN + SZ_W_FFNDN;
constexpr size_t OFF_BAR = WS_SIZE - 16384;
constexpr size_t OFF_HID2 = OFF_BAR - (size_t)NTOK * 2816 * 2;
static_assert(OFF_HID + (size_t)NTOK * 2816 * 2 <= WS_SIZE, "hid");
static_assert(OFF_AO + (size_t)NTOK * 512 * 2 <= OFF_Q, "ao");
static_assert(OFF_MERGED + (size_t)NTOK * 1024 * 2 <= WS_NEEDED, "merged");
static_assert(WS_NEEDED <= OFF_BAR && OFF_HID + (size_t)NTOK * 2816 * 2 <= OFF_BAR, "ws");
static_assert(OFF_X2B + (size_t)NTOK * 1024 * 2 <= OFF_HID2, "x2b");
static_assert(OFF_X2B + (size_t)NTOK * 1024 * 2 <= OFF_MERGED, "x2b/merged");
constexpr size_t D1_STILE = D1_RS2 + (size_t)NTOK * 4;
static_assert(D1_STILE + (size_t)256 * 131072 <= 2 * D1_OFF, "d1");

constexpr int TILE_BYTES = 128 * 144;
constexpr int SM_A = 0, SM_B = 2 * TILE_BYTES, SM_RSS = 4 * TILE_BYTES, SM_XCH = SM_RSS + 512, SM_TOTAL = SM_XCH + 1024;

struct Params {
    const float *xp, *xs, *memp, *mems;
    const float *ffn1_norm, *ffn1_gu, *ffn1_down, *mix_norm, *w_in, *q_lora_norm, *w_uq, *kv_lora_norm, *w_uk, *w_uv;
    const float *mla_q_norm, *mla_k_norm, *w_o_mla, *conv_w, *w_o_conv, *mem_norm, *w_mem_kv, *xa_q_norm, *xa_k_norm;
    const float *w_o_mem, *w_out, *ffn2_norm, *ffn2_gu, *ffn2_down;
    float* out;
    unsigned char* ws;
};

DEVI unsigned pk2(float lo, float hi) { f32x2n v = {lo, hi}; bf16x2n b = __builtin_convertvector(v, bf16x2n); return __builtin_bit_cast(unsigned, b); }
DEVI float bflo(unsigned w) { return __uint_as_float(w << 16); }
DEVI float bfhi(unsigned w) { return __uint_as_float(w & 0xffff0000u); }
DEVI void st_bf4(bf16_t* p, f32x4 v) { uint2 w; w.x = pk2(v[0], v[1]); w.y = pk2(v[2], v[3]); *(uint2*)p = w; }
DEVI f32x4 ld_bf4(const bf16_t* p) { uint2 w = *(const uint2*)p; f32x4 r = {bflo(w.x), bfhi(w.x), bflo(w.y), bfhi(w.y)}; return r; }
DEVI f32x4 ld_f4(const float* p) { float4 t = *(const float4*)p; f32x4 r = {t.x, t.y, t.z, t.w}; return r; }
DEVI float dot4(f32x4 v) { return v[0] * v[0] + v[1] * v[1] + v[2] * v[2] + v[3] * v[3]; }
DEVI float sigm(float x) { return __builtin_amdgcn_rcpf(1.f + __expf(-x)); }
DEVI int tok_pos(int tok) { return tok < 16384 ? (tok & 8191) : (tok & 4095); }
DEVI float red4q(float s) { s += __shfl_xor(s, 16); s += __shfl_xor(s, 32); return s; }

template <bool AF32>
DEVI void gemm_tile(f32x4 (&acc)[4][4], const void* Aptr, int lda, const bf16_t* Bptr, int ldb, int nk, unsigned char* smem) {
    int tid_ = threadIdx.x & 255; asm volatile("" : "+v"(tid_)); const int tid = tid_, lane = tid & 63, wid = tid >> 6, wr = wid >> 1, wc = wid & 1, fr = lane & 15, fq = lane >> 4;
    float4 af[8]; uint4 ab[4]; uint4 bb[4]; float ss[8];
#pragma unroll
    for (int i = 0; i < 8; ++i) ss[i] = 0.f;
    const float* Af = (const float*)Aptr + (size_t)(tid >> 4) * lda + (tid & 15) * 4;
    const bf16_t* Ab = (const bf16_t*)Aptr + (size_t)(tid >> 3) * lda + (tid & 7) * 8;
    const bf16_t* Bb = Bptr + (size_t)(tid >> 3) * ldb + (tid & 7) * 8;
    const int awf = (tid >> 4) * 144 + (tid & 15) * 8;
    const int awb = (tid >> 3) * 144 + (tid & 7) * 16;
    const int aro = (wr * 64 + fr) * 144 + fq * 16;
    const int bro = (wc * 64 + fr) * 144 + fq * 16;
#define GT_LOAD(kt) do { \
        if (AF32) { _Pragma("unroll") for (int i = 0; i < 8; ++i) af[i] = *(const float4*)(Af + (size_t)(16 * i) * lda + (kt) * 64); } \
        else      { _Pragma("unroll") for (int i = 0; i < 4; ++i) ab[i] = *(const uint4*)(Ab + (size_t)(32 * i) * lda + (kt) * 64); } \
        _Pragma("unroll") for (int i = 0; i < 4; ++i) bb[i] = *(const uint4*)(Bb + (size_t)(32 * i) * ldb + (kt) * 64); } while (0)
#define GT_STORE(buf) do { \
        unsigned char* As_ = smem + SM_A + (buf) * TILE_BYTES; unsigned char* Bs_ = smem + SM_B + (buf) * TILE_BYTES; \
        if (AF32) { _Pragma("unroll") for (int i = 0; i < 8; ++i) { float4 v = af[i]; ss[i] += v.x * v.x + v.y * v.y + v.z * v.z + v.w * v.w; \
                        uint2 w; w.x = pk2(v.x, v.y); w.y = pk2(v.z, v.w); *(uint2*)(As_ + awf + i * 16 * 144) = w; } } \
        else      { _Pragma("unroll") for (int i = 0; i < 4; ++i) *(uint4*)(As_ + awb + i * 32 * 144) = ab[i]; } \
        _Pragma("unroll") for (int i = 0; i < 4; ++i) *(uint4*)(Bs_ + awb + i * 32 * 144) = bb[i]; } while (0)
    GT_LOAD(0);
    GT_STORE(0);
    __syncthreads();
    for (int kt = 0; kt < nk; ++kt) {
        const bool more = kt + 1 < nk;
        if (more) GT_LOAD(kt + 1);
        const unsigned char* As = smem + SM_A + (kt & 1) * TILE_BYTES;
        const unsigned char* Bs = smem + SM_B + (kt & 1) * TILE_BYTES;
#pragma unroll
        for (int ks = 0; ks < 2; ++ks) {
            bf16x8 a[4], b[4];
#pragma unroll
            for (int m = 0; m < 4; ++m) a[m] = *(const bf16x8*)(As + aro + m * 16 * 144 + ks * 64);
#pragma unroll
            for (int n = 0; n < 4; ++n) b[n] = *(const bf16x8*)(Bs + bro + n * 16 * 144 + ks * 64);
#pragma unroll
            for (int m = 0; m < 4; ++m)
#pragma unroll
                for (int n = 0; n < 4; ++n) acc[m][n] = __builtin_amdgcn_mfma_f32_16x16x32_bf16(b[n], a[m], acc[m][n], 0, 0, 0);
        }
        if (more) GT_STORE((kt + 1) & 1);
        __syncthreads();
    }
    if (AF32) {
        float* rowss = (float*)(smem + SM_RSS);
#pragma unroll
        for (int i = 0; i < 8; ++i) {
            float s = ss[i];
            s += __shfl_xor(s, 1); s += __shfl_xor(s, 2); s += __shfl_xor(s, 4); s += __shfl_xor(s, 8);
            if ((tid & 15) == 0) rowss[(tid >> 4) + 16 * i] = s;
        }
        __syncthreads();
    }
#undef GT_LOAD
#undef GT_STORE
}
DEVI void zero_acc(f32x4 (&acc)[4][4]) {
#pragma unroll
    for (int m = 0; m < 4; ++m)
#pragma unroll
        for (int n = 0; n < 4; ++n) acc[m][n] = (f32x4){0.f, 0.f, 0.f, 0.f};
}
DEVI void tile_row_ss(const f32x4 (&acc)[4][4], float (&tot)[4], unsigned char* smem, int wr, int wc, int fr, int fq) {
    float* xch = (float*)(smem + SM_XCH);
#pragma unroll
    for (int m = 0; m < 4; ++m) {
        float s = 0.f;
#pragma unroll
        for (int n = 0; n < 4; ++n) s += dot4(acc[m][n]);
        s = red4q(s);
        if (fq == 0) xch[wc * 128 + wr * 64 + m * 16 + fr] = s;
    }
    __syncthreads();
#pragma unroll
    for (int m = 0; m < 4; ++m) { const int r = wr * 64 + m * 16 + fr; tot[m] = xch[r] + xch[128 + r]; }
}


enum { KD_ID = 0, KD_GU, KD_IN1, KD_IN2, KD_UK };
struct WSpec { const float* src; const float* gain; bf16_t* dst; int src_ld, K, Np, kind, coff, dld; };
DEVI int map_col(int kind, int coff, int np) {
    const int c2 = np & 255, pr = (c2 >> 7) * 64 + ((c2 >> 5) & 3) * 16 + (c2 & 15), n = (c2 >> 4) & 1;
    switch (kind) {
        case KD_GU: return n * 2816 + (np >> 8) * 128 + pr;
        case KD_IN1: return np < 672 ? np : (np < 768 ? -1 : 2208 + (np - 768));
        case KD_IN2: return np < 512 ? 672 + np : 1184 + n * 512 + ((np >> 8) - 2) * 128 + pr;
        case KD_UK: return ((np >> 8) * 4 + ((c2 >> 5) & 3)) * 64 + (c2 >> 7) * 32 + n * 16 + (c2 & 15);
        default: return coff + np;
    }
}
DEVI WSpec get_spec(const Params& p, int id) {
    unsigned char* ws = p.ws; unsigned char* d1 = (unsigned char*)p.out; WSpec s;
    switch (id) {
        case 0: s = {p.ffn1_gu, p.ffn1_norm, (bf16_t*)(ws + OFF_W1GU), 5632, 1024, 5632, KD_GU, 0, 1024}; break;
        case 1: s = {p.ffn1_down, nullptr, (bf16_t*)(ws + OFF_W1DN), 1024, 2816, 1024, KD_ID, 0, 2816}; break;
        case 2: s = {p.w_in, p.mix_norm, (bf16_t*)(ws + OFF_W_IN1), 5792, 1024, 1280, KD_IN1, 0, 1024}; break;
        case 3: s = {p.w_in, p.mix_norm, (bf16_t*)(ws + OFF_W_IN2), 5792, 1024, 1536, KD_IN2, 0, 1024}; break;
        case 4: s = {p.w_in, p.mix_norm, (bf16_t*)(ws + OFF_W_GATE), 5792, 1024, 3072, KD_ID, 2720, 1024}; break;
        case 5: s = {p.w_uq, p.q_lora_norm, (bf16_t*)(ws + OFF_W_UQ), 768, 384, 768, KD_ID, 0, 384}; break;
        case 6: s = {p.w_uk, p.kv_lora_norm, (bf16_t*)(ws + OFF_W_UK), 512, 256, 512, KD_UK, 0, 288}; break;
        case 7: s = {p.w_uv, p.kv_lora_norm, (bf16_t*)(ws + OFF_W_UV), 512, 256, 512, KD_ID, 0, 288}; break;
        case 8: s = {p.w_o_mla, nullptr, (bf16_t*)(ws + OFF_W_OMLA), 1024, 512, 1024, KD_ID, 0, 512}; break;
        case 9: s = {p.w_o_conv, nullptr, (bf16_t*)(ws + OFF_W_OCONV), 1024, 512, 1024, KD_ID, 0, 512}; break;
        case 10: s = {p.w_o_mem, nullptr, (bf16_t*)(ws + OFF_W_OMEM), 1024, 512, 1024, KD_ID, 0, 512}; break;
        case 11: s = {p.w_mem_kv, p.mem_norm, (bf16_t*)(ws + OFF_W_MEMK), 1024, 1024, 512, KD_ID, 0, 1024}; break;
        case 12: s = {p.w_mem_kv, p.mem_norm, (bf16_t*)(ws + OFF_W_MEMV), 1024, 1024, 512, KD_ID, 512, 1024}; break;
        case 13: s = {p.w_out, nullptr, (bf16_t*)(d1 + D1_WOUT), 1024, 1024, 1024, KD_ID, 0, 1024}; break;
        case 14: s = {p.ffn2_gu, p.ffn2_norm, (bf16_t*)(d1 + D1_W2GU), 5632, 1024, 5632, KD_GU, 0, 1024}; break;
        default: s = {p.ffn2_down, nullptr, (bf16_t*)(ws + OFF_W2DN), 1024, 2816, 1024, KD_ID, 0, 2816}; break;
    }
    return s;
}
DEVI void convert_spec(const WSpec& s, unsigned char* smem, int bid, int G, int tid, int& base) {
    float* T = (float*)smem;
    const int nkt = s.K >> 6, ntiles = (s.Np >> 6) * nkt;
    int first = (bid - base) % G; if (first < 0) first += G;
    base += ntiles;
    for (int t = first; t < ntiles; t += G) {
        const int n0 = (t / nkt) << 6, k0 = (t % nkt) << 6;
        const int c4 = (tid & 15) * 4, col = map_col(s.kind, s.coff, n0 + c4);
#pragma unroll
        for (int i = 0; i < 4; ++i) {
            const int r = (tid >> 4) + 16 * i;
            float4 v = make_float4(0.f, 0.f, 0.f, 0.f);
            if (col >= 0) { v = *(const float4*)(s.src + (size_t)(k0 + r) * s.src_ld + col); if (s.gain) { const float g = s.gain[k0 + r]; v.x *= g; v.y *= g; v.z *= g; v.w *= g; } }
            T[r * 65 + c4] = v.x; T[r * 65 + c4 + 1] = v.y; T[r * 65 + c4 + 2] = v.z; T[r * 65 + c4 + 3] = v.w;
        }
        __syncthreads();
#pragma unroll
        for (int i = 0; i < 2; ++i) {
            const int idx = tid + 256 * i, cn = idx >> 3, kc = idx & 7;
            uint4 w;
            w.x = pk2(T[(kc * 8 + 0) * 65 + cn], T[(kc * 8 + 1) * 65 + cn]);
            w.y = pk2(T[(kc * 8 + 2) * 65 + cn], T[(kc * 8 + 3) * 65 + cn]);
            w.z = pk2(T[(kc * 8 + 4) * 65 + cn], T[(kc * 8 + 5) * 65 + cn]);
            w.w = pk2(T[(kc * 8 + 6) * 65 + cn], T[(kc * 8 + 7) * 65 + cn]);
            *(uint4*)(s.dst + (size_t)(n0 + cn) * s.dld + k0 + kc * 8) = w;
        }
        __syncthreads();
    }
}

template <int DQK, int DV, bool PIPE, bool QNORM>
DEVI void attn_item(const float* qgain, float qscale, const bf16_t* Qp, int q_rs, const bf16_t* Kp, int k_rs, const bf16_t* Vtp, int vt_rs, int nkeys, bf16_t* Op, int o_rs, unsigned char* smem) {
    constexpr int KROW = (DQK + 8) * 2, VROW = 136, KT_BYTES = 64 * KROW, VT_BYTES = DV * VROW, STAGE = KT_BYTES + VT_BYTES;
    constexpr int KCH = DQK / 8, NKC = 64 * KCH / 256, NVC = DV * 8 / 256, NKK = DQK / 16, NDB = DV / 32;
    static_assert(2 * STAGE <= SM_TOTAL, "attn lds");
    int tid_ = threadIdx.x & 255; asm volatile("" : "+v"(tid_)); const int tid = tid_, lane = tid & 63, wid = tid >> 6, ql = lane & 31, half = lane >> 5;
    __syncthreads();
    bf16x8 qf[NKK];
    {
        const bf16_t* qrow = Qp + (size_t)(wid * 32 + ql) * q_rs + half * 8;
#pragma unroll
        for (int kk = 0; kk < NKK; ++kk) qf[kk] = *(const bf16x8*)(qrow + kk * 16);
    }
    if (QNORM) {
        float ss = 0.f;
#pragma unroll
        for (int kk = 0; kk < NKK; ++kk) { const uint4 w = __builtin_bit_cast(uint4, qf[kk]);
            ss += bflo(w.x) * bflo(w.x) + bfhi(w.x) * bfhi(w.x) + bflo(w.y) * bflo(w.y) + bfhi(w.y) * bfhi(w.y) + bflo(w.z) * bflo(w.z) + bfhi(w.z) * bfhi(w.z) + bflo(w.w) * bflo(w.w) + bfhi(w.w) * bfhi(w.w); }
        ss += __shfl_xor(ss, 32);
        const float inv = rsqrtf(ss * (1.f / DQK) + EPS) * qscale;
#pragma unroll
        for (int kk = 0; kk < NKK; ++kk) { const uint4 w = __builtin_bit_cast(uint4, qf[kk]);
            const f32x4 g0 = ld_f4(qgain + kk * 16 + half * 8), g1 = ld_f4(qgain + kk * 16 + half * 8 + 4); uint4 o;
            o.x = pk2(bflo(w.x) * inv * g0[0], bfhi(w.x) * inv * g0[1]); o.y = pk2(bflo(w.y) * inv * g0[2], bfhi(w.y) * inv * g0[3]);
            o.z = pk2(bflo(w.z) * inv * g1[0], bfhi(w.z) * inv * g1[1]); o.w = pk2(bflo(w.w) * inv * g1[2], bfhi(w.w) * inv * g1[3]);
            qf[kk] = __builtin_bit_cast(bf16x8, o); }
    }
    f32x16 accO[NDB];
#pragma unroll
    for (int db = 0; db < NDB; ++db)
#pragma unroll
        for (int r = 0; r < 16; ++r) accO[db][r] = 0.f;
    float m_run = -INFINITY, l_run = 0.f;
    uint4 kreg[NKC], vreg[NVC];
#define AT_LOAD(t) do { const int s0_ = (t) * 64; \
        _Pragma("unroll") for (int i = 0; i < NKC; ++i) { const int c = tid + 256 * i, row = c / KCH, kc = c % KCH; kreg[i] = *(const uint4*)(Kp + (size_t)(s0_ + row) * k_rs + kc * 8); } \
        _Pragma("unroll") for (int i = 0; i < NVC; ++i) { const int c = tid + 256 * i, d = c >> 3, kc = c & 7; vreg[i] = *(const uint4*)(Vtp + (size_t)d * vt_rs + s0_ + kc * 8); } } while (0)
#define AT_STORE(buf) do { unsigned char* Ks_ = smem + (buf) * STAGE; unsigned char* Vs_ = Ks_ + KT_BYTES; \
        _Pragma("unroll") for (int i = 0; i < NKC; ++i) { const int c = tid + 256 * i, row = c / KCH, kc = c % KCH; *(uint4*)(Ks_ + row * KROW + kc * 16) = kreg[i]; } \
        _Pragma("unroll") for (int i = 0; i < NVC; ++i) { const int c = tid + 256 * i, d = c >> 3, kc = c & 7; uint2 lo_, hi_; lo_.x = vreg[i].x; lo_.y = vreg[i].y; hi_.x = vreg[i].z; hi_.y = vreg[i].w; \
            *(uint2*)(Vs_ + d * VROW + kc * 16) = lo_; *(uint2*)(Vs_ + d * VROW + kc * 16 + 8) = hi_; } } while (0)
    const int nt = nkeys >> 6;
    if (PIPE) { AT_LOAD(0); AT_STORE(0); __syncthreads(); }
    for (int t = 0; t < nt; ++t) {
        const bool more = PIPE && (t + 1 < nt);
        if (PIPE) { if (more) AT_LOAD(t + 1); }
        else { AT_LOAD(t); AT_STORE(t & 1); __syncthreads(); }
        const unsigned char* Ks = smem + (t & 1) * STAGE;
        const unsigned char* Vs = Ks + KT_BYTES;
        f32x16 s[2];
#pragma unroll
        for (int kb = 0; kb < 2; ++kb) {
#pragma unroll
            for (int r = 0; r < 16; ++r) s[kb][r] = 0.f;
#pragma unroll
            for (int kk = 0; kk < NKK; ++kk) {
                const bf16x8 kf = *(const bf16x8*)(Ks + (kb * 32 + ql) * KROW + kk * 32 + half * 16);
                s[kb] = __builtin_amdgcn_mfma_f32_32x32x16_bf16(kf, qf[kk], s[kb], 0, 0, 0);
            }
        }
        float mx = s[0][0];
#pragma unroll
        for (int r = 1; r < 16; ++r) mx = fmaxf(mx, s[0][r]);
#pragma unroll
        for (int r = 0; r < 16; ++r) mx = fmaxf(mx, s[1][r]);
        mx = fmaxf(mx, __shfl_xor(mx, 32));
        const float m_new = fmaxf(m_run, mx);
        const float alpha = __builtin_amdgcn_exp2f(m_run - m_new);
        m_run = m_new;
        float psum = 0.f;
#pragma unroll
        for (int kb = 0; kb < 2; ++kb)
#pragma unroll
            for (int r = 0; r < 16; ++r) { const float pv = __builtin_amdgcn_exp2f(s[kb][r] - m_new); s[kb][r] = pv; psum += pv; }
        l_run = l_run * alpha + psum;
#pragma unroll
        for (int db = 0; db < NDB; ++db)
#pragma unroll
            for (int r = 0; r < 16; ++r) accO[db][r] *= alpha;
#pragma unroll
        for (int kb = 0; kb < 2; ++kb)
#pragma unroll
            for (int p2 = 0; p2 < 2; ++p2) {
                uint4 pw;
                pw.x = pk2(s[kb][8 * p2 + 0], s[kb][8 * p2 + 1]); pw.y = pk2(s[kb][8 * p2 + 2], s[kb][8 * p2 + 3]);
                pw.z = pk2(s[kb][8 * p2 + 4], s[kb][8 * p2 + 5]); pw.w = pk2(s[kb][8 * p2 + 6], s[kb][8 * p2 + 7]);
                const bf16x8 pf = __builtin_bit_cast(bf16x8, pw);
#pragma unroll
                for (int db = 0; db < NDB; ++db) {
                    const unsigned char* vp = Vs + (db * 32 + ql) * VROW + (kb * 32 + 16 * p2 + half * 4) * 2;
                    const uint2 vlo = *(const uint2*)vp, vhi = *(const uint2*)(vp + 16);
                    uint4 vw; vw.x = vlo.x; vw.y = vlo.y; vw.z = vhi.x; vw.w = vhi.y;
                    accO[db] = __builtin_amdgcn_mfma_f32_32x32x16_bf16(__builtin_bit_cast(bf16x8, vw), pf, accO[db], 0, 0, 0);
                }
            }
        if (PIPE) { if (more) AT_STORE((t + 1) & 1); __syncthreads(); }
    }
#undef AT_LOAD
#undef AT_STORE
    const float l = l_run + __shfl_xor(l_run, 32);
    const float inv = 1.f / l;
    bf16_t* orow = Op + (size_t)(wid * 32 + ql) * o_rs + half * 4;
#pragma unroll
    for (int db = 0; db < NDB; ++db)
#pragma unroll
        for (int g = 0; g < 4; ++g) {
            f32x4 v = {accO[db][4 * g] * inv, accO[db][4 * g + 1] * inv, accO[db][4 * g + 2] * inv, accO[db][4 * g + 3] * inv};
            st_bf4(orow + db * 32 + 8 * g, v);
        }
}


DEVI void attn_mla_item(const float* gq, const float* ROPEp, int pos0, const bf16_t* Qp, const bf16_t* Kp, const bf16_t* Vtp, int vt_rs, int nkeys, bf16_t* Op, unsigned char* smem, int tx) {
    constexpr int KROW = 208, VROW = 264, KT_BYTES = 128 * KROW, VT_BYTES = 64 * VROW, STAGE = KT_BYTES + VT_BYTES;
    static_assert(2 * STAGE <= 2 * SM_TOTAL, "attn lds");
    const int lane = tx & 63, wid = tx >> 6, ql = lane & 31, half = lane >> 5;
    __syncthreads();
    bf16x8 qf[6];
    {
        const bf16_t* qrow = Qp + (size_t)(wid * 32 + ql) * 768 + half * 8;
#pragma unroll
        for (int kk = 0; kk < 6; ++kk) qf[kk] = *(const bf16x8*)(qrow + kk * 16);
    }
    {
        float ss = 0.f;
#pragma unroll
        for (int kk = 0; kk < 6; ++kk) { const uint4 w = __builtin_bit_cast(uint4, qf[kk]);
            ss += bflo(w.x) * bflo(w.x) + bfhi(w.x) * bfhi(w.x) + bflo(w.y) * bflo(w.y) + bfhi(w.y) * bfhi(w.y) + bflo(w.z) * bflo(w.z) + bfhi(w.z) * bfhi(w.z) + bflo(w.w) * bflo(w.w) + bfhi(w.w) * bfhi(w.w); }
        ss += __shfl_xor(ss, 32);
        const float inv = rsqrtf(ss * (1.f / 96.f) + EPS) * QSCALE_MLA;
#pragma unroll
        for (int kk = 0; kk < 4; ++kk) { const uint4 w = __builtin_bit_cast(uint4, qf[kk]);
            const f32x4 g0 = ld_f4(gq + kk * 16 + half * 8), g1 = ld_f4(gq + kk * 16 + half * 8 + 4); uint4 o;
            o.x = pk2(bflo(w.x) * inv * g0[0], bfhi(w.x) * inv * g0[1]); o.y = pk2(bflo(w.y) * inv * g0[2], bfhi(w.y) * inv * g0[3]);
            o.z = pk2(bflo(w.z) * inv * g1[0], bfhi(w.z) * inv * g1[1]); o.w = pk2(bflo(w.w) * inv * g1[2], bfhi(w.w) * inv * g1[3]);
            qf[kk] = __builtin_bit_cast(bf16x8, o); }
        const uint4 wa = __builtin_bit_cast(uint4, qf[4]), wb = __builtin_bit_cast(uint4, qf[5]);
        const float* rp = ROPEp + ((size_t)(pos0 + wid * 32 + ql) * 16 + half * 8) * 2;
        const float* ga = gq + 64 + half * 8; const float* gb = gq + 80 + half * 8;
        float x1[8] = {bflo(wa.x), bfhi(wa.x), bflo(wa.y), bfhi(wa.y), bflo(wa.z), bfhi(wa.z), bflo(wa.w), bfhi(wa.w)};
        float x2[8] = {bflo(wb.x), bfhi(wb.x), bflo(wb.y), bfhi(wb.y), bflo(wb.z), bfhi(wb.z), bflo(wb.w), bfhi(wb.w)};
        float r1[8], r2[8];
#pragma unroll
        for (int q4 = 0; q4 < 2; ++q4) {
            const f32x4 g1v = ld_f4(ga + q4 * 4), g2v = ld_f4(gb + q4 * 4), csA = ld_f4(rp + q4 * 8), csB = ld_f4(rp + q4 * 8 + 4);
            const float co[4] = {csA[0], csA[2], csB[0], csB[2]}, si[4] = {csA[1], csA[3], csB[1], csB[3]};
#pragma unroll
            for (int j = 0; j < 4; ++j) { const float a = x1[q4 * 4 + j] * inv * g1v[j], b = x2[q4 * 4 + j] * inv * g2v[j]; r1[q4 * 4 + j] = a * co[j] - b * si[j]; r2[q4 * 4 + j] = b * co[j] + a * si[j]; }
        }
        uint4 oa, ob;
        oa.x = pk2(r1[0], r1[1]); oa.y = pk2(r1[2], r1[3]); oa.z = pk2(r1[4], r1[5]); oa.w = pk2(r1[6], r1[7]);
        ob.x = pk2(r2[0], r2[1]); ob.y = pk2(r2[2], r2[3]); ob.z = pk2(r2[4], r2[5]); ob.w = pk2(r2[6], r2[7]);
        qf[4] = __builtin_bit_cast(bf16x8, oa); qf[5] = __builtin_bit_cast(bf16x8, ob);
    }
    f32x16 accO[2];
#pragma unroll
    for (int db = 0; db < 2; ++db)
#pragma unroll
        for (int r = 0; r < 16; ++r) accO[db][r] = 0.f;
    float m_run = -INFINITY, l_run = 0.f;
    uint4 kreg[3], vreg[2];
#define AM_LOAD(t) do { const int s0_ = (t) * 128; \
        _Pragma("unroll") for (int i = 0; i < 3; ++i) { const int c = tx + 512 * i, row = c / 12, kc = c % 12; kreg[i] = *(const uint4*)(Kp + (size_t)(s0_ + row) * 768 + kc * 8); } \
        _Pragma("unroll") for (int i = 0; i < 2; ++i) { const int c = tx + 512 * i, d = c >> 4, kc = c & 15; vreg[i] = *(const uint4*)(Vtp + (size_t)d * vt_rs + s0_ + kc * 8); } } while (0)
#define AM_STORE(buf) do { unsigned char* Ks_ = smem + (buf) * STAGE; unsigned char* Vs_ = Ks_ + KT_BYTES; \
        _Pragma("unroll") for (int i = 0; i < 3; ++i) { const int c = tx + 512 * i, row = c / 12, kc = c % 12; *(uint4*)(Ks_ + row * KROW + kc * 16) = kreg[i]; } \
        _Pragma("unroll") for (int i = 0; i < 2; ++i) { const int c = tx + 512 * i, d = c >> 4, kc = c & 15; uint2 lo_, hi_; lo_.x = vreg[i].x; lo_.y = vreg[i].y; hi_.x = vreg[i].z; hi_.y = vreg[i].w; \
            *(uint2*)(Vs_ + d * VROW + kc * 16) = lo_; *(uint2*)(Vs_ + d * VROW + kc * 16 + 8) = hi_; } } while (0)
    const int nt = nkeys >> 7;
    AM_LOAD(0); AM_STORE(0); __syncthreads();
    for (int t = 0; t < nt; ++t) {
        const bool more = t + 1 < nt;
        if (more) AM_LOAD(t + 1);
        const unsigned char* Ks = smem + (t & 1) * STAGE;
        const unsigned char* Vs = Ks + KT_BYTES;
        f32x16 s[4];
#pragma unroll
        for (int kb = 0; kb < 4; ++kb)
#pragma unroll
            for (int r = 0; r < 16; ++r) s[kb][r] = 0.f;
#pragma unroll
        for (int kk = 0; kk < 6; ++kk)
#pragma unroll
            for (int kb = 0; kb < 4; ++kb) {
                const bf16x8 kf = *(const bf16x8*)(Ks + (kb * 32 + ql) * KROW + kk * 32 + half * 16);
                s[kb] = __builtin_amdgcn_mfma_f32_32x32x16_bf16(kf, qf[kk], s[kb], 0, 0, 0);
            }
        float mx = -INFINITY;
#pragma unroll
        for (int kb = 0; kb < 4; ++kb)
#pragma unroll
            for (int r = 0; r < 16; r += 2) mx = fmaxf(fmaxf(mx, s[kb][r]), s[kb][r + 1]);
        mx = fmaxf(mx, __shfl_xor(mx, 32));
        const float m_new = fmaxf(m_run, mx);
        if (__any(m_new > m_run)) {
            const float alpha = __builtin_amdgcn_exp2f(m_run - m_new);
            l_run *= alpha;
#pragma unroll
            for (int db = 0; db < 2; ++db)
#pragma unroll
                for (int r = 0; r < 16; ++r) accO[db][r] *= alpha;
        }
        m_run = m_new;
        float psum = 0.f;
#pragma unroll
        for (int kb = 0; kb < 4; ++kb)
#pragma unroll
            for (int r = 0; r < 16; ++r) { const float pv = __builtin_amdgcn_exp2f(s[kb][r] - m_new); s[kb][r] = pv; psum += pv; }
        l_run += psum;
#pragma unroll
        for (int kb = 0; kb < 4; ++kb)
#pragma unroll
            for (int p2 = 0; p2 < 2; ++p2) {
                uint4 pw;
                pw.x = pk2(s[kb][8 * p2 + 0], s[kb][8 * p2 + 1]); pw.y = pk2(s[kb][8 * p2 + 2], s[kb][8 * p2 + 3]);
                pw.z = pk2(s[kb][8 * p2 + 4], s[kb][8 * p2 + 5]); pw.w = pk2(s[kb][8 * p2 + 6], s[kb][8 * p2 + 7]);
                const bf16x8 pf = __builtin_bit_cast(bf16x8, pw);
#pragma unroll
                for (int db = 0; db < 2; ++db) {
                    const unsigned char* vp = Vs + (db * 32 + ql) * VROW + (kb * 32 + 16 * p2 + half * 4) * 2;
                    const uint2 vlo = *(const uint2*)vp, vhi = *(const uint2*)(vp + 16);
                    uint4 vw; vw.x = vlo.x; vw.y = vlo.y; vw.z = vhi.x; vw.w = vhi.y;
                    accO[db] = __builtin_amdgcn_mfma_f32_32x32x16_bf16(__builtin_bit_cast(bf16x8, vw), pf, accO[db], 0, 0, 0);
                }
            }
        if (more) AM_STORE((t + 1) & 1);
        __syncthreads();
    }
#undef AM_LOAD
#undef AM_STORE
    const float l = l_run + __shfl_xor(l_run, 32);
    const float inv = 1.f / l;
    bf16_t* orow = Op + (size_t)(wid * 32 + ql) * 512 + half * 4;
#pragma unroll
    for (int db = 0; db < 2; ++db)
#pragma unroll
        for (int g = 0; g < 4; ++g) {
            f32x4 v = {accO[db][4 * g] * inv, accO[db][4 * g + 1] * inv, accO[db][4 * g + 2] * inv, accO[db][4 * g + 3] * inv};
            st_bf4(orow + db * 32 + 8 * g, v);
        }
}

namespace pg8 {
#define PG8_LAS __attribute__((address_space(3)))
typedef unsigned short bf16_t;
typedef short bf16x8 __attribute__((ext_vector_type(8)));
typedef float f32x4 __attribute__((ext_vector_type(4)));
typedef unsigned u32x4 __attribute__((ext_vector_type(4)));
constexpr int BM = 256, BK = 64, HALF = 128, HTB = HALF * BK * 2  , STAGE_BYTES = 8 * HTB, NXCD = 8, WGM = 8;

__host__ __device__ __forceinline__ int lds_byte(int r, int c) { const int st = (r >> 4) * 2 + (c >> 5), rr = r & 15, cc = c & 31, ob = rr * 64 + cc * 2; return st * 1024 + (ob ^ (((ob >> 9) & 1) << 5)); }
__host__ __device__ __forceinline__ void stage_rc(int b, int& R, int& C) { const int st = b / 1024, sb = b % 1024, swz = sb ^ (((sb >> 9) & 1) << 5); R = (st >> 1) * 16 + swz / 64; C = (st & 1) * 32 + (swz % 64) / 2; }
__host__ __device__ __forceinline__ int perm32(int rho) { const int n = rho >> 4, i = rho & 15; return 8 * (i >> 2) + 4 * n + (i & 3); }

struct Unit { int pm, pn; };
struct Gemm { const bf16_t* A; const bf16_t* Bt; int M, N, K, lda, ldb; size_t kstepA, kstepB; };

struct StaticOrder {
    int nM, nN, nwg, G, c;
    __host__ __device__ void init(int M, int N, int G_, int c_) { nM = M / BM; nN = N / BM; nwg = nM * nN; G = G_; c = c_; }
    __host__ __device__ bool next(int i, Unit& u) const {
        const long L = (long)i * G + c; if (L >= nwg) return false;
        int wgid = (int)L; { const int q = nwg / NXCD, r = nwg % NXCD, xcd = wgid % NXCD, off = wgid / NXCD; wgid = (xcd < r ? xcd * (q + 1) : r * (q + 1) + (xcd - r) * q) + off; }
        const int nig = WGM * nN, gid = wgid / nig, fm = gid * WGM, gsz = (nM - fm) < WGM ? (nM - fm) : WGM;
        u.pm = fm + ((wgid % nig) % gsz); u.pn = (wgid % nig) / gsz; return true;
    }
    __device__ __forceinline__ void a_ready(const Unit&) const {}
    __device__ __forceinline__ void done(const Unit&) const {}
};


DEVI float rs_inv(const float* rs, int row) { return rsqrtf(rs[row] * (1.f / 1024.f) + EPS); }
struct EpiGU {
    static constexpr bool PERM = false, AFTER_DRAIN = false;
    bf16_t* HID; const float* rs;
    __device__ __forceinline__ void operator()(const f32x4 (&acc)[2][2][4][2], const Unit& u, int wr, int wc, int fr, int fq) const {
        asm volatile("" : "+v"(fr), "+v"(fq));
#pragma unroll
        for (int ai = 0; ai < 2; ++ai)
#pragma unroll
            for (int m = 0; m < 4; ++m) {
                const int row = u.pm * BM + ai * HALF + wr * 64 + m * 16 + fr; const float ri = rs_inv(rs, row);
                bf16_t* rowp = HID + ((size_t)(u.pn * 2) * NTOK + (size_t)(u.pm * 2 + ai) * 128) * 64 + ((wr * 4 + m) * 4 + wc) * 256 + fr * 16 + fq * 4;
#pragma unroll
                for (int bj = 0; bj < 2; ++bj) {
                    const f32x4 g = acc[ai][bj][m][0] * ri, up = acc[ai][bj][m][1] * ri; f32x4 h;
#pragma unroll
                    for (int j = 0; j < 4; ++j) h[j] = g[j] * __builtin_amdgcn_rcpf(1.f + __expf(-g[j])) * up[j];
                    ::st_bf4(rowp + (size_t)bj * NTOK * 64, h);
                }
            }
    }
};
template <int RES> struct EpiRes {
    static constexpr bool PERM = false, AFTER_DRAIN = false;
    const float* rf0; const float* rf1; const bf16_t* rb; bf16_t* out; float* rs; float scale;
    __device__ __forceinline__ void operator()(const f32x4 (&acc)[2][2][4][2], const Unit& u, int wr, int wc, int fr, int fq) const {
        asm volatile("" : "+v"(fr), "+v"(fq));
#pragma unroll
        for (int ai = 0; ai < 2; ++ai) {
            const int row0 = u.pm * BM + ai * HALF + wr * 64 + fr, col0 = u.pn * BM + wc * 32 + fq * 4;
            f32x4 r[4][2][2];
#pragma unroll
            for (int m = 0; m < 4; ++m) {
                const int row = row0 + m * 16;
                const float* rp = (row < 16384 ? rf0 + (size_t)row * 1024 : rf1 + (size_t)(row - 16384) * 1024) + col0;
#pragma unroll
                for (int bj = 0; bj < 2; ++bj)
#pragma unroll
                    for (int n = 0; n < 2; ++n) r[m][bj][n] = RES == 0 ? ::ld_f4(rp + bj * HALF + n * 16) : ::ld_bf4(rb + (size_t)row * 1024 + col0 + bj * HALF + n * 16);
            }
#pragma unroll
            for (int m = 0; m < 4; ++m) {
                const int row = row0 + m * 16;
                float ss = 0.f;
#pragma unroll
                for (int bj = 0; bj < 2; ++bj)
#pragma unroll
                    for (int n = 0; n < 2; ++n) {
                        const f32x4 o = r[m][bj][n] + acc[ai][bj][m][n] * scale;
                        ss += ::dot4(o);
                        ::st_bf4(out + (size_t)row * 1024 + col0 + bj * HALF + n * 16, o);
                    }
                ss = ::red4q(ss);
                if (fq == 0) atomicAdd(rs + row, ss);
            }
        }
    }
};
struct EpiFinal {
    static constexpr bool PERM = false, AFTER_DRAIN = false;
    const bf16_t* rb; float* out;
    __device__ __forceinline__ void operator()(const f32x4 (&acc)[2][2][4][2], const Unit& u, int wr, int wc, int fr, int fq) const {
        asm volatile("" : "+v"(fr), "+v"(fq));
#pragma unroll
        for (int ai = 0; ai < 2; ++ai)
#pragma unroll
            for (int m = 0; m < 4; ++m) {
                const size_t off = (size_t)(u.pm * BM + ai * HALF + wr * 64 + m * 16 + fr) * 1024 + u.pn * BM + wc * 32 + fq * 4;
#pragma unroll
                for (int bj = 0; bj < 2; ++bj)
#pragma unroll
                    for (int n = 0; n < 2; ++n) { const f32x4 o = ::ld_bf4(rb + off + bj * HALF + n * 16) + acc[ai][bj][m][n] * 0.5f; *(float4*)(out + off + bj * HALF + n * 16) = make_float4(o[0], o[1], o[2], o[3]); }
            }
    }
};

struct EpiQ {
    static constexpr bool PERM = false, AFTER_DRAIN = false;
    const float* RSQ; bf16_t* Q;
    __device__ __forceinline__ void operator()(const f32x4 (&acc)[2][2][4][2], const Unit& u, int wr, int wc, int fr, int fq) const {
        asm volatile("" : "+v"(fr), "+v"(fq));
#pragma unroll
        for (int ai = 0; ai < 2; ++ai)
#pragma unroll
            for (int m = 0; m < 4; ++m) {
                const int row = u.pm * BM + ai * HALF + wr * 64 + m * 16 + fr; const float ri = rsqrtf(RSQ[row] * (1.f / 384.f) + EPS);
                bf16_t* d = Q + (size_t)row * 768 + u.pn * BM + wc * 32 + fq * 4;
#pragma unroll
                for (int bj = 0; bj < 2; ++bj)
#pragma unroll
                    for (int n = 0; n < 2; ++n) ::st_bf4(d + bj * HALF + n * 16, acc[ai][bj][m][n] * ri);
            }
    }
};
struct EpiK {
    static constexpr bool PERM = false, AFTER_DRAIN = false;
    const float* RSKV; const bf16_t* CKV; const float* gk; const float* ROPE; bf16_t* K;
    __device__ __forceinline__ void operator()(const f32x4 (&acc)[2][2][4][2], const Unit& u, int wr, int wc, int fr, int fq) const {
        asm volatile("" : "+v"(fr), "+v"(fq));
        const int h = u.pn * 4 + wc;
#pragma unroll
        for (int ai = 0; ai < 2; ++ai) {
            uint2 krA[4], krB[4]; float rsv[4];
#pragma unroll
            for (int m = 0; m < 4; ++m) {
                const int row = u.pm * BM + ai * HALF + wr * 64 + m * 16 + fr;
                rsv[m] = RSKV[row];
                krA[m] = *(const uint2*)(CKV + (size_t)row * 288 + 256 + fq * 4);
                krB[m] = *(const uint2*)(CKV + (size_t)row * 288 + 272 + fq * 4);
            }
#pragma unroll
            for (int m = 0; m < 4; ++m) {
                const int row = u.pm * BM + ai * HALF + wr * 64 + m * 16 + fr; const float ri = rsqrtf(rsv[m] * (1.f / 256.f) + EPS);
                float s = 0.f;
#pragma unroll
                for (int bj = 0; bj < 2; ++bj)
#pragma unroll
                    for (int n = 0; n < 2; ++n) s += ::dot4(acc[ai][bj][m][n]);
                s *= ri * ri;
                const uint2 wa = krA[m], wb = krB[m];
                const f32x4 kr1 = {::bflo(wa.x), ::bfhi(wa.x), ::bflo(wa.y), ::bfhi(wa.y)}, kr2 = {::bflo(wb.x), ::bfhi(wb.x), ::bflo(wb.y), ::bfhi(wb.y)};
                s += ::dot4(kr1) + ::dot4(kr2);
                s = ::red4q(s);
                const float inv = rsqrtf(s * (1.f / 96.f) + EPS), rinv = ri * inv;
                bf16_t* dst = K + ((size_t)row * 8 + h) * 96;
#pragma unroll
                for (int bj = 0; bj < 2; ++bj)
#pragma unroll
                    for (int n = 0; n < 2; ++n) { const int c = bj * 32 + n * 16 + fq * 4; ::st_bf4(dst + c, acc[ai][bj][m][n] * rinv * ::ld_f4(gk + c)); }
                const int pos = ::tok_pos(row);
                const f32x4 x1 = kr1 * inv * ::ld_f4(gk + 64 + fq * 4), x2 = kr2 * inv * ::ld_f4(gk + 80 + fq * 4);
                const f32x4 cs0 = ::ld_f4(ROPE + ((size_t)pos * 16 + fq * 4) * 2), cs1 = ::ld_f4(ROPE + ((size_t)pos * 16 + fq * 4) * 2 + 4);
                const f32x4 co = {cs0[0], cs0[2], cs1[0], cs1[2]}, si = {cs0[1], cs0[3], cs1[1], cs1[3]};
                ::st_bf4(dst + 64 + fq * 4, x1 * co - x2 * si);
                ::st_bf4(dst + 80 + fq * 4, x2 * co + x1 * si);
            }
        }
    }
};
struct EpiVt {
    static constexpr bool PERM = false, AFTER_DRAIN = false;
    const float* RSKV; bf16_t* VT;
    __device__ __forceinline__ void operator()(const f32x4 (&acc)[2][2][4][2], const Unit& u, int wr, int wc, int fr, int fq) const {
        asm volatile("" : "+v"(fr), "+v"(fq));
#pragma unroll
        for (int bj = 0; bj < 2; ++bj)
#pragma unroll
            for (int n = 0; n < 2; ++n) {
                const int tok0 = u.pn * BM + bj * HALF + wc * 32 + n * 16 + fq * 4;
                f32x4 ric = ::ld_f4(RSKV + tok0);
#pragma unroll
                for (int j = 0; j < 4; ++j) ric[j] = rsqrtf(ric[j] * (1.f / 256.f) + EPS);
#pragma unroll
                for (int ai = 0; ai < 2; ++ai)
#pragma unroll
                    for (int m = 0; m < 4; ++m) {
                        const int hd = u.pm * BM + ai * HALF + wr * 64 + m * 16 + fr, h = hd >> 6, d = hd & 63;
                        size_t off;
                        if (tok0 < 16384) off = ((size_t)((tok0 >> 13) * 8 + h) * 64 + d) * 8192 + (tok0 & 8191);
                        else { const int tt = tok0 - 16384; off = (size_t)8388608 + ((size_t)((tt >> 12) * 8 + h) * 64 + d) * 4096 + (tt & 4095); }
                        ::st_bf4(VT + off, acc[ai][bj][m][n] * ric);
                    }
            }
    }
};
struct EpiIn1 {
    static constexpr bool PERM = false, AFTER_DRAIN = false;
    const float* rs1; bf16_t* CQ; bf16_t* CKV; bf16_t* XQ; float* RSQ; float* RSKV;
    __device__ __forceinline__ void operator()(const f32x4 (&acc)[2][2][4][2], const Unit& u, int wr, int wc, int fr, int fq) const {
        asm volatile("" : "+v"(fr), "+v"(fq));
#pragma unroll
        for (int bj = 0; bj < 2; ++bj) {
            const int cg = u.pn * BM + bj * HALF + wc * 32;
            bf16_t* dst; int ld, c0; float* rs = nullptr;
            if (cg < 384) { dst = CQ; ld = 384; c0 = cg; rs = RSQ; }
            else if (cg < 640) { dst = CKV; ld = 288; c0 = cg - 384; rs = RSKV; }
            else if (cg < 672) { dst = CKV; ld = 288; c0 = 256 + (cg - 640); }
            else if (cg < 768) continue;
            else { dst = XQ; ld = 512; c0 = cg - 768; }
#pragma unroll
            for (int ai = 0; ai < 2; ++ai)
#pragma unroll
                for (int m = 0; m < 4; ++m) {
                    const int row = u.pm * BM + ai * HALF + wr * 64 + m * 16 + fr; const float ri = rs_inv(rs1, row);
                    const f32x4 v0 = acc[ai][bj][m][0] * ri, v1 = acc[ai][bj][m][1] * ri;
                    ::st_bf4(dst + (size_t)row * ld + c0 + fq * 4, v0); ::st_bf4(dst + (size_t)row * ld + c0 + 16 + fq * 4, v1);
                    if (rs) { const float s = ::red4q(::dot4(v0) + ::dot4(v1)); if (fq == 0) atomicAdd(rs + row, s); }
                }
        }
    }
};
struct EpiIn2 {
    static constexpr bool PERM = false, AFTER_DRAIN = false;
    const float* rs1; bf16_t* CB; bf16_t* U;
    __device__ __forceinline__ void operator()(const f32x4 (&acc)[2][2][4][2], const Unit& u, int wr, int wc, int fr, int fq) const {
        asm volatile("" : "+v"(fr), "+v"(fq));
#pragma unroll
        for (int ai = 0; ai < 2; ++ai)
#pragma unroll
            for (int m = 0; m < 4; ++m) {
                const int row = u.pm * BM + ai * HALF + wr * 64 + m * 16 + fr; const float ri = rs_inv(rs1, row);
#pragma unroll
                for (int bj = 0; bj < 2; ++bj) {
                    const f32x4 v0 = acc[ai][bj][m][0] * ri, v1 = acc[ai][bj][m][1] * ri;
                    if (u.pn < 2) { bf16_t* d = CB + (size_t)row * 512 + u.pn * BM + bj * HALF + wc * 32 + fq * 4; ::st_bf4(d, v0); ::st_bf4(d + 16, v1); }
                    else ::st_bf4(U + (size_t)row * 512 + (u.pn - 2) * 128 + bj * 64 + wc * 16 + fq * 4, v0 * v1);
                }
            }
    }
};
template <class Epi, class Sched, bool ALIGN_EPI = false, bool SP2 = false>
__device__ __forceinline__ void gemm_phase(PG8_LAS unsigned char* lds, const Gemm g, const Sched& S, const Epi& E) {
    int tid_ = threadIdx.x; asm volatile("" : "+v"(tid_));
    const int tid = tid_, wid = __builtin_amdgcn_readfirstlane(tid >> 6), lane = tid & 63, wr = wid >> 2, wc = wid & 3, fr = lane & 15, fq = lane >> 4;
    const int K = g.K, nt = K / BK;
    unsigned voffA[2], voffB[2];
#pragma unroll
    for (int i = 0; i < 2; ++i) { int R, C; stage_rc(tid * 16 + i * 8192, R, C); const int Rb = Epi::PERM ? ((R & ~31) + perm32(R & 31)) : R;
        voffA[i] = g.lda ? (unsigned)(R * g.lda + C) * 2u : (unsigned)(((R >> 4) * 4 + (C >> 4)) * 512 + (R & 15) * 32 + ((C >> 3) & 1) * 16);
        voffB[i] = (unsigned)(Rb * g.ldb + C) * 2u; }
    const size_t kstepA = g.kstepA, kstepB = g.kstepB;
    const size_t hstepA = (size_t)HALF * (g.lda ? g.lda : 64) * 2, hstepB = (size_t)HALF * g.ldb * 2;
    const size_t tstepA = 2 * hstepA, tstepB = 2 * hstepB;
    const unsigned ldsw = (unsigned)wid * 1024u;
    const int aoff = lds_byte(wr * 64 + fr, fq * 8), boff = lds_byte(wc * 32 + fr, fq * 8);
#define PG8_SA(b, h) (((b) * 2 + (h)) * HTB)
#define PG8_SB(b, h) ((4 + (b) * 2 + (h)) * HTB)
#define PG8_STAGE(bufoff, gbase, voff) do { _Pragma("unroll") for (int _i = 0; _i < 2; ++_i) \
        __builtin_amdgcn_global_load_lds((const unsigned*)((const char*)(gbase) + (voff)[_i]), (PG8_LAS unsigned*)(lds + (bufoff) + ldsw + _i * 8192), 16, 0, 0); } while (0)
#define PG8_LDA(dst, b, h) do { _Pragma("unroll") for (int m = 0; m < 4; ++m) _Pragma("unroll") for (int k = 0; k < 2; ++k) dst[m][k] = *(const PG8_LAS bf16x8*)(lds + PG8_SA(b, h) + aoff + m * 2048 + k * 1024); } while (0)
#define PG8_LDB(dst, b, h) do { _Pragma("unroll") for (int n = 0; n < 2; ++n) _Pragma("unroll") for (int k = 0; k < 2; ++k) dst[n][k] = *(const PG8_LAS bf16x8*)(lds + PG8_SB(b, h) + boff + n * 2048 + k * 1024); } while (0)
#define PG8_MMA(ai, bj, At, Bt) do { __builtin_amdgcn_s_setprio(1); _Pragma("unroll") for (int m = 0; m < 4; ++m) _Pragma("unroll") for (int n = 0; n < 2; ++n) _Pragma("unroll") for (int k = 0; k < 2; ++k) \
        acc[ai][bj][m][n] = __builtin_amdgcn_mfma_f32_16x16x32_bf16(Bt[n][k], At[m][k], acc[ai][bj][m][n], 0, 0, 0); __builtin_amdgcn_s_setprio(0); } while (0)
#define PG8_WAIT_V(n) asm volatile("s_waitcnt vmcnt(" #n ")" ::: "memory")
#define PG8_WAIT_L(n) asm volatile("s_waitcnt lgkmcnt(" #n ")" ::: "memory")
#define PG8_BAR __builtin_amdgcn_s_barrier()
#define PG8_SCHED __builtin_amdgcn_sched_barrier(0)
    Unit cur, nxt; int ui = 0;
    if (!S.next(0, cur)) return;
    f32x4 acc[2][2][4][2];
#pragma unroll
    for (int a = 0; a < 2; ++a)
#pragma unroll
        for (int b = 0; b < 2; ++b)
#pragma unroll
            for (int m = 0; m < 4; ++m)
#pragma unroll
                for (int n = 0; n < 2; ++n) acc[a][b][m][n] = (f32x4){0.f, 0.f, 0.f, 0.f};
    bf16x8 At[4][2], B0[2][2], B1[2][2];
    const char* cA = (const char*)g.A + (size_t)cur.pm * tstepA; const char* cB = (const char*)g.Bt + (size_t)cur.pn * tstepB;
    S.a_ready(cur);
    if constexpr (SP2) {
        PG8_STAGE(PG8_SB(0, 0), cB, voffB); PG8_STAGE(PG8_SB(0, 1), cB + hstepB, voffB); PG8_STAGE(PG8_SA(0, 0), cA, voffA); PG8_STAGE(PG8_SA(0, 1), cA + hstepA, voffA);
        if (wr == 1) PG8_BAR;
        PG8_WAIT_V(2); PG8_BAR;
        PG8_STAGE(PG8_SB(1, 0), cB + kstepB, voffB); PG8_STAGE(PG8_SA(1, 0), cA + kstepA, voffA); PG8_STAGE(PG8_SB(1, 1), cB + hstepB + kstepB, voffB);
        PG8_WAIT_V(6); PG8_BAR;
    } else {
        PG8_STAGE(PG8_SB(0, 0), cB, voffB); PG8_STAGE(PG8_SA(0, 0), cA, voffA); PG8_STAGE(PG8_SB(0, 1), cB + hstepB, voffB); PG8_STAGE(PG8_SA(0, 1), cA + hstepA, voffA);
        if (wr == 1) PG8_BAR;
        PG8_WAIT_V(4); PG8_BAR;
        PG8_STAGE(PG8_SB(1, 0), cB + kstepB, voffB); PG8_STAGE(PG8_SA(1, 0), cA + kstepA, voffA); PG8_STAGE(PG8_SB(1, 1), cB + hstepB + kstepB, voffB);
        PG8_WAIT_V(6); PG8_BAR;
    }
    for (;;) {
        const bool has_next = S.next(ui + 1, nxt);
        const char* nA = has_next ? (const char*)g.A + (size_t)nxt.pm * tstepA : cA; const char* nB = has_next ? (const char*)g.Bt + (size_t)nxt.pn * tstepB : cB;
        for (int t = 0; t < nt; t += 2) {
            const bool last = (t == nt - 2);
            const char* a1 = cA + (size_t)(t + 1) * kstepA;
            const char* a2 = last ? nA : cA + (size_t)(t + 2) * kstepA; const char* b2 = last ? nB : cB + (size_t)(t + 2) * kstepB;
            const char* a3 = a2 + kstepA; const char* b3 = b2 + kstepB;
            if (last && has_next) S.a_ready(nxt);
            if constexpr (SP2) {
            PG8_LDB(B0, 0, 0); PG8_LDB(B1, 0, 1); PG8_SCHED; PG8_LDA(At, 0, 0); PG8_STAGE(PG8_SA(1, 1), a1 + hstepA, voffA);
            PG8_WAIT_V(8); PG8_WAIT_L(0); PG8_BAR; PG8_MMA(0, 0, At, B0); PG8_MMA(0, 1, At, B1); PG8_BAR; PG8_SCHED;
            PG8_LDA(At, 0, 1); PG8_STAGE(PG8_SB(0, 0), b2, voffB); PG8_STAGE(PG8_SB(0, 1), b2 + hstepB, voffB); PG8_STAGE(PG8_SA(0, 0), a2, voffA);
            PG8_WAIT_V(8); PG8_WAIT_L(0); PG8_BAR; PG8_MMA(1, 0, At, B0); PG8_MMA(1, 1, At, B1); PG8_BAR; PG8_SCHED;
            PG8_LDB(B0, 1, 0); PG8_LDB(B1, 1, 1); PG8_SCHED; PG8_LDA(At, 1, 0); PG8_STAGE(PG8_SA(0, 1), a2 + hstepA, voffA);
            PG8_WAIT_V(8); PG8_WAIT_L(0); PG8_BAR; PG8_MMA(0, 0, At, B0); PG8_MMA(0, 1, At, B1); PG8_BAR; PG8_SCHED;
            PG8_LDA(At, 1, 1); PG8_STAGE(PG8_SB(1, 0), b3, voffB); PG8_STAGE(PG8_SB(1, 1), b3 + hstepB, voffB); PG8_STAGE(PG8_SA(1, 0), a3, voffA);
            PG8_WAIT_V(8); PG8_WAIT_L(0); PG8_BAR; PG8_MMA(1, 0, At, B0); PG8_MMA(1, 1, At, B1); PG8_BAR; PG8_SCHED;
            } else {
            PG8_LDB(B0, 0, 0); PG8_SCHED; PG8_LDA(At, 0, 0); PG8_STAGE(PG8_SA(1, 1), a1 + hstepA, voffA);
            PG8_WAIT_L(8); PG8_BAR; PG8_WAIT_L(0); PG8_MMA(0, 0, At, B0); PG8_BAR; PG8_SCHED;
            PG8_LDB(B1, 0, 1); PG8_STAGE(PG8_SB(0, 0), b2, voffB);
            PG8_BAR; PG8_WAIT_L(0); PG8_MMA(0, 1, At, B1); PG8_BAR;
            PG8_LDA(At, 0, 1); PG8_STAGE(PG8_SA(0, 0), a2, voffA);
            PG8_BAR; PG8_WAIT_L(0); PG8_MMA(1, 0, At, B0); PG8_BAR; PG8_SCHED;
            PG8_STAGE(PG8_SB(0, 1), b2 + hstepB, voffB);
            PG8_WAIT_V(6); PG8_BAR; PG8_MMA(1, 1, At, B1); PG8_BAR;
            PG8_LDB(B0, 1, 0); PG8_SCHED; PG8_LDA(At, 1, 0); PG8_STAGE(PG8_SA(0, 1), a2 + hstepA, voffA);
            PG8_WAIT_L(8); PG8_BAR; PG8_WAIT_L(0); PG8_MMA(0, 0, At, B0); PG8_BAR; PG8_SCHED;
            PG8_LDB(B1, 1, 1); PG8_STAGE(PG8_SB(1, 0), b3, voffB);
            PG8_BAR; PG8_WAIT_L(0); PG8_MMA(0, 1, At, B1); PG8_BAR;
            PG8_LDA(At, 1, 1); PG8_STAGE(PG8_SA(1, 0), a3, voffA);
            PG8_BAR; PG8_WAIT_L(0); PG8_MMA(1, 0, At, B0); PG8_BAR; PG8_SCHED;
            PG8_STAGE(PG8_SB(1, 1), b3 + hstepB, voffB);
            PG8_WAIT_V(6); PG8_BAR; PG8_MMA(1, 1, At, B1); PG8_BAR;
            }
        }
        if constexpr (ALIGN_EPI) { if (wr == 0) PG8_BAR; }
        if constexpr (!Epi::AFTER_DRAIN) { E(acc, cur, wr, wc, fr, fq); S.done(cur); }
        if (!has_next) break;
#pragma unroll
        for (int a = 0; a < 2; ++a)
#pragma unroll
            for (int b = 0; b < 2; ++b)
#pragma unroll
                for (int m = 0; m < 4; ++m)
#pragma unroll
                    for (int n = 0; n < 2; ++n) acc[a][b][m][n] = (f32x4){0.f, 0.f, 0.f, 0.f};
        cur = nxt; cA = nA; cB = nB; ++ui;
        if constexpr (ALIGN_EPI) { if (wr == 1) PG8_BAR; }
    }
    PG8_WAIT_V(0);
    if constexpr (!ALIGN_EPI) { if (wr == 0) PG8_BAR; }
    PG8_BAR;
    if constexpr (Epi::AFTER_DRAIN) { E.fused(acc, cur, wr, wc, fr, fq, lds, wid, lane); S.done(cur); }
#undef PG8_SA
#undef PG8_SB
#undef PG8_STAGE
#undef PG8_LDA
#undef PG8_LDB
#undef PG8_MMA
#undef PG8_WAIT_V
#undef PG8_WAIT_L
#undef PG8_BAR
#undef PG8_SCHED
}
struct MUnit { int pm, pn, b, g; };
template <class Epi>
__device__ __forceinline__ void gemm_phase_merge(PG8_LAS unsigned char* lds, const unsigned char* ws, const bf16_t* XBp, const StaticOrder& S, const Epi& E) {
    int tid_ = threadIdx.x; asm volatile("" : "+v"(tid_));
    const int tid = tid_, wid = __builtin_amdgcn_readfirstlane(tid >> 6), lane = tid & 63, wr = wid >> 2, wc = wid & 3, fr = lane & 15, fq = lane >> 4;
    unsigned vY0, vGd;
    { int R, C; stage_rc(tid * 16, R, C); vY0 = (unsigned)(R * 512 + C) * 2u; vGd = (unsigned)(R * 512) * 2u; }
    constexpr size_t kstep = (size_t)(BK * 2), hY = (size_t)HALF * 512 * 2, hG = (size_t)HALF * 1024 * 2;
    const unsigned ldsw = (unsigned)wid * 1024u;
    const int aoff = lds_byte(wr * 64 + fr, fq * 8), boff = lds_byte(wc * 32 + fr, fq * 8);
#define PG8_SA(b, h) (((b) * 2 + (h)) * HTB)
#define PG8_SB(b, h) ((4 + (b) * 2 + (h)) * HTB)
#define PG8_STAGE(bufoff, gbase, voff, q64) do { const char* gb0_ = (const char*)(gbase); const char* gb1_ = gb0_ + (q64); unsigned vo_ = (voff); \
        asm volatile("" : "+s"(gb0_)); asm volatile("" : "+s"(gb1_)); asm volatile("" : "+v"(vo_));        \
        __builtin_amdgcn_global_load_lds((const unsigned*)(gb0_ + vo_), (PG8_LAS unsigned*)(lds + (bufoff) + ldsw), 16, 0, 0); \
        __builtin_amdgcn_global_load_lds((const unsigned*)(gb1_ + vo_), (PG8_LAS unsigned*)(lds + (bufoff) + ldsw + 8192), 16, 0, 0); } while (0)
#define PG8_LDA(dst, b, h) do { _Pragma("unroll") for (int m = 0; m < 4; ++m) _Pragma("unroll") for (int k = 0; k < 2; ++k) dst[m][k] = *(const PG8_LAS bf16x8*)(lds + PG8_SA(b, h) + aoff + m * 2048 + k * 1024); } while (0)
#define PG8_LDB(dst, b, h) do { _Pragma("unroll") for (int n = 0; n < 2; ++n) _Pragma("unroll") for (int k = 0; k < 2; ++k) dst[n][k] = *(const PG8_LAS bf16x8*)(lds + PG8_SB(b, h) + boff + n * 2048 + k * 1024); } while (0)
#define PG8_MMA(ai, bj, At, Bt) do { __builtin_amdgcn_s_setprio(1); _Pragma("unroll") for (int m = 0; m < 4; ++m) _Pragma("unroll") for (int n = 0; n < 2; ++n) _Pragma("unroll") for (int k = 0; k < 2; ++k) \
        acc[ai][bj][m][n] = __builtin_amdgcn_mfma_f32_16x16x32_bf16(Bt[n][k], At[m][k], acc[ai][bj][m][n], 0, 0, 0); __builtin_amdgcn_s_setprio(0); } while (0)
#define PG8_WAIT_V(n) asm volatile("s_waitcnt vmcnt(" #n ")" ::: "memory")
#define PG8_WAIT_L(n) asm volatile("s_waitcnt lgkmcnt(" #n ")" ::: "memory")
#define PG8_BAR __builtin_amdgcn_s_barrier()
#define PG8_SCHED __builtin_amdgcn_sched_barrier(0)
#define MU_NEXT(i, u, ok) do { Unit t_; const int ti_ = (i) / 6, sub_ = (i) - 6 * ti_; ok = S.next(ti_, t_); u.pm = t_.pm; u.pn = t_.pn; u.b = sub_ >> 1; u.g = sub_ & 1; } while (0)
#define MU_BASEA(u) ((u).g ? (const char*)XBp + (size_t)(u).pm * (2 * hG) : (const char*)ws + ((u).b == 0 ? OFF_AO : ((u).b == 1 ? OFF_CB : OFF_XQ)) + (size_t)(u).pm * (2 * hY))
#define MU_BASEB(u) ((u).g ? (const char*)ws + OFF_W_GATE + ((size_t)(u).b * 1024 + (size_t)(u).pn * 256) * 2048 : (const char*)ws + OFF_W_OMLA + (size_t)(u).b * 1048576 + (size_t)(u).pn * (2 * hY))
    MUnit cur, nxt; int ui = 0; bool ok0;
    MU_NEXT(0, cur, ok0);
    if (!ok0) return;
    f32x4 acc[2][2][4][2];
#pragma unroll
    for (int a = 0; a < 2; ++a)
#pragma unroll
        for (int b = 0; b < 2; ++b)
#pragma unroll
            for (int m = 0; m < 4; ++m)
#pragma unroll
                for (int n = 0; n < 2; ++n) acc[a][b][m][n] = (f32x4){0.f, 0.f, 0.f, 0.f};
    bf16x8 At[4][2], B0[2][2], B1[2][2];
    const char* cA = MU_BASEA(cur); const char* cB = MU_BASEB(cur);
    {
        const unsigned vc = cur.g ? vY0 + vGd : vY0; const size_t hc = cur.g ? hG : hY, qc = hc >> 1;
        PG8_STAGE(PG8_SB(0, 0), cB, vc, qc); PG8_STAGE(PG8_SB(0, 1), cB + hc, vc, qc); PG8_STAGE(PG8_SA(0, 0), cA, vc, qc); PG8_STAGE(PG8_SA(0, 1), cA + hc, vc, qc);
        if (wr == 1) PG8_BAR;
        PG8_WAIT_V(2); PG8_BAR;
        PG8_STAGE(PG8_SB(1, 0), cB + kstep, vc, qc); PG8_STAGE(PG8_SA(1, 0), cA + kstep, vc, qc); PG8_STAGE(PG8_SB(1, 1), cB + hc + kstep, vc, qc);
        PG8_WAIT_V(6); PG8_BAR;
    }
    for (;;) {
        bool has_next; MU_NEXT(ui + 1, nxt, has_next);
        const char* nA = has_next ? MU_BASEA(nxt) : cA; const char* nB = has_next ? MU_BASEB(nxt) : cB;
        const int ng = has_next ? nxt.g : cur.g;
        const unsigned vc = cur.g ? vY0 + vGd : vY0, vn = ng ? vY0 + vGd : vY0;
        const size_t hc = cur.g ? hG : hY, hn = ng ? hG : hY, qc = hc >> 1;
        const int nt = cur.g ? 16 : 8;
        for (int t = 0; t < nt; t += 2) {
            const bool last = (t == nt - 2);
            const char* a1 = cA + (size_t)(t + 1) * kstep;
            const char* a2 = last ? nA : cA + (size_t)(t + 2) * kstep; const char* b2 = last ? nB : cB + (size_t)(t + 2) * kstep;
            const char* a3 = a2 + kstep; const char* b3 = b2 + kstep;
            const unsigned v2 = last ? vn : vc; const size_t h2 = last ? hn : hc, q2 = h2 >> 1;
            PG8_LDB(B0, 0, 0); PG8_LDB(B1, 0, 1); PG8_SCHED; PG8_LDA(At, 0, 0); PG8_STAGE(PG8_SA(1, 1), a1 + hc, vc, qc);
            PG8_WAIT_V(8); PG8_WAIT_L(0); PG8_BAR; PG8_MMA(0, 0, At, B0); PG8_MMA(0, 1, At, B1); PG8_BAR; PG8_SCHED;
            PG8_LDA(At, 0, 1); PG8_STAGE(PG8_SB(0, 0), b2, v2, q2); PG8_STAGE(PG8_SB(0, 1), b2 + h2, v2, q2); PG8_STAGE(PG8_SA(0, 0), a2, v2, q2);
            PG8_WAIT_V(8); PG8_WAIT_L(0); PG8_BAR; PG8_MMA(1, 0, At, B0); PG8_MMA(1, 1, At, B1); PG8_BAR; PG8_SCHED;
            PG8_LDB(B0, 1, 0); PG8_LDB(B1, 1, 1); PG8_SCHED; PG8_LDA(At, 1, 0); PG8_STAGE(PG8_SA(0, 1), a2 + h2, v2, q2);
            PG8_WAIT_V(8); PG8_WAIT_L(0); PG8_BAR; PG8_MMA(0, 0, At, B0); PG8_MMA(0, 1, At, B1); PG8_BAR; PG8_SCHED;
            PG8_LDA(At, 1, 1); PG8_STAGE(PG8_SB(1, 0), b3, v2, q2); PG8_STAGE(PG8_SB(1, 1), b3 + h2, v2, q2); PG8_STAGE(PG8_SA(1, 0), a3, v2, q2);
            PG8_WAIT_V(8); PG8_WAIT_L(0); PG8_BAR; PG8_MMA(1, 0, At, B0); PG8_MMA(1, 1, At, B1); PG8_BAR; PG8_SCHED;
        }
        if (wr == 0) PG8_BAR;
        E(acc, cur, wr, wc, fr, fq);
        if (!has_next) break;
#pragma unroll
        for (int a = 0; a < 2; ++a)
#pragma unroll
            for (int b = 0; b < 2; ++b)
#pragma unroll
                for (int m = 0; m < 4; ++m)
#pragma unroll
                    for (int n = 0; n < 2; ++n) acc[a][b][m][n] = (f32x4){0.f, 0.f, 0.f, 0.f};
        cur = nxt; cA = nA; cB = nB; ++ui;
        if (wr == 1) PG8_BAR;
    }
    PG8_WAIT_V(0);
    PG8_BAR;
#undef MU_NEXT
#undef MU_BASEA
#undef MU_BASEB
#undef PG8_SA
#undef PG8_SB
#undef PG8_STAGE
#undef PG8_LDA
#undef PG8_LDB
#undef PG8_MMA
#undef PG8_WAIT_V
#undef PG8_WAIT_L
#undef PG8_BAR
#undef PG8_SCHED
}
struct EpiMerge {
    uint4* ytile; uint4* stile; const float* rs1; bf16_t* MERGED;
    __device__ __forceinline__ void operator()(const f32x4 (&acc)[2][2][4][2], const MUnit& u, int wr, int wc, int fr, int fq) const {
        asm volatile("" : "+v"(fr), "+v"(fq));
        const int slot = (wr * 4 + wc) * 16 * 64 + fq * 16 + fr;
#pragma unroll
        for (int ai = 0; ai < 2; ++ai) {
            if (!u.g) {
#pragma unroll
                for (int m = 0; m < 4; ++m)
#pragma unroll
                    for (int bj = 0; bj < 2; ++bj) {
                        const f32x4 v0 = acc[ai][bj][m][0], v1 = acc[ai][bj][m][1]; uint4 w;
                        w.x = ::pk2(v0[0], v0[1]); w.y = ::pk2(v0[2], v0[3]); w.z = ::pk2(v1[0], v1[1]); w.w = ::pk2(v1[2], v1[3]);
                        ytile[slot + ((ai * 4 + m) * 2 + bj) * 64] = w;
                    }
            } else {
                uint4 ys[4][2], ss[4][2]; float ri[4];
#pragma unroll
                for (int m = 0; m < 4; ++m) {
                    ri[m] = rs1[u.pm * BM + ai * HALF + wr * 64 + m * 16 + fr];
#pragma unroll
                    for (int bj = 0; bj < 2; ++bj) {
                        ys[m][bj] = ytile[slot + ((ai * 4 + m) * 2 + bj) * 64];
                        if (u.b > 0) ss[m][bj] = stile[slot + ((ai * 4 + m) * 2 + bj) * 64]; else ss[m][bj] = make_uint4(0u, 0u, 0u, 0u);
                    }
                }
#pragma unroll
                for (int m = 0; m < 4; ++m) {
                    const float rinv = rsqrtf(ri[m] * (1.f / 1024.f) + EPS);
                    bf16_t* mp = MERGED + ((size_t)(u.pn * 4 + (wc >> 1)) * NTOK + (size_t)(u.pm * 2 + ai) * 128) * 64 + ((wr * 4 + m) * 4 + (wc & 1) * 2) * 256 + fr * 16 + fq * 4;
#pragma unroll
                    for (int bj = 0; bj < 2; ++bj) {
                        const uint4 yw = ys[m][bj], sw = ss[m][bj];
                        const f32x4 g0 = acc[ai][bj][m][0] * rinv, g1 = acc[ai][bj][m][1] * rinv;
                        const f32x4 y0 = {::bflo(yw.x), ::bfhi(yw.x), ::bflo(yw.y), ::bfhi(yw.y)}, y1 = {::bflo(yw.z), ::bfhi(yw.z), ::bflo(yw.w), ::bfhi(yw.w)};
                        f32x4 v0 = {::bflo(sw.x), ::bfhi(sw.x), ::bflo(sw.y), ::bfhi(sw.y)}, v1 = {::bflo(sw.z), ::bfhi(sw.z), ::bflo(sw.w), ::bfhi(sw.w)};
#pragma unroll
                        for (int j = 0; j < 4; ++j) { v0[j] += y0[j] * __builtin_amdgcn_rcpf(1.f + __expf(-g0[j])); v1[j] += y1[j] * __builtin_amdgcn_rcpf(1.f + __expf(-g1[j])); }
                        if (u.b < 2) {
                            uint4 w; w.x = ::pk2(v0[0], v0[1]); w.y = ::pk2(v0[2], v0[3]); w.z = ::pk2(v1[0], v1[1]); w.w = ::pk2(v1[2], v1[3]);
                            stile[slot + ((ai * 4 + m) * 2 + bj) * 64] = w;
                        } else { ::st_bf4(mp + (size_t)bj * 2 * NTOK * 64, v0); ::st_bf4(mp + (size_t)bj * 2 * NTOK * 64 + 256, v1); }
                    }
                }
            }
        }
    }
};
}

DEVI void copy_rows_bf16(const float* x0, const float* x1, bf16_t* dst, float* rs, int gw, int nw, int lane) {
    for (int row = gw; row < NTOK; row += nw) {
        const float* src = row < 16384 ? x0 + (size_t)row * 1024 : x1 + (size_t)(row - 16384) * 1024;
        f32x4 v[4]; float s = 0.f;
#pragma unroll
        for (int i = 0; i < 4; ++i) { v[i] = ld_f4(src + lane * 4 + 256 * i); s += dot4(v[i]); }
        s += __shfl_xor(s, 1); s += __shfl_xor(s, 2); s += __shfl_xor(s, 4); s += __shfl_xor(s, 8); s += __shfl_xor(s, 16); s += __shfl_xor(s, 32);
        if (lane == 0) rs[row] = s;
#pragma unroll
        for (int i = 0; i < 4; ++i) st_bf4(dst + (size_t)row * 1024 + lane * 4 + 256 * i, v[i]);
    }
}

#define W1GU ((bf16_t*)(ws + OFF_W1GU))
#define W1DN ((bf16_t*)(ws + OFF_W1DN))
#define W2DN ((bf16_t*)(ws + OFF_W2DN))
#define W2GU ((bf16_t*)((unsigned char*)p.out + D1_W2GU))
#define W_OUT ((bf16_t*)((unsigned char*)p.out + D1_WOUT))
#define RS2 ((float*)((unsigned char*)p.out + D1_RS2))
#define RS0 ((float*)(ws + OFF_RS0))
#define RS1 ((float*)(ws + OFF_RS1))
#define XB ((bf16_t*)p.out)
#define XB0 ((bf16_t*)((unsigned char*)p.out + D1_OFF))
#define X2B ((bf16_t*)(ws + OFF_X2B))
#define HID2 ((bf16_t*)(ws + OFF_HID2))
#define W_IN1 ((bf16_t*)(ws + OFF_W_IN1))
#define W_IN2 ((bf16_t*)(ws + OFF_W_IN2))
#define W_GATE ((bf16_t*)(ws + OFF_W_GATE))
#define W_UQ ((bf16_t*)(ws + OFF_W_UQ))
#define W_UK ((bf16_t*)(ws + OFF_W_UK))
#define W_UV ((bf16_t*)(ws + OFF_W_UV))
#define W_OMLA ((bf16_t*)(ws + OFF_W_OMLA))
#define W_OCONV ((bf16_t*)(ws + OFF_W_OCONV))
#define W_OMEM ((bf16_t*)(ws + OFF_W_OMEM))
#define W_MEMK ((bf16_t*)(ws + OFF_W_MEMK))
#define W_MEMV ((bf16_t*)(ws + OFF_W_MEMV))
#define MK ((bf16_t*)(ws + OFF_MK))
#define MVT ((bf16_t*)(ws + OFF_MVT))
#define ROPE ((float*)(ws + OFF_ROPE))
#define RSQ ((float*)(ws + OFF_RSQ))
#define RSKV ((float*)(ws + OFF_RSKV))
#define MN ((bf16_t*)(ws + OFF_MN))
#define XQ ((bf16_t*)(ws + OFF_XQ))
#define CQ ((bf16_t*)(ws + OFF_CQ))
#define CKV ((bf16_t*)(ws + OFF_CKV))
#define Qb ((bf16_t*)(ws + OFF_Q))
#define Kb ((bf16_t*)(ws + OFF_K))
#define VT ((bf16_t*)(ws + OFF_VT))
#define HID ((bf16_t*)(ws + OFF_HID))
#define AO ((bf16_t*)(ws + OFF_AO))
#define CB ((bf16_t*)(ws + OFF_CB))
#define Ub ((bf16_t*)(ws + OFF_U))
#define MERGED ((bf16_t*)(ws + OFF_MERGED))
#define LAS __attribute__((address_space(3)))
#define XB_TMO      128
#define XB_XCNT(j)  (256  + 64 * (j))
#define XB_XSUB(j)  (1280 + 64 * (j))
#define XB_XGEN(j)  (2304 + 64 * (j))
#define XB_TOP      3328
#define XB_TOPGEN   3392
#define XCD_BAR_WORDS 3456
#define XB_SPIN_CAP (1u << 18)

__device__ __forceinline__ unsigned xb_ld(unsigned* p)              { return __hip_atomic_load(p, __ATOMIC_RELAXED, __HIP_MEMORY_SCOPE_AGENT); }
__device__ __forceinline__ unsigned xb_add(unsigned* p, unsigned v) { return __hip_atomic_fetch_add(p, v, __ATOMIC_RELAXED, __HIP_MEMORY_SCOPE_AGENT); }
__device__ __forceinline__ unsigned xb_xcc_id() { return (unsigned)__builtin_amdgcn_s_getreg((3 << 11) | 20) & 0xFu; }
#define XB_SPIN(cond, bar) do { unsigned _sp = 0; while (cond) { __builtin_amdgcn_s_sleep(1); \
    if ((++_sp & 255u) == 0u) { if (xb_ld(&(bar)[XB_TMO])) break; if (_sp > XB_SPIN_CAP) { atomicAdd(&(bar)[XB_TMO], 1u); break; } } } } while (0)

struct XcdBarrier {
    unsigned* bar; unsigned x;
    volatile LAS unsigned* st;
};

__device__ __forceinline__ XcdBarrier xcd_barrier_post(unsigned* bar, volatile LAS unsigned* st) {
    XcdBarrier b; b.bar = bar; b.x = xb_xcc_id(); b.st = st;
    if (threadIdx.x == 0) (void)xb_add(&bar[XB_XCNT(b.x)], 1u);
    return b;
}
__device__ __forceinline__ void xcd_barrier_complete(unsigned* bar, unsigned x, unsigned& nloc, unsigned& nx) {
    const unsigned G = gridDim.x * gridDim.y * gridDim.z;
    unsigned sum, cnt, mine, sp = 0u;
    for (;;) {
        sum = 0u; cnt = 0u; mine = 0u;
#pragma unroll
        for (unsigned j = 0; j < 16; ++j) { const unsigned c = xb_ld(&bar[XB_XCNT(j)]); sum += c; cnt += (c > 0u) ? 1u : 0u; mine = (j == x) ? c : mine; }
        if (sum == G) break;
        __builtin_amdgcn_s_sleep(1);
        if ((++sp & 255u) == 0u) { if (xb_ld(&bar[XB_TMO])) break; if (sp > XB_SPIN_CAP) { atomicAdd(&bar[XB_TMO], 1u); break; } }
    }
    nloc = mine > 0u ? mine : 1u; nx = cnt > 0u ? cnt : 1u;
}

__device__ __forceinline__ void xcd_barrier(const XcdBarrier& b) {
    asm volatile("s_waitcnt vmcnt(0)" ::: "memory");
    __syncthreads();
    if (threadIdx.x == 0) {
        unsigned* bar = b.bar;
        __builtin_amdgcn_s_waitcnt(0);
        unsigned nloc = b.st[0], nx = b.st[1];
        if (nloc == 0u) { xcd_barrier_complete(bar, b.x, nloc, nx); b.st[0] = nloc; b.st[1] = nx; }
        const unsigned old = xb_add(&bar[XB_XSUB(b.x)], 1u);
        const unsigned gen = old / nloc;
        if (old + 1u == (gen + 1u) * nloc) {
            __builtin_amdgcn_fence(__ATOMIC_RELEASE, "agent");
            asm volatile("s_waitcnt vmcnt(0)" ::: "memory");
            const unsigned og = xb_add(&bar[XB_TOP], 1u);
            const unsigned tg = og / nx;
            if (og + 1u == (tg + 1u) * nx) xb_add(&bar[XB_TOPGEN], 1u);
            else XB_SPIN(xb_ld(&bar[XB_TOPGEN]) == tg, bar);
            __builtin_amdgcn_fence(__ATOMIC_ACQUIRE, "agent");
            xb_add(&bar[XB_XGEN(b.x)], 1u);
            asm volatile("s_waitcnt vmcnt(0)" ::: "memory");
        } else {
            XB_SPIN(xb_ld(&bar[XB_XGEN(b.x)]) == gen, bar);
            __builtin_amdgcn_fence(__ATOMIC_ACQUIRE, "agent");
            asm volatile("s_waitcnt vmcnt(0)" ::: "memory");
        }
    }
    __syncthreads();
}

#define PHASE_VARS \
    int tx_ = threadIdx.x; asm volatile("" : "+v"(tx_)); \
    const int vh = __builtin_amdgcn_readfirstlane(tx_ >> 8); \
    unsigned char* const smem = smem_all + vh * SM_TOTAL; \
    const int tid = tx_ & 255, lane = tid & 63, wid = tid >> 6, wr = wid >> 1, wc = wid & 1, fr = lane & 15, fq = lane >> 4; \
    const int G = gridDim.x * 2, bid = blockIdx.x * 2 + vh; \
    (void)smem; (void)tid; (void)lane; (void)wid; (void)wr; (void)wc; (void)fr; (void)fq; (void)G; (void)bid;
__global__ void __launch_bounds__(512, 2) mega(Params p) {
    extern __shared__ __attribute__((aligned(16))) unsigned char smem_all[];

    unsigned char* ws = p.ws;
    volatile LAS unsigned* bst = (volatile LAS unsigned*)((LAS unsigned char*)smem_all + 2 * SM_TOTAL);
    if (threadIdx.x == 0) { bst[0] = 0u; bst[1] = 0u; }
    __syncthreads();
    const XcdBarrier xbar = xcd_barrier_post((unsigned*)(ws + OFF_BAR), bst);

    { PHASE_VARS
    { int cbase = 0; for (int id = 0; id < 13; ++id) { const WSpec s = get_spec(p, id); convert_spec(s, smem, bid, G, tid, cbase); } }
    for (int i = bid * 256 + tid; i < 3 * NTOK; i += G * 256) RSQ[i] = 0.f;
    for (int i = bid * 256 + tid; i < 8192 * 16; i += G * 256) {
        const int s = i >> 4, f = i & 15, a = f >> 2, b = f & 3;
        const double fa = a == 0 ? 1.0 : (a == 1 ? 0.1 : (a == 2 ? 0.01 : 0.001));
        const double fb = b == 0 ? 1.0 : (b == 1 ? 0.5623413251903491 : (b == 2 ? 0.31622776601683794 : 0.1778279410038923));
        double rev = (double)s * fa * fb * 0.15915494309189535; rev -= floor(rev);
        const float rv = (float)rev;
        ROPE[2 * i] = __builtin_amdgcn_cosf(rv); ROPE[2 * i + 1] = __builtin_amdgcn_sinf(rv);
    }
    for (int row = bid * 4 + wid; row < 1536; row += G * 4) {
        const float* src = row < 512 ? p.memp + (size_t)row * 1024 : p.mems + (size_t)(row - 512) * 1024;
        f32x4 v[4]; float s = 0.f;
#pragma unroll
        for (int i = 0; i < 4; ++i) { v[i] = ld_f4(src + lane * 4 + 256 * i); s += dot4(v[i]); }
        s += __shfl_xor(s, 1); s += __shfl_xor(s, 2); s += __shfl_xor(s, 4); s += __shfl_xor(s, 8); s += __shfl_xor(s, 16); s += __shfl_xor(s, 32);
        const float inv = rsqrtf(s * (1.f / 1024.f) + EPS);
#pragma unroll
        for (int i = 0; i < 4; ++i) st_bf4(MN + (size_t)row * 1024 + lane * 4 + 256 * i, v[i] * inv);
    }
    copy_rows_bf16(p.xp, p.xs, XB0, RS0, bid * 4 + wid, G * 4, lane);
    }
    xcd_barrier(xbar);
    { PHASE_VARS
    { pg8::Gemm g{XB0, W1GU, NTOK, 5632, 1024, 1024, 1024, 128, 128}; pg8::StaticOrder so; so.init(NTOK, 5632, gridDim.x, blockIdx.x);
      pg8::gemm_phase<pg8::EpiGU, pg8::StaticOrder, true, true>((PG8_LAS unsigned char*)smem_all, g, so, pg8::EpiGU{HID, RS0}); }
    }
    xcd_barrier(xbar);
    { PHASE_VARS
    { pg8::Gemm g{HID, W1DN, NTOK, 1024, 2816, 0, 2816, (size_t)NTOK * 128, 128}; pg8::StaticOrder so; so.init(NTOK, 1024, gridDim.x, blockIdx.x);
      pg8::gemm_phase<pg8::EpiRes<1>, pg8::StaticOrder, true, true>((PG8_LAS unsigned char*)smem_all, g, so, pg8::EpiRes<1>{nullptr, nullptr, XB0, XB, RS1, 0.5f}); }
    }
    xcd_barrier(xbar);
    { PHASE_VARS
    { int cbase = 0; for (int id = 13; id < 16; ++id) { const WSpec s = get_spec(p, id); convert_spec(s, smem, bid, G, tid, cbase); } }
    for (int i = bid * 256 + tid; i < NTOK; i += G * 256) RS2[i] = 0.f;
    __syncthreads();
    { pg8::Gemm g{XB, W_IN1, NTOK, 1280, 1024, 1024, 1024, 128, 128}; pg8::StaticOrder so; so.init(NTOK, 1280, gridDim.x, blockIdx.x);
      pg8::gemm_phase<pg8::EpiIn1, pg8::StaticOrder, true, true>((PG8_LAS unsigned char*)smem_all, g, so, pg8::EpiIn1{RS1, CQ, CKV, XQ, RSQ, RSKV}); }
    __syncthreads();
    for (int u = bid - 256; u >= 0 && u < 96; u += 1 << 30) {
        f32x4 acc[4][4]; zero_acc(acc);
        if (u < 48) {
            const int tm = u >> 2, hh = u & 3;
            gemm_tile<false>(acc, MN + (size_t)tm * 128 * 1024, 1024, W_MEMK + (size_t)hh * 128 * 1024, 1024, 16, smem);
            float tot[4]; tile_row_ss(acc, tot, smem, wr, wc, fr, fq);
#pragma unroll
            for (int m = 0; m < 4; ++m) {
                const int row = tm * 128 + wr * 64 + m * 16 + fr; const float inv = rsqrtf(tot[m] * (1.f / 128.f) + EPS);
#pragma unroll
                for (int n = 0; n < 4; ++n) { const int c = wc * 64 + n * 16 + fq * 4; st_bf4(MK + (size_t)row * 512 + hh * 128 + c, acc[m][n] * inv * ld_f4(p.xa_k_norm + c)); }
            }
        } else {
            const int v = u - 48, tm = v / 12, tn = v % 12;
            gemm_tile<false>(acc, W_MEMV + (size_t)tm * 128 * 1024, 1024, MN + (size_t)tn * 128 * 1024, 1024, 16, smem);
#pragma unroll
            for (int m = 0; m < 4; ++m) {
                const int d = wr * 64 + m * 16 + fr;
#pragma unroll
                for (int n = 0; n < 4; ++n) { const int col = tn * 128 + wc * 64 + n * 16 + fq * 4, b = col >> 8, mm = col & 255; st_bf4(MVT + ((size_t)(b * 4 + tm) * 128 + d) * 256 + mm, acc[m][n]); }
            }
        }
    }
    }
    xcd_barrier(xbar);
    { PHASE_VARS
    { pg8::Gemm g{CQ, W_UQ, NTOK, 768, 384, 384, 384, 128, 128}; pg8::StaticOrder so; so.init(NTOK, 768, gridDim.x, blockIdx.x);
      pg8::gemm_phase<pg8::EpiQ, pg8::StaticOrder, true, true>((PG8_LAS unsigned char*)smem_all, g, so, pg8::EpiQ{RSQ, Qb}); }
    { pg8::Gemm g{CKV, W_UK, NTOK, 512, 256, 288, 288, 128, 128}; pg8::StaticOrder so; so.init(NTOK, 512, gridDim.x, blockIdx.x);
      pg8::gemm_phase<pg8::EpiK, pg8::StaticOrder, true, true>((PG8_LAS unsigned char*)smem_all, g, so, pg8::EpiK{RSKV, CKV, p.mla_k_norm, ROPE, Kb}); }
    { pg8::Gemm g{W_UV, CKV, 512, NTOK, 256, 288, 288, 128, 128}; pg8::StaticOrder so; so.init(512, NTOK, gridDim.x, blockIdx.x);
      pg8::gemm_phase<pg8::EpiVt, pg8::StaticOrder, true, true>((PG8_LAS unsigned char*)smem_all, g, so, pg8::EpiVt{RSKV, VT}); }
    }
    xcd_barrier(xbar);
    { PHASE_VARS
    for (int j = blockIdx.x; j < 1024; j += gridDim.x) {
        int tok0i, pair, qt, nk, vtoff;
        if (j < 512) { const int r = j >> 8, i = j & 255; pair = (i & 7) + 8 * r; qt = i >> 3; tok0i = (pair >> 3) * 8192; nk = 8192; vtoff = 0; }
        else { const int jj = j - 512, r = jj >> 8, i = jj & 255, slot = i >> 3; pair = (i & 7) + 8 * (2 * r + (slot >> 4)); qt = slot & 15; tok0i = 16384 + (pair >> 3) * 4096; nk = 4096; vtoff = 8388608; }
        const int h = pair & 7;
        const size_t tok0 = (size_t)tok0i;
        attn_mla_item(p.mla_q_norm, ROPE, qt * 256, Qb + ((tok0 + qt * 256) * 8 + h) * 96, Kb + (tok0 * 8 + h) * 96, VT + (size_t)vtoff + (size_t)pair * 64 * nk, nk, nk, AO + (tok0 + qt * 256) * 512 + h * 64, smem_all, tx_);
    }
    __syncthreads();
    for (int jj = bid; jj < 1024; jj += G) {
        const int tile = jj >> 2, hh = jj & 3, tok0 = tile * 128;
        const int mb = tok0 < 16384 ? (tok0 >> 13) : 2 + ((tok0 - 16384) >> 12);
        bf16_t* qp = XQ + (size_t)tok0 * 512 + hh * 128;
        attn_item<128, 128, false, true>(p.xa_q_norm, QSCALE_XA, qp, 512, MK + (size_t)mb * 256 * 512 + hh * 128, 512, MVT + (size_t)(mb * 4 + hh) * 128 * 256, 256, 256, qp, 512, smem);
    }
    }
    xcd_barrier(xbar);
    { PHASE_VARS
    { pg8::Gemm g{XB, W_IN2, NTOK, 1536, 1024, 1024, 1024, 128, 128}; pg8::StaticOrder so; so.init(NTOK, 1536, gridDim.x, blockIdx.x);
      pg8::gemm_phase<pg8::EpiIn2, pg8::StaticOrder, true, true>((PG8_LAS unsigned char*)smem_all, g, so, pg8::EpiIn2{RS1, CB, Ub}); }
    }
    xcd_barrier(xbar);
    { PHASE_VARS
    for (int i = bid * 256 + tid; i < NTOK * 64; i += G * 256) {
        const int tok = i >> 6, c0 = (i & 63) * 8, pos = tok_pos(tok), slen = tok < 16384 ? 8192 : 4096;
        const bf16_t* up = Ub + (size_t)tok * 512 + c0;
        const uint4 z = {0u, 0u, 0u, 0u};
        const uint4 u0 = pos > 0 ? *(const uint4*)(up - 512) : z, u1 = *(const uint4*)up, u2 = pos < slen - 1 ? *(const uint4*)(up + 512) : z;
        const uint4 cb = *(const uint4*)(CB + (size_t)tok * 512 + c0);
        const unsigned a0[4] = {u0.x, u0.y, u0.z, u0.w}, a1[4] = {u1.x, u1.y, u1.z, u1.w}, a2[4] = {u2.x, u2.y, u2.z, u2.w}, ab[4] = {cb.x, cb.y, cb.z, cb.w};
        unsigned o[4];
#pragma unroll
        for (int q = 0; q < 4; ++q) {
            const int c = c0 + 2 * q;
            const float w0l = p.conv_w[c], w0h = p.conv_w[c + 1], w1l = p.conv_w[512 + c], w1h = p.conv_w[512 + c + 1], w2l = p.conv_w[1024 + c], w2h = p.conv_w[1024 + c + 1];
            const float yl = bflo(a0[q]) * w0l + bflo(a1[q]) * w1l + bflo(a2[q]) * w2l, yh = bfhi(a0[q]) * w0h + bfhi(a1[q]) * w1h + bfhi(a2[q]) * w2h;
            o[q] = pk2(bflo(ab[q]) * yl, bfhi(ab[q]) * yh);
        }
        uint4 ov; ov.x = o[0]; ov.y = o[1]; ov.z = o[2]; ov.w = o[3];
        *(uint4*)(CB + (size_t)tok * 512 + c0) = ov;
    }
    }
    xcd_barrier(xbar);
    { PHASE_VARS
    { pg8::StaticOrder so; so.init(NTOK, 1024, gridDim.x, blockIdx.x);
      pg8::gemm_phase_merge<pg8::EpiMerge>((PG8_LAS unsigned char*)smem_all, ws, XB, so, pg8::EpiMerge{(uint4*)Ub + (size_t)blockIdx.x * 8192, (uint4*)((unsigned char*)p.out + D1_STILE) + (size_t)blockIdx.x * 8192, RS1, MERGED}); }
    }
    xcd_barrier(xbar);
    { PHASE_VARS
    { pg8::Gemm g{MERGED, W_OUT, NTOK, 1024, 1024, 0, 1024, (size_t)NTOK * 128, 128}; pg8::StaticOrder so; so.init(NTOK, 1024, gridDim.x, blockIdx.x);
      pg8::gemm_phase<pg8::EpiRes<1>, pg8::StaticOrder, true, true>((PG8_LAS unsigned char*)smem_all, g, so, pg8::EpiRes<1>{nullptr, nullptr, XB, X2B, RS2, 1.0f}); }
    }
    xcd_barrier(xbar);
    { PHASE_VARS
    { pg8::Gemm g{X2B, W2GU, NTOK, 5632, 1024, 1024, 1024, 128, 128}; pg8::StaticOrder so; so.init(NTOK, 5632, gridDim.x, blockIdx.x);
      pg8::gemm_phase<pg8::EpiGU, pg8::StaticOrder, true, true>((PG8_LAS unsigned char*)smem_all, g, so, pg8::EpiGU{HID2, RS2}); }
    }
    xcd_barrier(xbar);
    { PHASE_VARS
    { pg8::Gemm g{HID2, W2DN, NTOK, 1024, 2816, 0, 2816, (size_t)NTOK * 128, 128}; pg8::StaticOrder so; so.init(NTOK, 1024, gridDim.x, blockIdx.x);
      pg8::gemm_phase<pg8::EpiFinal, pg8::StaticOrder, true, true>((PG8_LAS unsigned char*)smem_all, g, so, pg8::EpiFinal{X2B, p.out}); }
    }
}

extern "C" void kernel_launch(void* const* d_in, const int* in_sizes, int n_in, void* d_out, int out_size, void* d_ws, size_t ws_size, hipStream_t stream) {
    (void)in_sizes; (void)n_in; (void)out_size;
    static int grid_blocks = 0;
    if (!grid_blocks) {
        int dev = 0, cus = 0, per_cu = 0;
        (void)hipGetDevice(&dev);
        (void)hipDeviceGetAttribute(&cus, hipDeviceAttributeMultiprocessorCount, dev);
        (void)hipFuncSetAttribute((const void*)mega, hipFuncAttributeMaxDynamicSharedMemorySize, 2 * SM_TOTAL + 16);
        (void)hipOccupancyMaxActiveBlocksPerMultiprocessor(&per_cu, (const void*)mega, 512, 2 * SM_TOTAL + 16);
        if (per_cu > 1) per_cu = 1;
        if (per_cu < 1) per_cu = 1;
        grid_blocks = cus * per_cu;
        if (grid_blocks > 256) grid_blocks = 256;
    }
    if (ws_size < WS_SIZE) { fprintf(stderr, "workspace too small: %zu < %zu\n", ws_size, (size_t)WS_SIZE); return; }
    Params p{};
    const float* const* in = (const float* const*)d_in;
    p.xp = in[0]; p.xs = in[1]; p.memp = in[2]; p.mems = in[3];
    p.ffn1_norm = in[4]; p.ffn1_gu = in[5]; p.ffn1_down = in[6]; p.mix_norm = in[7]; p.w_in = in[8]; p.q_lora_norm = in[9]; p.w_uq = in[10];
    p.kv_lora_norm = in[11]; p.w_uk = in[12]; p.w_uv = in[13]; p.mla_q_norm = in[14]; p.mla_k_norm = in[15]; p.w_o_mla = in[16]; p.conv_w = in[17];
    p.w_o_conv = in[18]; p.mem_norm = in[19]; p.w_mem_kv = in[20]; p.xa_q_norm = in[21]; p.xa_k_norm = in[22]; p.w_o_mem = in[23]; p.w_out = in[24];
    p.ffn2_norm = in[25]; p.ffn2_gu = in[26]; p.ffn2_down = in[27];
    p.out = (float*)d_out; p.ws = (unsigned char*)d_ws;
    if (hipMemsetAsync((unsigned char*)d_ws + OFF_BAR, 0, 16384, stream) != hipSuccess) { fprintf(stderr, "memset of the barrier words failed\n"); return; }
    void* args[] = {&p};
    hipError_t e = hipLaunchCooperativeKernel((const void*)mega, dim3(grid_blocks), dim3(512), args, 2 * SM_TOTAL + 16, stream);
    if (e != hipSuccess) fprintf(stderr, "cooperative launch failed: %s (grid %d)\n", hipGetErrorString(e), grid_blocks);
}
```

```cpp
#include <hip/hip_runtime.h>
#include <hip/hip_cooperative_groups.h>
#include <cstdio>
#include <cstdint>
namespace cg = cooperative_groups;

#define DEVI __device__ __forceinline__
typedef unsigned short bf16_t;
typedef short bf16x8 __attribute__((ext_vector_type(8)));
typedef float f32x4 __attribute__((ext_vector_type(4)));
typedef float f32x16 __attribute__((ext_vector_type(16)));
typedef __bf16 bf16x2n __attribute__((ext_vector_type(2)));
typedef float f32x2n __attribute__((ext_vector_type(2)));

constexpr float EPS = 1e-6f;
constexpr int NTOK = 32768;
constexpr float QSCALE_MLA = 0.10206207261596575f * 1.4426950408889634f;
constexpr float QSCALE_XA = 0.08838834764831845f * 1.4426950408889634f;


constexpr size_t SZ_W_FFNGU = (size_t)5632 * 1024 * 2, SZ_W_FFNDN = (size_t)1024 * 2816 * 2;
constexpr size_t D1_OFF = (size_t)NTOK * 1024 * 2;
constexpr size_t D1_W2GU = D1_OFF, D1_WOUT = D1_W2GU + SZ_W_FFNGU, D1_RS2 = D1_WOUT + (size_t)1024 * 1024 * 2;
constexpr size_t OFF_W1GU = 0;
constexpr size_t OFF_W1DN = OFF_W1GU + SZ_W_FFNGU;
constexpr size_t OFF_W2DN = 0;
constexpr size_t OFF_W_IN1 = OFF_W1DN + SZ_W_FFNDN;
constexpr size_t OFF_W_IN2 = OFF_W_IN1 + (size_t)1280 * 1024 * 2;
constexpr size_t OFF_W_GATE = OFF_W_IN2 + (size_t)1536 * 1024 * 2;
constexpr size_t OFF_W_UQ = OFF_W_GATE + (size_t)3072 * 1024 * 2;
constexpr size_t OFF_W_UK = OFF_W_UQ + (size_t)1024 * 384 * 2;
constexpr size_t OFF_W_UV = OFF_W_UK + (size_t)512 * 288 * 2;
constexpr size_t OFF_W_OMLA = OFF_W_UV + (size_t)512 * 288 * 2;
constexpr size_t OFF_W_OCONV = OFF_W_OMLA + (size_t)1024 * 512 * 2;
constexpr size_t OFF_W_OMEM = OFF_W_OCONV + (size_t)1024 * 512 * 2;
constexpr size_t OFF_W_MEMK = OFF_W_OMEM + (size_t)1024 * 512 * 2;
constexpr size_t OFF_W_MEMV = OFF_W_MEMK + (size_t)512 * 1024 * 2;
constexpr size_t OFF_MK = OFF_W_MEMV + (size_t)512 * 1024 * 2;
constexpr size_t OFF_MVT = OFF_MK + (size_t)1536 * 512 * 2;
constexpr size_t OFF_ROPE = OFF_MVT + (size_t)1536 * 512 * 2;
constexpr size_t OFF_RSQ = OFF_ROPE + (size_t)8192 * 16 * 2 * 4;
constexpr size_t OFF_RSKV = OFF_RSQ + (size_t)NTOK * 4;
constexpr size_t OFF_RS1 = OFF_RSKV + (size_t)NTOK * 4;
constexpr size_t OFF_RS0 = OFF_RS1 + (size_t)NTOK * 4;
constexpr size_t OFF_MN = OFF_RS0 + (size_t)NTOK * 4;
constexpr size_t OFF_ACT = OFF_MN + (size_t)1536 * 1024 * 2;
constexpr size_t OFF_XQ = OFF_ACT;
constexpr size_t OFF_CQ = OFF_XQ + (size_t)NTOK * 512 * 2;
constexpr size_t OFF_CKV = OFF_CQ + (size_t)NTOK * 384 * 2;
constexpr size_t OFF_Q = OFF_CKV + (size_t)NTOK * 288 * 2;
constexpr size_t OFF_K = OFF_Q + (size_t)NTOK * 768 * 2;
constexpr size_t OFF_VT = OFF_K + (size_t)NTOK * 768 * 2;
constexpr size_t WS_NEEDED = OFF_VT + (size_t)NTOK * 512 * 2;
constexpr size_t WS_SIZE = (size_t)256 * 1024 * 1024;
constexpr size_t OFF_HID = OFF_ACT;
constexpr size_t OFF_AO = OFF_CQ;
constexpr size_t OFF_CB = OFF_Q;
constexpr size_t OFF_U = OFF_CB + (size_t)NTOK * 512 * 2;
constexpr size_t OFF_MERGED = OFF_U + (size_t)NTOK * 512 * 2;
constexpr size_t OFF_X2B = OFF_W2DN + SZ_W_FFNDN;
constexpr size_t OFF_BAR = WS_SIZE - 16384;
constexpr size_t OFF_HID2 = OFF_BAR - (size_t)NTOK * 2816 * 2;
static_assert(OFF_HID + (size_t)NTOK * 2816 * 2 <= WS_SIZE, "hid");
static_assert(OFF_AO + (size_t)NTOK * 512 * 2 <= OFF_Q, "ao");
static_assert(OFF_MERGED + (size_t)NTOK * 1024 * 2 <= WS_NEEDED, "merged");
static_assert(WS_NEEDED <= OFF_BAR && OFF_HID + (size_t)NTOK * 2816 * 2 <= OFF_BAR, "ws");
static_assert(OFF_X2B + (size_t)NTOK * 1024 * 2 <= OFF_HID2, "x2b");
static_assert(OFF_X2B + (size_t)NTOK * 1024 * 2 <= OFF_MERGED, "x2b/merged");
constexpr size_t D1_STILE = D1_RS2 + (size_t)NTOK * 4;
static_assert(D1_STILE + (size_t)256 * 131072 <= 2 * D1_OFF, "d1");

constexpr int TILE_BYTES = 128 * 144;
constexpr int SM_A = 0, SM_B = 2 * TILE_BYTES, SM_RSS = 4 * TILE_BYTES, SM_XCH = SM_RSS + 512, SM_TOTAL = SM_XCH + 1024;

struct Params {
    const float *xp, *xs, *memp, *mems;
    const float *ffn1_norm, *ffn1_gu, *ffn1_down, *mix_norm, *w_in, *q_lora_norm, *w_uq, *kv_lora_norm, *w_uk, *w_uv;
    const float *mla_q_norm, *mla_k_norm, *w_o_mla, *conv_w, *w_o_conv, *mem_norm, *w_mem_kv, *xa_q_norm, *xa_k_norm;
    const float *w_o_mem, *w_out, *ffn2_norm, *ffn2_gu, *ffn2_down;
    float* out;
    unsigned char* ws;
};

DEVI unsigned pk2(float lo, float hi) { f32x2n v = {lo, hi}; bf16x2n b = __builtin_convertvector(v, bf16x2n); return __builtin_bit_cast(unsigned, b); }
DEVI float bflo(unsigned w) { return __uint_as_float(w << 16); }
DEVI float bfhi(unsigned w) { return __uint_as_float(w & 0xffff0000u); }
DEVI void st_bf4(bf16_t* p, f32x4 v) { uint2 w; w.x = pk2(v[0], v[1]); w.y = pk2(v[2], v[3]); *(uint2*)p = w; }
DEVI f32x4 ld_bf4(const bf16_t* p) { uint2 w = *(const uint2*)p; f32x4 r = {bflo(w.x), bfhi(w.x), bflo(w.y), bfhi(w.y)}; return r; }
DEVI f32x4 ld_f4(const float* p) { float4 t = *(const float4*)p; f32x4 r = {t.x, t.y, t.z, t.w}; return r; }
DEVI float dot4(f32x4 v) { return v[0] * v[0] + v[1] * v[1] + v[2] * v[2] + v[3] * v[3]; }
DEVI float sigm(float x) { return __builtin_amdgcn_rcpf(1.f + __expf(-x)); }
DEVI int tok_pos(int tok) { return tok < 16384 ? (tok & 8191) : (tok & 4095); }
DEVI float red4q(float s) { s += __shfl_xor(s, 16); s += __shfl_xor(s, 32); return s; }

template <bool AF32>
DEVI void gemm_tile(f32x4 (&acc)[4][4], const void* Aptr, int lda, const bf16_t* Bptr, int ldb, int nk, unsigned char* smem) {
    int tid_ = threadIdx.x & 255; asm volatile("" : "+v"(tid_)); const int tid = tid_, lane = tid & 63, wid = tid >> 6, wr = wid >> 1, wc = wid & 1, fr = lane & 15, fq = lane >> 4;
    float4 af[8]; uint4 ab[4]; uint4 bb[4]; float ss[8];
#pragma unroll
    for (int i = 0; i < 8; ++i) ss[i] = 0.f;
    const float* Af = (const float*)Aptr + (size_t)(tid >> 4) * lda + (tid & 15) * 4;
    const bf16_t* Ab = (const bf16_t*)Aptr + (size_t)(tid >> 3) * lda + (tid & 7) * 8;
    const bf16_t* Bb = Bptr + (size_t)(tid >> 3) * ldb + (tid & 7) * 8;
    const int awf = (tid >> 4) * 144 + (tid & 15) * 8;
    const int awb = (tid >> 3) * 144 + (tid & 7) * 16;
    const int aro = (wr * 64 + fr) * 144 + fq * 16;
    const int bro = (wc * 64 + fr) * 144 + fq * 16;
#define GT_LOAD(kt) do { \
        if (AF32) { _Pragma("unroll") for (int i = 0; i < 8; ++i) af[i] = *(const float4*)(Af + (size_t)(16 * i) * lda + (kt) * 64); } \
        else      { _Pragma("unroll") for (int i = 0; i < 4; ++i) ab[i] = *(const uint4*)(Ab + (size_t)(32 * i) * lda + (kt) * 64); } \
        _Pragma("unroll") for (int i = 0; i < 4; ++i) bb[i] = *(const uint4*)(Bb + (size_t)(32 * i) * ldb + (kt) * 64); } while (0)
#define GT_STORE(buf) do { \
        unsigned char* As_ = smem + SM_A + (buf) * TILE_BYTES; unsigned char* Bs_ = smem + SM_B + (buf) * TILE_BYTES; \
        if (AF32) { _Pragma("unroll") for (int i = 0; i < 8; ++i) { float4 v = af[i]; ss[i] += v.x * v.x + v.y * v.y + v.z * v.z + v.w * v.w; \
                        uint2 w; w.x = pk2(v.x, v.y); w.y = pk2(v.z, v.w); *(uint2*)(As_ + awf + i * 16 * 144) = w; } } \
        else      { _Pragma("unroll") for (int i = 0; i < 4; ++i) *(uint4*)(As_ + awb + i * 32 * 144) = ab[i]; } \
        _Pragma("unroll") for (int i = 0; i < 4; ++i) *(uint4*)(Bs_ + awb + i * 32 * 144) = bb[i]; } while (0)
    GT_LOAD(0);
    GT_STORE(0);
    __syncthreads();
    for (int kt = 0; kt < nk; ++kt) {
        const bool more = kt + 1 < nk;
        if (more) GT_LOAD(kt + 1);
        const unsigned char* As = smem + SM_A + (kt & 1) * TILE_BYTES;
        const unsigned char* Bs = smem + SM_B + (kt & 1) * TILE_BYTES;
#pragma unroll
        for (int ks = 0; ks < 2; ++ks) {
            bf16x8 a[4], b[4];
#pragma unroll
            for (int m = 0; m < 4; ++m) a[m] = *(const bf16x8*)(As + aro + m * 16 * 144 + ks * 64);
#pragma unroll
            for (int n = 0; n < 4; ++n) b[n] = *(const bf16x8*)(Bs + bro + n * 16 * 144 + ks * 64);
#pragma unroll
            for (int m = 0; m < 4; ++m)
#pragma unroll
                for (int n = 0; n < 4; ++n) acc[m][n] = __builtin_amdgcn_mfma_f32_16x16x32_bf16(b[n], a[m], acc[m][n], 0, 0, 0);
        }
        if (more) GT_STORE((kt + 1) & 1);
        __syncthreads();
    }
    if (AF32) {
        float* rowss = (float*)(smem + SM_RSS);
#pragma unroll
        for (int i = 0; i < 8; ++i) {
            float s = ss[i];
            s += __shfl_xor(s, 1); s += __shfl_xor(s, 2); s += __shfl_xor(s, 4); s += __shfl_xor(s, 8);
            if ((tid & 15) == 0) rowss[(tid >> 4) + 16 * i] = s;
        }
        __syncthreads();
    }
#undef GT_LOAD
#undef GT_STORE
}
DEVI void zero_acc(f32x4 (&acc)[4][4]) {
#pragma unroll
    for (int m = 0; m < 4; ++m)
#pragma unroll
        for (int n = 0; n < 4; ++n) acc[m][n] = (f32x4){0.f, 0.f, 0.f, 0.f};
}
DEVI void tile_row_ss(const f32x4 (&acc)[4][4], float (&tot)[4], unsigned char* smem, int wr, int wc, int fr, int fq) {
    float* xch = (float*)(smem + SM_XCH);
#pragma unroll
    for (int m = 0; m < 4; ++m) {
        float s = 0.f;
#pragma unroll
        for (int n = 0; n < 4; ++n) s += dot4(acc[m][n]);
        s = red4q(s);
        if (fq == 0) xch[wc * 128 + wr * 64 + m * 16 + fr] = s;
    }
    __syncthreads();
#pragma unroll
    for (int m = 0; m < 4; ++m) { const int r = wr * 64 + m * 16 + fr; tot[m] = xch[r] + xch[128 + r]; }
}


enum { KD_ID = 0, KD_GU, KD_IN1, KD_IN2, KD_UK };
struct WSpec { const float* src; const float* gain; bf16_t* dst; int src_ld, K, Np, kind, coff, dld; };
DEVI int map_col(int kind, int coff, int np) {
    const int c2 = np & 255, pr = (c2 >> 7) * 64 + ((c2 >> 5) & 3) * 16 + (c2 & 15), n = (c2 >> 4) & 1;
    switch (kind) {
        case KD_GU: return n * 2816 + (np >> 8) * 128 + pr;
        case KD_IN1: return np < 672 ? np : (np < 768 ? -1 : 2208 + (np - 768));
        case KD_IN2: return np < 512 ? 672 + np : 1184 + n * 512 + ((np >> 8) - 2) * 128 + pr;
        case KD_UK: return ((np >> 8) * 4 + ((c2 >> 5) & 3)) * 64 + (c2 >> 7) * 32 + n * 16 + (c2 & 15);
        default: return coff + np;
    }
}
DEVI WSpec get_spec(const Params& p, int id) {
    unsigned char* ws = p.ws; unsigned char* d1 = (unsigned char*)p.out; WSpec s;
    switch (id) {
        case 0: s = {p.ffn1_gu, p.ffn1_norm, (bf16_t*)(ws + OFF_W1GU), 5632, 1024, 5632, KD_GU, 0, 1024}; break;
        case 1: s = {p.ffn1_down, nullptr, (bf16_t*)(ws + OFF_W1DN), 1024, 2816, 1024, KD_ID, 0, 2816}; break;
        case 2: s = {p.w_in, p.mix_norm, (bf16_t*)(ws + OFF_W_IN1), 5792, 1024, 1280, KD_IN1, 0, 1024}; break;
        case 3: s = {p.w_in, p.mix_norm, (bf16_t*)(ws + OFF_W_IN2), 5792, 1024, 1536, KD_IN2, 0, 1024}; break;
        case 4: s = {p.w_in, p.mix_norm, (bf16_t*)(ws + OFF_W_GATE), 5792, 1024, 3072, KD_ID, 2720, 1024}; break;
        case 5: s = {p.w_uq, p.q_lora_norm, (bf16_t*)(ws + OFF_W_UQ), 768, 384, 768, KD_ID, 0, 384}; break;
        case 6: s = {p.w_uk, p.kv_lora_norm, (bf16_t*)(ws + OFF_W_UK), 512, 256, 512, KD_UK, 0, 288}; break;
        case 7: s = {p.w_uv, p.kv_lora_norm, (bf16_t*)(ws + OFF_W_UV), 512, 256, 512, KD_ID, 0, 288}; break;
        case 8: s = {p.w_o_mla, nullptr, (bf16_t*)(ws + OFF_W_OMLA), 1024, 512, 1024, KD_ID, 0, 512}; break;
        case 9: s = {p.w_o_conv, nullptr, (bf16_t*)(ws + OFF_W_OCONV), 1024, 512, 1024, KD_ID, 0, 512}; break;
        case 10: s = {p.w_o_mem, nullptr, (bf16_t*)(ws + OFF_W_OMEM), 1024, 512, 1024, KD_ID, 0, 512}; break;
        case 11: s = {p.w_mem_kv, p.mem_norm, (bf16_t*)(ws + OFF_W_MEMK), 1024, 1024, 512, KD_ID, 0, 1024}; break;
        case 12: s = {p.w_mem_kv, p.mem_norm, (bf16_t*)(ws + OFF_W_MEMV), 1024, 1024, 512, KD_ID, 512, 1024}; break;
        case 13: s = {p.w_out, nullptr, (bf16_t*)(d1 + D1_WOUT), 1024, 1024, 1024, KD_ID, 0, 1024}; break;
        case 14: s = {p.ffn2_gu, p.ffn2_norm, (bf16_t*)(d1 + D1_W2GU), 5632, 1024, 5632, KD_GU, 0, 1024}; break;
        default: s = {p.ffn2_down, nullptr, (bf16_t*)(ws + OFF_W2DN), 1024, 2816, 1024, KD_ID, 0, 2816}; break;
    }
    return s;
}
DEVI void convert_spec(const WSpec& s, unsigned char* smem, int bid, int G, int tid, int& base) {
    float* T = (float*)smem;
    const int nkt = s.K >> 6, ntiles = (s.Np >> 6) * nkt;
    int first = (bid - base) % G; if (first < 0) first += G;
    base += ntiles;
    for (int t = first; t < ntiles; t += G) {
        const int n0 = (t / nkt) << 6, k0 = (t % nkt) << 6;
        const int c4 = (tid & 15) * 4, col = map_col(s.kind, s.coff, n0 + c4);
#pragma unroll
        for (int i = 0; i < 4; ++i) {
            const int r = (tid >> 4) + 16 * i;
            float4 v = make_float4(0.f, 0.f, 0.f, 0.f);
            if (col >= 0) { v = *(const float4*)(s.src + (size_t)(k0 + r) * s.src_ld + col); if (s.gain) { const float g = s.gain[k0 + r]; v.x *= g; v.y *= g; v.z *= g; v.w *= g; } }
            T[r * 65 + c4] = v.x; T[r * 65 + c4 + 1] = v.y; T[r * 65 + c4 + 2] = v.z; T[r * 65 + c4 + 3] = v.w;
        }
        __syncthreads();
#pragma unroll
        for (int i = 0; i < 2; ++i) {
            const int idx = tid + 256 * i, cn = idx >> 3, kc = idx & 7;
            uint4 w;
            w.x = pk2(T[(kc * 8 + 0) * 65 + cn], T[(kc * 8 + 1) * 65 + cn]);
            w.y = pk2(T[(kc * 8 + 2) * 65 + cn], T[(kc * 8 + 3) * 65 + cn]);
            w.z = pk2(T[(kc * 8 + 4) * 65 + cn], T[(kc * 8 + 5) * 65 + cn]);
            w.w = pk2(T[(kc * 8 + 6) * 65 + cn], T[(kc * 8 + 7) * 65 + cn]);
            *(uint4*)(s.dst + (size_t)(n0 + cn) * s.dld + k0 + kc * 8) = w;
        }
        __syncthreads();
    }
}

template <int DQK, int DV, bool PIPE, bool QNORM>
DEVI void attn_item(const float* qgain, float qscale, const bf16_t* Qp, int q_rs, const bf16_t* Kp, int k_rs, const bf16_t* Vtp, int vt_rs, int nkeys, bf16_t* Op, int o_rs, unsigned char* smem) {
    constexpr int KROW = (DQK + 8) * 2, VROW = 136, KT_BYTES = 64 * KROW, VT_BYTES = DV * VROW, STAGE = KT_BYTES + VT_BYTES;
    constexpr int KCH = DQK / 8, NKC = 64 * KCH / 256, NVC = DV * 8 / 256, NKK = DQK / 16, NDB = DV / 32;
    static_assert(2 * STAGE <= SM_TOTAL, "attn lds");
    int tid_ = threadIdx.x & 255; asm volatile("" : "+v"(tid_)); const int tid = tid_, lane = tid & 63, wid = tid >> 6, ql = lane & 31, half = lane >> 5;
    __syncthreads();
    bf16x8 qf[NKK];
    {
        const bf16_t* qrow = Qp + (size_t)(wid * 32 + ql) * q_rs + half * 8;
#pragma unroll
        for (int kk = 0; kk < NKK; ++kk) qf[kk] = *(const bf16x8*)(qrow + kk * 16);
    }
    if (QNORM) {
        float ss = 0.f;
#pragma unroll
        for (int kk = 0; kk < NKK; ++kk) { const uint4 w = __builtin_bit_cast(uint4, qf[kk]);
            ss += bflo(w.x) * bflo(w.x) + bfhi(w.x) * bfhi(w.x) + bflo(w.y) * bflo(w.y) + bfhi(w.y) * bfhi(w.y) + bflo(w.z) * bflo(w.z) + bfhi(w.z) * bfhi(w.z) + bflo(w.w) * bflo(w.w) + bfhi(w.w) * bfhi(w.w); }
        ss += __shfl_xor(ss, 32);
        const float inv = rsqrtf(ss * (1.f / DQK) + EPS) * qscale;
#pragma unroll
        for (int kk = 0; kk < NKK; ++kk) { const uint4 w = __builtin_bit_cast(uint4, qf[kk]);
            const f32x4 g0 = ld_f4(qgain + kk * 16 + half * 8), g1 = ld_f4(qgain + kk * 16 + half * 8 + 4); uint4 o;
            o.x = pk2(bflo(w.x) * inv * g0[0], bfhi(w.x) * inv * g0[1]); o.y = pk2(bflo(w.y) * inv * g0[2], bfhi(w.y) * inv * g0[3]);
            o.z = pk2(bflo(w.z) * inv * g1[0], bfhi(w.z) * inv * g1[1]); o.w = pk2(bflo(w.w) * inv * g1[2], bfhi(w.w) * inv * g1[3]);
            qf[kk] = __builtin_bit_cast(bf16x8, o); }
    }
    f32x16 accO[NDB];
#pragma unroll
    for (int db = 0; db < NDB; ++db)
#pragma unroll
        for (int r = 0; r < 16; ++r) accO[db][r] = 0.f;
    float m_run = -INFINITY, l_run = 0.f;
    uint4 kreg[NKC], vreg[NVC];
#define AT_LOAD(t) do { const int s0_ = (t) * 64; \
        _Pragma("unroll") for (int i = 0; i < NKC; ++i) { const int c = tid + 256 * i, row = c / KCH, kc = c % KCH; kreg[i] = *(const uint4*)(Kp + (size_t)(s0_ + row) * k_rs + kc * 8); } \
        _Pragma("unroll") for (int i = 0; i < NVC; ++i) { const int c = tid + 256 * i, d = c >> 3, kc = c & 7; vreg[i] = *(const uint4*)(Vtp + (size_t)d * vt_rs + s0_ + kc * 8); } } while (0)
#define AT_STORE(buf) do { unsigned char* Ks_ = smem + (buf) * STAGE; unsigned char* Vs_ = Ks_ + KT_BYTES; \
        _Pragma("unroll") for (int i = 0; i < NKC; ++i) { const int c = tid + 256 * i, row = c / KCH, kc = c % KCH; *(uint4*)(Ks_ + row * KROW + kc * 16) = kreg[i]; } \
        _Pragma("unroll") for (int i = 0; i < NVC; ++i) { const int c = tid + 256 * i, d = c >> 3, kc = c & 7; uint2 lo_, hi_; lo_.x = vreg[i].x; lo_.y = vreg[i].y; hi_.x = vreg[i].z; hi_.y = vreg[i].w; \
            *(uint2*)(Vs_ + d * VROW + kc * 16) = lo_; *(uint2*)(Vs_ + d * VROW + kc * 16 + 8) = hi_; } } while (0)
    const int nt = nkeys >> 6;
    if (PIPE) { AT_LOAD(0); AT_STORE(0); __syncthreads(); }
    for (int t = 0; t < nt; ++t) {
        const bool more = PIPE && (t + 1 < nt);
        if (PIPE) { if (more) AT_LOAD(t + 1); }
        else { AT_LOAD(t); AT_STORE(t & 1); __syncthreads(); }
        const unsigned char* Ks = smem + (t & 1) * STAGE;
        const unsigned char* Vs = Ks + KT_BYTES;
        f32x16 s[2];
#pragma unroll
        for (int kb = 0; kb < 2; ++kb) {
#pragma unroll
            for (int r = 0; r < 16; ++r) s[kb][r] = 0.f;
#pragma unroll
            for (int kk = 0; kk < NKK; ++kk) {
                const bf16x8 kf = *(const bf16x8*)(Ks + (kb * 32 + ql) * KROW + kk * 32 + half * 16);
                s[kb] = __builtin_amdgcn_mfma_f32_32x32x16_bf16(kf, qf[kk], s[kb], 0, 0, 0);
            }
        }
        float mx = s[0][0];
#pragma unroll
        for (int r = 1; r < 16; ++r) mx = fmaxf(mx, s[0][r]);
#pragma unroll
        for (int r = 0; r < 16; ++r) mx = fmaxf(mx, s[1][r]);
        mx = fmaxf(mx, __shfl_xor(mx, 32));
        const float m_new = fmaxf(m_run, mx);
        const float alpha = __builtin_amdgcn_exp2f(m_run - m_new);
        m_run = m_new;
        float psum = 0.f;
#pragma unroll
        for (int kb = 0; kb < 2; ++kb)
#pragma unroll
            for (int r = 0; r < 16; ++r) { const float pv = __builtin_amdgcn_exp2f(s[kb][r] - m_new); s[kb][r] = pv; psum += pv; }
        l_run = l_run * alpha + psum;
#pragma unroll
        for (int db = 0; db < NDB; ++db)
#pragma unroll
            for (int r = 0; r < 16; ++r) accO[db][r] *= alpha;
#pragma unroll
        for (int kb = 0; kb < 2; ++kb)
#pragma unroll
            for (int p2 = 0; p2 < 2; ++p2) {
                uint4 pw;
                pw.x = pk2(s[kb][8 * p2 + 0], s[kb][8 * p2 + 1]); pw.y = pk2(s[kb][8 * p2 + 2], s[kb][8 * p2 + 3]);
                pw.z = pk2(s[kb][8 * p2 + 4], s[kb][8 * p2 + 5]); pw.w = pk2(s[kb][8 * p2 + 6], s[kb][8 * p2 + 7]);
                const bf16x8 pf = __builtin_bit_cast(bf16x8, pw);
#pragma unroll
                for (int db = 0; db < NDB; ++db) {
                    const unsigned char* vp = Vs + (db * 32 + ql) * VROW + (kb * 32 + 16 * p2 + half * 4) * 2;
                    const uint2 vlo = *(const uint2*)vp, vhi = *(const uint2*)(vp + 16);
                    uint4 vw; vw.x = vlo.x; vw.y = vlo.y; vw.z = vhi.x; vw.w = vhi.y;
                    accO[db] = __builtin_amdgcn_mfma_f32_32x32x16_bf16(__builtin_bit_cast(bf16x8, vw), pf, accO[db], 0, 0, 0);
                }
            }
        if (PIPE) { if (more) AT_STORE((t + 1) & 1); __syncthreads(); }
    }
#undef AT_LOAD
#undef AT_STORE
    const float l = l_run + __shfl_xor(l_run, 32);
    const float inv = 1.f / l;
    bf16_t* orow = Op + (size_t)(wid * 32 + ql) * o_rs + half * 4;
#pragma unroll
    for (int db = 0; db < NDB; ++db)
#pragma unroll
        for (int g = 0; g < 4; ++g) {
            f32x4 v = {accO[db][4 * g] * inv, accO[db][4 * g + 1] * inv, accO[db][4 * g + 2] * inv, accO[db][4 * g + 3] * inv};
            st_bf4(orow + db * 32 + 8 * g, v);
        }
}


DEVI void attn_mla_item(const float* gq, const float* ROPEp, int pos0, const bf16_t* Qp, const bf16_t* Kp, const bf16_t* Vtp, int vt_rs, int nkeys, bf16_t* Op, unsigned char* smem, int tx) {
    constexpr int KROW = 208, VROW = 264, KT_BYTES = 128 * KROW, VT_BYTES = 64 * VROW, STAGE = KT_BYTES + VT_BYTES;
    static_assert(2 * STAGE <= 2 * SM_TOTAL, "attn lds");
    const int lane = tx & 63, wid = tx >> 6, ql = lane & 31, half = lane >> 5;
    __syncthreads();
    bf16x8 qf[6];
    {
        const bf16_t* qrow = Qp + (size_t)(wid * 32 + ql) * 768 + half * 8;
#pragma unroll
        for (int kk = 0; kk < 6; ++kk) qf[kk] = *(const bf16x8*)(qrow + kk * 16);
    }
    {
        float ss = 0.f;
#pragma unroll
        for (int kk = 0; kk < 6; ++kk) { const uint4 w = __builtin_bit_cast(uint4, qf[kk]);
            ss += bflo(w.x) * bflo(w.x) + bfhi(w.x) * bfhi(w.x) + bflo(w.y) * bflo(w.y) + bfhi(w.y) * bfhi(w.y) + bflo(w.z) * bflo(w.z) + bfhi(w.z) * bfhi(w.z) + bflo(w.w) * bflo(w.w) + bfhi(w.w) * bfhi(w.w); }
        ss += __shfl_xor(ss, 32);
        const float inv = rsqrtf(ss * (1.f / 96.f) + EPS) * QSCALE_MLA;
#pragma unroll
        for (int kk = 0; kk < 4; ++kk) { const uint4 w = __builtin_bit_cast(uint4, qf[kk]);
            const f32x4 g0 = ld_f4(gq + kk * 16 + half * 8), g1 = ld_f4(gq + kk * 16 + half * 8 + 4); uint4 o;
            o.x = pk2(bflo(w.x) * inv * g0[0], bfhi(w.x) * inv * g0[1]); o.y = pk2(bflo(w.y) * inv * g0[2], bfhi(w.y) * inv * g0[3]);
            o.z = pk2(bflo(w.z) * inv * g1[0], bfhi(w.z) * inv * g1[1]); o.w = pk2(bflo(w.w) * inv * g1[2], bfhi(w.w) * inv * g1[3]);
            qf[kk] = __builtin_bit_cast(bf16x8, o); }
        const uint4 wa = __builtin_bit_cast(uint4, qf[4]), wb = __builtin_bit_cast(uint4, qf[5]);
        const float* rp = ROPEp + ((size_t)(pos0 + wid * 32 + ql) * 16 + half * 8) * 2;
        const float* ga = gq + 64 + half * 8; const float* gb = gq + 80 + half * 8;
        float x1[8] = {bflo(wa.x), bfhi(wa.x), bflo(wa.y), bfhi(wa.y), bflo(wa.z), bfhi(wa.z), bflo(wa.w), bfhi(wa.w)};
        float x2[8] = {bflo(wb.x), bfhi(wb.x), bflo(wb.y), bfhi(wb.y), bflo(wb.z), bfhi(wb.z), bflo(wb.w), bfhi(wb.w)};
        float r1[8], r2[8];
#pragma unroll
        for (int q4 = 0; q4 < 2; ++q4) {
            const f32x4 g1v = ld_f4(ga + q4 * 4), g2v = ld_f4(gb + q4 * 4), csA = ld_f4(rp + q4 * 8), csB = ld_f4(rp + q4 * 8 + 4);
            const float co[4] = {csA[0], csA[2], csB[0], csB[2]}, si[4] = {csA[1], csA[3], csB[1], csB[3]};
#pragma unroll
            for (int j = 0; j < 4; ++j) { const float a = x1[q4 * 4 + j] * inv * g1v[j], b = x2[q4 * 4 + j] * inv * g2v[j]; r1[q4 * 4 + j] = a * co[j] - b * si[j]; r2[q4 * 4 + j] = b * co[j] + a * si[j]; }
        }
        uint4 oa, ob;
        oa.x = pk2(r1[0], r1[1]); oa.y = pk2(r1[2], r1[3]); oa.z = pk2(r1[4], r1[5]); oa.w = pk2(r1[6], r1[7]);
        ob.x = pk2(r2[0], r2[1]); ob.y = pk2(r2[2], r2[3]); ob.z = pk2(r2[4], r2[5]); ob.w = pk2(r2[6], r2[7]);
        qf[4] = __builtin_bit_cast(bf16x8, oa); qf[5] = __builtin_bit_cast(bf16x8, ob);
    }
    f32x16 accO[2];
#pragma unroll
    for (int db = 0; db < 2; ++db)
#pragma unroll
        for (int r = 0; r < 16; ++r) accO[db][r] = 0.f;
    float m_run = -INFINITY, l_run = 0.f;
    uint4 kreg[3], vreg[2];
#define AM_LOAD(t) do { const int s0_ = (t) * 128; \
        _Pragma("unroll") for (int i = 0; i < 3; ++i) { const int c = tx + 512 * i, row = c / 12, kc = c % 12; kreg[i] = *(const uint4*)(Kp + (size_t)(s0_ + row) * 768 + kc * 8); } \
        _Pragma("unroll") for (int i = 0; i < 2; ++i) { const int c = tx + 512 * i, d = c >> 4, kc = c & 15; vreg[i] = *(const uint4*)(Vtp + (size_t)d * vt_rs + s0_ + kc * 8); } } while (0)
#define AM_STORE(buf) do { unsigned char* Ks_ = smem + (buf) * STAGE; unsigned char* Vs_ = Ks_ + KT_BYTES; \
        _Pragma("unroll") for (int i = 0; i < 3; ++i) { const int c = tx + 512 * i, row = c / 12, kc = c % 12; *(uint4*)(Ks_ + row * KROW + kc * 16) = kreg[i]; } \
        _Pragma("unroll") for (int i = 0; i < 2; ++i) { const int c = tx + 512 * i, d = c >> 4, kc = c & 15; uint2 lo_, hi_; lo_.x = vreg[i].x; lo_.y = vreg[i].y; hi_.x = vreg[i].z; hi_.y = vreg[i].w; \
            *(uint2*)(Vs_ + d * VROW + kc * 16) = lo_; *(uint2*)(Vs_ + d * VROW + kc * 16 + 8) = hi_; } } while (0)
    const int nt = nkeys >> 7;
    AM_LOAD(0); AM_STORE(0); __syncthreads();
    for (int t = 0; t < nt; ++t) {
        const bool more = t + 1 < nt;
        if (more) AM_LOAD(t + 1);
        const unsigned char* Ks = smem + (t & 1) * STAGE;
        const unsigned char* Vs = Ks + KT_BYTES;
        f32x16 s[4];
#pragma unroll
        for (int kb = 0; kb < 4; ++kb)
#pragma unroll
            for (int r = 0; r < 16; ++r) s[kb][r] = 0.f;
#pragma unroll
        for (int kk = 0; kk < 6; ++kk)
#pragma unroll
            for (int kb = 0; kb < 4; ++kb) {
                const bf16x8 kf = *(const bf16x8*)(Ks + (kb * 32 + ql) * KROW + kk * 32 + half * 16);
                s[kb] = __builtin_amdgcn_mfma_f32_32x32x16_bf16(kf, qf[kk], s[kb], 0, 0, 0);
            }
        float mx = -INFINITY;
#pragma unroll
        for (int kb = 0; kb < 4; ++kb)
#pragma unroll
            for (int r = 0; r < 16; r += 2) mx = fmaxf(fmaxf(mx, s[kb][r]), s[kb][r + 1]);
        mx = fmaxf(mx, __shfl_xor(mx, 32));
        const float m_new = fmaxf(m_run, mx);
        if (__any(m_new > m_run)) {
            const float alpha = __builtin_amdgcn_exp2f(m_run - m_new);
            l_run *= alpha;
#pragma unroll
            for (int db = 0; db < 2; ++db)
#pragma unroll
                for (int r = 0; r < 16; ++r) accO[db][r] *= alpha;
        }
        m_run = m_new;
        float psum = 0.f;
#pragma unroll
        for (int kb = 0; kb < 4; ++kb)
#pragma unroll
            for (int r = 0; r < 16; ++r) { const float pv = __builtin_amdgcn_exp2f(s[kb][r] - m_new); s[kb][r] = pv; psum += pv; }
        l_run += psum;
#pragma unroll
        for (int kb = 0; kb < 4; ++kb)
#pragma unroll
            for (int p2 = 0; p2 < 2; ++p2) {
                uint4 pw;
                pw.x = pk2(s[kb][8 * p2 + 0], s[kb][8 * p2 + 1]); pw.y = pk2(s[kb][8 * p2 + 2], s[kb][8 * p2 + 3]);
                pw.z = pk2(s[kb][8 * p2 + 4], s[kb][8 * p2 + 5]); pw.w = pk2(s[kb][8 * p2 + 6], s[kb][8 * p2 + 7]);
                const bf16x8 pf = __builtin_bit_cast(bf16x8, pw);
#pragma unroll
                for (int db = 0; db < 2; ++db) {
                    const unsigned char* vp = Vs + (db * 32 + ql) * VROW + (kb * 32 + 16 * p2 + half * 4) * 2;
                    const uint2 vlo = *(const uint2*)vp, vhi = *(const uint2*)(vp + 16);
                    uint4 vw; vw.x = vlo.x; vw.y = vlo.y; vw.z = vhi.x; vw.w = vhi.y;
                    accO[db] = __builtin_amdgcn_mfma_f32_32x32x16_bf16(__builtin_bit_cast(bf16x8, vw), pf, accO[db], 0, 0, 0);
                }
            }
        if (more) AM_STORE((t + 1) & 1);
        __syncthreads();
    }
#undef AM_LOAD
#undef AM_STORE
    const float l = l_run + __shfl_xor(l_run, 32);
    const float inv = 1.f / l;
    bf16_t* orow = Op + (size_t)(wid * 32 + ql) * 512 + half * 4;
#pragma unroll
    for (int db = 0; db < 2; ++db)
#pragma unroll
        for (int g = 0; g < 4; ++g) {
            f32x4 v = {accO[db][4 * g] * inv, accO[db][4 * g + 1] * inv, accO[db][4 * g + 2] * inv, accO[db][4 * g + 3] * inv};
            st_bf4(orow + db * 32 + 8 * g, v);
        }
}

namespace pg8 {
#define PG8_LAS __attribute__((address_space(3)))
typedef unsigned short bf16_t;
typedef short bf16x8 __attribute__((ext_vector_type(8)));
typedef float f32x4 __attribute__((ext_vector_type(4)));
typedef unsigned u32x4 __attribute__((ext_vector_type(4)));
constexpr int BM = 256, BK = 64, HALF = 128, HTB = HALF * BK * 2  , STAGE_BYTES = 8 * HTB, NXCD = 8, WGM = 8;

__host__ __device__ __forceinline__ int lds_byte(int r, int c) { const int st = (r >> 4) * 2 + (c >> 5), rr = r & 15, cc = c & 31, ob = rr * 64 + cc * 2; return st * 1024 + (ob ^ (((ob >> 9) & 1) << 5)); }
__host__ __device__ __forceinline__ void stage_rc(int b, int& R, int& C) { const int st = b / 1024, sb = b % 1024, swz = sb ^ (((sb >> 9) & 1) << 5); R = (st >> 1) * 16 + swz / 64; C = (st & 1) * 32 + (swz % 64) / 2; }
__host__ __device__ __forceinline__ int perm32(int rho) { const int n = rho >> 4, i = rho & 15; return 8 * (i >> 2) + 4 * n + (i & 3); }

struct Unit { int pm, pn; };
struct Gemm { const bf16_t* A; const bf16_t* Bt; int M, N, K, lda, ldb; size_t kstepA, kstepB; };

struct StaticOrder {
    int nM, nN, nwg, G, c;
    __host__ __device__ void init(int M, int N, int G_, int c_) { nM = M / BM; nN = N / BM; nwg = nM * nN; G = G_; c = c_; }
    __host__ __device__ bool next(int i, Unit& u) const {
        const long L = (long)i * G + c; if (L >= nwg) return false;
        int wgid = (int)L; { const int q = nwg / NXCD, r = nwg % NXCD, xcd = wgid % NXCD, off = wgid / NXCD; wgid = (xcd < r ? xcd * (q + 1) : r * (q + 1) + (xcd - r) * q) + off; }
        const int nig = WGM * nN, gid = wgid / nig, fm = gid * WGM, gsz = (nM - fm) < WGM ? (nM - fm) : WGM;
        u.pm = fm + ((wgid % nig) % gsz); u.pn = (wgid % nig) / gsz; return true;
    }
    __device__ __forceinline__ void a_ready(const Unit&) const {}
    __device__ __forceinline__ void done(const Unit&) const {}
};


DEVI float rs_inv(const float* rs, int row) { return rsqrtf(rs[row] * (1.f / 1024.f) + EPS); }
struct EpiGU {
    static constexpr bool PERM = false, AFTER_DRAIN = false;
    bf16_t* HID; const float* rs;
    __device__ __forceinline__ void operator()(const f32x4 (&acc)[2][2][4][2], const Unit& u, int wr, int wc, int fr, int fq) const {
        asm volatile("" : "+v"(fr), "+v"(fq));
#pragma unroll
        for (int ai = 0; ai < 2; ++ai)
#pragma unroll
            for (int m = 0; m < 4; ++m) {
                const int row = u.pm * BM + ai * HALF + wr * 64 + m * 16 + fr; const float ri = rs_inv(rs, row);
                bf16_t* rowp = HID + ((size_t)(u.pn * 2) * NTOK + (size_t)(u.pm * 2 + ai) * 128) * 64 + ((wr * 4 + m) * 4 + wc) * 256 + fr * 16 + fq * 4;
#pragma unroll
                for (int bj = 0; bj < 2; ++bj) {
                    const f32x4 g = acc[ai][bj][m][0] * ri, up = acc[ai][bj][m][1] * ri; f32x4 h;
#pragma unroll
                    for (int j = 0; j < 4; ++j) h[j] = g[j] * __builtin_amdgcn_rcpf(1.f + __expf(-g[j])) * up[j];
                    ::st_bf4(rowp + (size_t)bj * NTOK * 64, h);
                }
            }
    }
};
template <int RES> struct EpiRes {
    static constexpr bool PERM = false, AFTER_DRAIN = false;
    const float* rf0; const float* rf1; const bf16_t* rb; bf16_t* out; float* rs; float scale;
    __device__ __forceinline__ void operator()(const f32x4 (&acc)[2][2][4][2], const Unit& u, int wr, int wc, int fr, int fq) const {
        asm volatile("" : "+v"(fr), "+v"(fq));
#pragma unroll
        for (int ai = 0; ai < 2; ++ai) {
            const int row0 = u.pm * BM + ai * HALF + wr * 64 + fr, col0 = u.pn * BM + wc * 32 + fq * 4;
            f32x4 r[4][2][2];
#pragma unroll
            for (int m = 0; m < 4; ++m) {
                const int row = row0 + m * 16;
                const float* rp = (row < 16384 ? rf0 + (size_t)row * 1024 : rf1 + (size_t)(row - 16384) * 1024) + col0;
#pragma unroll
                for (int bj = 0; bj < 2; ++bj)
#pragma unroll
                    for (int n = 0; n < 2; ++n) r[m][bj][n] = RES == 0 ? ::ld_f4(rp + bj * HALF + n * 16) : ::ld_bf4(rb + (size_t)row * 1024 + col0 + bj * HALF + n * 16);
            }
#pragma unroll
            for (int m = 0; m < 4; ++m) {
                const int row = row0 + m * 16;
                float ss = 0.f;
#pragma unroll
                for (int bj = 0; bj < 2; ++bj)
#pragma unroll
                    for (int n = 0; n < 2; ++n) {
                        const f32x4 o = r[m][bj][n] + acc[ai][bj][m][n] * scale;
                        ss += ::dot4(o);
                        ::st_bf4(out + (size_t)row * 1024 + col0 + bj * HALF + n * 16, o);
                    }
                ss = ::red4q(ss);
                if (fq == 0) atomicAdd(rs + row, ss);
            }
        }
    }
};
struct EpiFinal {
    static constexpr bool PERM = false, AFTER_DRAIN = false;
    const bf16_t* rb; float* out;
    __device__ __forceinline__ void operator()(const f32x4 (&acc)[2][2][4][2], const Unit& u, int wr, int wc, int fr, int fq) const {
        asm volatile("" : "+v"(fr), "+v"(fq));
#pragma unroll
        for (int ai = 0; ai < 2; ++ai)
#pragma unroll
            for (int m = 0; m < 4; ++m) {
                const size_t off = (size_t)(u.pm * BM + ai * HALF + wr * 64 + m * 16 + fr) * 1024 + u.pn * BM + wc * 32 + fq * 4;
#pragma unroll
                for (int bj = 0; bj < 2; ++bj)
#pragma unroll
                    for (int n = 0; n < 2; ++n) { const f32x4 o = ::ld_bf4(rb + off + bj * HALF + n * 16) + acc[ai][bj][m][n] * 0.5f; *(float4*)(out + off + bj * HALF + n * 16) = make_float4(o[0], o[1], o[2], o[3]); }
            }
    }
};

struct EpiQ {
    static constexpr bool PERM = false, AFTER_DRAIN = false;
    const float* RSQ; bf16_t* Q;
    __device__ __forceinline__ void operator()(const f32x4 (&acc)[2][2][4][2], const Unit& u, int wr, int wc, int fr, int fq) const {
        asm volatile("" : "+v"(fr), "+v"(fq));
#pragma unroll
        for (int ai = 0; ai < 2; ++ai)
#pragma unroll
            for (int m = 0; m < 4; ++m) {
                const int row = u.pm * BM + ai * HALF + wr * 64 + m * 16 + fr; const float ri = rsqrtf(RSQ[row] * (1.f / 384.f) + EPS);
                bf16_t* d = Q + (size_t)row * 768 + u.pn * BM + wc * 32 + fq * 4;
#pragma unroll
                for (int bj = 0; bj < 2; ++bj)
#pragma unroll
                    for (int n = 0; n < 2; ++n) ::st_bf4(d + bj * HALF + n * 16, acc[ai][bj][m][n] * ri);
            }
    }
};
struct EpiK {
    static constexpr bool PERM = false, AFTER_DRAIN = false;
    const float* RSKV; const bf16_t* CKV; const float* gk; const float* ROPE; bf16_t* K;
    __device__ __forceinline__ void operator()(const f32x4 (&acc)[2][2][4][2], const Unit& u, int wr, int wc, int fr, int fq) const {
        asm volatile("" : "+v"(fr), "+v"(fq));
        const int h = u.pn * 4 + wc;
#pragma unroll
        for (int ai = 0; ai < 2; ++ai) {
            uint2 krA[4], krB[4]; float rsv[4];
#pragma unroll
            for (int m = 0; m < 4; ++m) {
                const int row = u.pm * BM + ai * HALF + wr * 64 + m * 16 + fr;
                rsv[m] = RSKV[row];
                krA[m] = *(const uint2*)(CKV + (size_t)row * 288 + 256 + fq * 4);
                krB[m] = *(const uint2*)(CKV + (size_t)row * 288 + 272 + fq * 4);
            }
#pragma unroll
            for (int m = 0; m < 4; ++m) {
                const int row = u.pm * BM + ai * HALF + wr * 64 + m * 16 + fr; const float ri = rsqrtf(rsv[m] * (1.f / 256.f) + EPS);
                float s = 0.f;
#pragma unroll
                for (int bj = 0; bj < 2; ++bj)
#pragma unroll
                    for (int n = 0; n < 2; ++n) s += ::dot4(acc[ai][bj][m][n]);
                s *= ri * ri;
                const uint2 wa = krA[m], wb = krB[m];
                const f32x4 kr1 = {::bflo(wa.x), ::bfhi(wa.x), ::bflo(wa.y), ::bfhi(wa.y)}, kr2 = {::bflo(wb.x), ::bfhi(wb.x), ::bflo(wb.y), ::bfhi(wb.y)};
                s += ::dot4(kr1) + ::dot4(kr2);
                s = ::red4q(s);
                const float inv = rsqrtf(s * (1.f / 96.f) + EPS), rinv = ri * inv;
                bf16_t* dst = K + ((size_t)row * 8 + h) * 96;
#pragma unroll
                for (int bj = 0; bj < 2; ++bj)
#pragma unroll
                    for (int n = 0; n < 2; ++n) { const int c = bj * 32 + n * 16 + fq * 4; ::st_bf4(dst + c, acc[ai][bj][m][n] * rinv * ::ld_f4(gk + c)); }
                const int pos = ::tok_pos(row);
                const f32x4 x1 = kr1 * inv * ::ld_f4(gk + 64 + fq * 4), x2 = kr2 * inv * ::ld_f4(gk + 80 + fq * 4);
                const f32x4 cs0 = ::ld_f4(ROPE + ((size_t)pos * 16 + fq * 4) * 2), cs1 = ::ld_f4(ROPE + ((size_t)pos * 16 + fq * 4) * 2 + 4);
                const f32x4 co = {cs0[0], cs0[2], cs1[0], cs1[2]}, si = {cs0[1], cs0[3], cs1[1], cs1[3]};
                ::st_bf4(dst + 64 + fq * 4, x1 * co - x2 * si);
                ::st_bf4(dst + 80 + fq * 4, x2 * co + x1 * si);
            }
        }
    }
};
struct EpiVt {
    static constexpr bool PERM = false, AFTER_DRAIN = false;
    const float* RSKV; bf16_t* VT;
    __device__ __forceinline__ void operator()(const f32x4 (&acc)[2][2][4][2], const Unit& u, int wr, int wc, int fr, int fq) const {
        asm volatile("" : "+v"(fr), "+v"(fq));
#pragma unroll
        for (int bj = 0; bj < 2; ++bj)
#pragma unroll
            for (int n = 0; n < 2; ++n) {
                const int tok0 = u.pn * BM + bj * HALF + wc * 32 + n * 16 + fq * 4;
                f32x4 ric = ::ld_f4(RSKV + tok0);
#pragma unroll
                for (int j = 0; j < 4; ++j) ric[j] = rsqrtf(ric[j] * (1.f / 256.f) + EPS);
#pragma unroll
                for (int ai = 0; ai < 2; ++ai)
#pragma unroll
                    for (int m = 0; m < 4; ++m) {
                        const int hd = u.pm * BM + ai * HALF + wr * 64 + m * 16 + fr, h = hd >> 6, d = hd & 63;
                        size_t off;
                        if (tok0 < 16384) off = ((size_t)((tok0 >> 13) * 8 + h) * 64 + d) * 8192 + (tok0 & 8191);
                        else { const int tt = tok0 - 16384; off = (size_t)8388608 + ((size_t)((tt >> 12) * 8 + h) * 64 + d) * 4096 + (tt & 4095); }
                        ::st_bf4(VT + off, acc[ai][bj][m][n] * ric);
                    }
            }
    }
};
struct EpiIn1 {
    static constexpr bool PERM = false, AFTER_DRAIN = false;
    const float* rs1; bf16_t* CQ; bf16_t* CKV; bf16_t* XQ; float* RSQ; float* RSKV;
    __device__ __forceinline__ void operator()(const f32x4 (&acc)[2][2][4][2], const Unit& u, int wr, int wc, int fr, int fq) const {
        asm volatile("" : "+v"(fr), "+v"(fq));
#pragma unroll
        for (int bj = 0; bj < 2; ++bj) {
            const int cg = u.pn * BM + bj * HALF + wc * 32;
            bf16_t* dst; int ld, c0; float* rs = nullptr;
            if (cg < 384) { dst = CQ; ld = 384; c0 = cg; rs = RSQ; }
            else if (cg < 640) { dst = CKV; ld = 288; c0 = cg - 384; rs = RSKV; }
            else if (cg < 672) { dst = CKV; ld = 288; c0 = 256 + (cg - 640); }
            else if (cg < 768) continue;
            else { dst = XQ; ld = 512; c0 = cg - 768; }
#pragma unroll
            for (int ai = 0; ai < 2; ++ai)
#pragma unroll
                for (int m = 0; m < 4; ++m) {
                    const int row = u.pm * BM + ai * HALF + wr * 64 + m * 16 + fr; const float ri = rs_inv(rs1, row);
                    const f32x4 v0 = acc[ai][bj][m][0] * ri, v1 = acc[ai][bj][m][1] * ri;
                    ::st_bf4(dst + (size_t)row * ld + c0 + fq * 4, v0); ::st_bf4(dst + (size_t)row * ld + c0 + 16 + fq * 4, v1);
                    if (rs) { const float s = ::red4q(::dot4(v0) + ::dot4(v1)); if (fq == 0) atomicAdd(rs + row, s); }
                }
        }
    }
};
struct EpiIn2 {
    static constexpr bool PERM = false, AFTER_DRAIN = false;
    const float* rs1; bf16_t* CB; bf16_t* U;
    __device__ __forceinline__ void operator()(const f32x4 (&acc)[2][2][4][2], const Unit& u, int wr, int wc, int fr, int fq) const {
        asm volatile("" : "+v"(fr), "+v"(fq));
#pragma unroll
        for (int ai = 0; ai < 2; ++ai)
#pragma unroll
            for (int m = 0; m < 4; ++m) {
                const int row = u.pm * BM + ai * HALF + wr * 64 + m * 16 + fr; const float ri = rs_inv(rs1, row);
#pragma unroll
                for (int bj = 0; bj < 2; ++bj) {
                    const f32x4 v0 = acc[ai][bj][m][0] * ri, v1 = acc[ai][bj][m][1] * ri;
                    if (u.pn < 2) { bf16_t* d = CB + (size_t)row * 512 + u.pn * BM + bj * HALF + wc * 32 + fq * 4; ::st_bf4(d, v0); ::st_bf4(d + 16, v1); }
                    else ::st_bf4(U + (size_t)row * 512 + (u.pn - 2) * 128 + bj * 64 + wc * 16 + fq * 4, v0 * v1);
                }
            }
    }
};
template <class Epi, class Sched, bool ALIGN_EPI = false, bool SP2 = false>
__device__ __forceinline__ void gemm_phase(PG8_LAS unsigned char* lds, const Gemm g, const Sched& S, const Epi& E) {
    int tid_ = threadIdx.x; asm volatile("" : "+v"(tid_));
    const int tid = tid_, wid = __builtin_amdgcn_readfirstlane(tid >> 6), lane = tid & 63, wr = wid >> 2, wc = wid & 3, fr = lane & 15, fq = lane >> 4;
    const int K = g.K, nt = K / BK;
    unsigned voffA[2], voffB[2];
#pragma unroll
    for (int i = 0; i < 2; ++i) { int R, C; stage_rc(tid * 16 + i * 8192, R, C); const int Rb = Epi::PERM ? ((R & ~31) + perm32(R & 31)) : R;
        voffA[i] = g.lda ? (unsigned)(R * g.lda + C) * 2u : (unsigned)(((R >> 4) * 4 + (C >> 4)) * 512 + (R & 15) * 32 + ((C >> 3) & 1) * 16);
        voffB[i] = (unsigned)(Rb * g.ldb + C) * 2u; }
    const size_t kstepA = g.kstepA, kstepB = g.kstepB;
    const size_t hstepA = (size_t)HALF * (g.lda ? g.lda : 64) * 2, hstepB = (size_t)HALF * g.ldb * 2;
    const size_t tstepA = 2 * hstepA, tstepB = 2 * hstepB;
    const unsigned ldsw = (unsigned)wid * 1024u;
    const int aoff = lds_byte(wr * 64 + fr, fq * 8), boff = lds_byte(wc * 32 + fr, fq * 8);
#define PG8_SA(b, h) (((b) * 2 + (h)) * HTB)
#define PG8_SB(b, h) ((4 + (b) * 2 + (h)) * HTB)
#define PG8_STAGE(bufoff, gbase, voff) do { _Pragma("unroll") for (int _i = 0; _i < 2; ++_i) \
        __builtin_amdgcn_global_load_lds((const unsigned*)((const char*)(gbase) + (voff)[_i]), (PG8_LAS unsigned*)(lds + (bufoff) + ldsw + _i * 8192), 16, 0, 0); } while (0)
#define PG8_LDA(dst, b, h) do { _Pragma("unroll") for (int m = 0; m < 4; ++m) _Pragma("unroll") for (int k = 0; k < 2; ++k) dst[m][k] = *(const PG8_LAS bf16x8*)(lds + PG8_SA(b, h) + aoff + m * 2048 + k * 1024); } while (0)
#define PG8_LDB(dst, b, h) do { _Pragma("unroll") for (int n = 0; n < 2; ++n) _Pragma("unroll") for (int k = 0; k < 2; ++k) dst[n][k] = *(const PG8_LAS bf16x8*)(lds + PG8_SB(b, h) + boff + n * 2048 + k * 1024); } while (0)
#define PG8_MMA(ai, bj, At, Bt) do { __builtin_amdgcn_s_setprio(1); _Pragma("unroll") for (int m = 0; m < 4; ++m) _Pragma("unroll") for (int n = 0; n < 2; ++n) _Pragma("unroll") for (int k = 0; k < 2; ++k) \
        acc[ai][bj][m][n] = __builtin_amdgcn_mfma_f32_16x16x32_bf16(Bt[n][k], At[m][k], acc[ai][bj][m][n], 0, 0, 0); __builtin_amdgcn_s_setprio(0); } while (0)
#define PG8_WAIT_V(n) asm volatile("s_waitcnt vmcnt(" #n ")" ::: "memory")
#define PG8_WAIT_L(n) asm volatile("s_waitcnt lgkmcnt(" #n ")" ::: "memory")
#define PG8_BAR __builtin_amdgcn_s_barrier()
#define PG8_SCHED __builtin_amdgcn_sched_barrier(0)
    Unit cur, nxt; int ui = 0;
    if (!S.next(0, cur)) return;
    f32x4 acc[2][2][4][2];
#pragma unroll
    for (int a = 0; a < 2; ++a)
#pragma unroll
        for (int b = 0; b < 2; ++b)
#pragma unroll
            for (int m = 0; m < 4; ++m)
#pragma unroll
                for (int n = 0; n < 2; ++n) acc[a][b][m][n] = (f32x4){0.f, 0.f, 0.f, 0.f};
    bf16x8 At[4][2], B0[2][2], B1[2][2];
    const char* cA = (const char*)g.A + (size_t)cur.pm * tstepA; const char* cB = (const char*)g.Bt + (size_t)cur.pn * tstepB;
    S.a_ready(cur);
    if constexpr (SP2) {
        PG8_STAGE(PG8_SB(0, 0), cB, voffB); PG8_STAGE(PG8_SB(0, 1), cB + hstepB, voffB); PG8_STAGE(PG8_SA(0, 0), cA, voffA); PG8_STAGE(PG8_SA(0, 1), cA + hstepA, voffA);
        if (wr == 1) PG8_BAR;
        PG8_WAIT_V(2); PG8_BAR;
        PG8_STAGE(PG8_SB(1, 0), cB + kstepB, voffB); PG8_STAGE(PG8_SA(1, 0), cA + kstepA, voffA); PG8_STAGE(PG8_SB(1, 1), cB + hstepB + kstepB, voffB);
        PG8_WAIT_V(6); PG8_BAR;
    } else {
        PG8_STAGE(PG8_SB(0, 0), cB, voffB); PG8_STAGE(PG8_SA(0, 0), cA, voffA); PG8_STAGE(PG8_SB(0, 1), cB + hstepB, voffB); PG8_STAGE(PG8_SA(0, 1), cA + hstepA, voffA);
        if (wr == 1) PG8_BAR;
        PG8_WAIT_V(4); PG8_BAR;
        PG8_STAGE(PG8_SB(1, 0), cB + kstepB, voffB); PG8_STAGE(PG8_SA(1, 0), cA + kstepA, voffA); PG8_STAGE(PG8_SB(1, 1), cB + hstepB + kstepB, voffB);
        PG8_WAIT_V(6); PG8_BAR;
    }
    for (;;) {
        const bool has_next = S.next(ui + 1, nxt);
        const char* nA = has_next ? (const char*)g.A + (size_t)nxt.pm * tstepA : cA; const char* nB = has_next ? (const char*)g.Bt + (size_t)nxt.pn * tstepB : cB;
        for (int t = 0; t < nt; t += 2) {
            const bool last = (t == nt - 2);
            const char* a1 = cA + (size_t)(t + 1) * kstepA;
            const char* a2 = last ? nA : cA + (size_t)(t + 2) * kstepA; const char* b2 = last ? nB : cB + (size_t)(t + 2) * kstepB;
            const char* a3 = a2 + kstepA; const char* b3 = b2 + kstepB;
            if (last && has_next) S.a_ready(nxt);
            if constexpr (SP2) {
            PG8_LDB(B0, 0, 0); PG8_LDB(B1, 0, 1); PG8_SCHED; PG8_LDA(At, 0, 0); PG8_STAGE(PG8_SA(1, 1), a1 + hstepA, voffA);
            PG8_WAIT_V(8); PG8_WAIT_L(0); PG8_BAR; PG8_MMA(0, 0, At, B0); PG8_MMA(0, 1, At, B1); PG8_BAR; PG8_SCHED;
            PG8_LDA(At, 0, 1); PG8_STAGE(PG8_SB(0, 0), b2, voffB); PG8_STAGE(PG8_SB(0, 1), b2 + hstepB, voffB); PG8_STAGE(PG8_SA(0, 0), a2, voffA);
            PG8_WAIT_V(8); PG8_WAIT_L(0); PG8_BAR; PG8_MMA(1, 0, At, B0); PG8_MMA(1, 1, At, B1); PG8_BAR; PG8_SCHED;
            PG8_LDB(B0, 1, 0); PG8_LDB(B1, 1, 1); PG8_SCHED; PG8_LDA(At, 1, 0); PG8_STAGE(PG8_SA(0, 1), a2 + hstepA, voffA);
            PG8_WAIT_V(8); PG8_WAIT_L(0); PG8_BAR; PG8_MMA(0, 0, At, B0); PG8_MMA(0, 1, At, B1); PG8_BAR; PG8_SCHED;
            PG8_LDA(At, 1, 1); PG8_STAGE(PG8_SB(1, 0), b3, voffB); PG8_STAGE(PG8_SB(1, 1), b3 + hstepB, voffB); PG8_STAGE(PG8_SA(1, 0), a3, voffA);
            PG8_WAIT_V(8); PG8_WAIT_L(0); PG8_BAR; PG8_MMA(1, 0, At, B0); PG8_MMA(1, 1, At, B1); PG8_BAR; PG8_SCHED;
            } else {
            PG8_LDB(B0, 0, 0); PG8_SCHED; PG8_LDA(At, 0, 0); PG8_STAGE(PG8_SA(1, 1), a1 + hstepA, voffA);
            PG8_WAIT_L(8); PG8_BAR; PG8_WAIT_L(0); PG8_MMA(0, 0, At, B0); PG8_BAR; PG8_SCHED;
            PG8_LDB(B1, 0, 1); PG8_STAGE(PG8_SB(0, 0), b2, voffB);
            PG8_BAR; PG8_WAIT_L(0); PG8_MMA(0, 1, At, B1); PG8_BAR;
            PG8_LDA(At, 0, 1); PG8_STAGE(PG8_SA(0, 0), a2, voffA);
            PG8_BAR; PG8_WAIT_L(0); PG8_MMA(1, 0, At, B0); PG8_BAR; PG8_SCHED;
            PG8_STAGE(PG8_SB(0, 1), b2 + hstepB, voffB);
            PG8_WAIT_V(6); PG8_BAR; PG8_MMA(1, 1, At, B1); PG8_BAR;
            PG8_LDB(B0, 1, 0); PG8_SCHED; PG8_LDA(At, 1, 0); PG8_STAGE(PG8_SA(0, 1), a2 + hstepA, voffA);
            PG8_WAIT_L(8); PG8_BAR; PG8_WAIT_L(0); PG8_MMA(0, 0, At, B0); PG8_BAR; PG8_SCHED;
            PG8_LDB(B1, 1, 1); PG8_STAGE(PG8_SB(1, 0), b3, voffB);
            PG8_BAR; PG8_WAIT_L(0); PG8_MMA(0, 1, At, B1); PG8_BAR;
            PG8_LDA(At, 1, 1); PG8_STAGE(PG8_SA(1, 0), a3, voffA);
            PG8_BAR; PG8_WAIT_L(0); PG8_MMA(1, 0, At, B0); PG8_BAR; PG8_SCHED;
            PG8_STAGE(PG8_SB(1, 1), b3 + hstepB, voffB);
            PG8_WAIT_V(6); PG8_BAR; PG8_MMA(1, 1, At, B1); PG8_BAR;
            }
        }
        if constexpr (ALIGN_EPI) { if (wr == 0) PG8_BAR; }
        if constexpr (!Epi::AFTER_DRAIN) { E(acc, cur, wr, wc, fr, fq); S.done(cur); }
        if (!has_next) break;
#pragma unroll
        for (int a = 0; a < 2; ++a)
#pragma unroll
            for (int b = 0; b < 2; ++b)
#pragma unroll
                for (int m = 0; m < 4; ++m)
#pragma unroll
                    for (int n = 0; n < 2; ++n) acc[a][b][m][n] = (f32x4){0.f, 0.f, 0.f, 0.f};
        cur = nxt; cA = nA; cB = nB; ++ui;
        if constexpr (ALIGN_EPI) { if (wr == 1) PG8_BAR; }
    }
    PG8_WAIT_V(0);
    if constexpr (!ALIGN_EPI) { if (wr == 0) PG8_BAR; }
    PG8_BAR;
    if constexpr (Epi::AFTER_DRAIN) { E.fused(acc, cur, wr, wc, fr, fq, lds, wid, lane); S.done(cur); }
#undef PG8_SA
#undef PG8_SB
#undef PG8_STAGE
#undef PG8_LDA
#undef PG8_LDB
#undef PG8_MMA
#undef PG8_WAIT_V
#undef PG8_WAIT_L
#undef PG8_BAR
#undef PG8_SCHED
}
struct MUnit { int pm, pn, b, g; };
template <class Epi>
__device__ __forceinline__ void gemm_phase_merge(PG8_LAS unsigned char* lds, const unsigned char* ws, const bf16_t* XBp, const StaticOrder& S, const Epi& E) {
    int tid_ = threadIdx.x; asm volatile("" : "+v"(tid_));
    const int tid = tid_, wid = __builtin_amdgcn_readfirstlane(tid >> 6), lane = tid & 63, wr = wid >> 2, wc = wid & 3, fr = lane & 15, fq = lane >> 4;
    unsigned vY0, vGd;
    { int R, C; stage_rc(tid * 16, R, C); vY0 = (unsigned)(R * 512 + C) * 2u; vGd = (unsigned)(R * 512) * 2u; }
    constexpr size_t kstep = (size_t)(BK * 2), hY = (size_t)HALF * 512 * 2, hG = (size_t)HALF * 1024 * 2;
    const unsigned ldsw = (unsigned)wid * 1024u;
    const int aoff = lds_byte(wr * 64 + fr, fq * 8), boff = lds_byte(wc * 32 + fr, fq * 8);
#define PG8_SA(b, h) (((b) * 2 + (h)) * HTB)
#define PG8_SB(b, h) ((4 + (b) * 2 + (h)) * HTB)
#define PG8_STAGE(bufoff, gbase, voff, q64) do { const char* gb0_ = (const char*)(gbase); const char* gb1_ = gb0_ + (q64); unsigned vo_ = (voff); \
        asm volatile("" : "+s"(gb0_)); asm volatile("" : "+s"(gb1_)); asm volatile("" : "+v"(vo_));        \
        __builtin_amdgcn_global_load_lds((const unsigned*)(gb0_ + vo_), (PG8_LAS unsigned*)(lds + (bufoff) + ldsw), 16, 0, 0); \
        __builtin_amdgcn_global_load_lds((const unsigned*)(gb1_ + vo_), (PG8_LAS unsigned*)(lds + (bufoff) + ldsw + 8192), 16, 0, 0); } while (0)
#define PG8_LDA(dst, b, h) do { _Pragma("unroll") for (int m = 0; m < 4; ++m) _Pragma("unroll") for (int k = 0; k < 2; ++k) dst[m][k] = *(const PG8_LAS bf16x8*)(lds + PG8_SA(b, h) + aoff + m * 2048 + k * 1024); } while (0)
#define PG8_LDB(dst, b, h) do { _Pragma("unroll") for (int n = 0; n < 2; ++n) _Pragma("unroll") for (int k = 0; k < 2; ++k) dst[n][k] = *(const PG8_LAS bf16x8*)(lds + PG8_SB(b, h) + boff + n * 2048 + k * 1024); } while (0)
#define PG8_MMA(ai, bj, At, Bt) do { __builtin_amdgcn_s_setprio(1); _Pragma("unroll") for (int m = 0; m < 4; ++m) _Pragma("unroll") for (int n = 0; n < 2; ++n) _Pragma("unroll") for (int k = 0; k < 2; ++k) \
        acc[ai][bj][m][n] = __builtin_amdgcn_mfma_f32_16x16x32_bf16(Bt[n][k], At[m][k], acc[ai][bj][m][n], 0, 0, 0); __builtin_amdgcn_s_setprio(0); } while (0)
#define PG8_WAIT_V(n) asm volatile("s_waitcnt vmcnt(" #n ")" ::: "memory")
#define PG8_WAIT_L(n) asm volatile("s_waitcnt lgkmcnt(" #n ")" ::: "memory")
#define PG8_BAR __builtin_amdgcn_s_barrier()
#define PG8_SCHED __builtin_amdgcn_sched_barrier(0)
#define MU_NEXT(i, u, ok) do { Unit t_; const int ti_ = (i) / 6, sub_ = (i) - 6 * ti_; ok = S.next(ti_, t_); u.pm = t_.pm; u.pn = t_.pn; u.b = sub_ >> 1; u.g = sub_ & 1; } while (0)
#define MU_BASEA(u) ((u).g ? (const char*)XBp + (size_t)(u).pm * (2 * hG) : (const char*)ws + ((u).b == 0 ? OFF_AO : ((u).b == 1 ? OFF_CB : OFF_XQ)) + (size_t)(u).pm * (2 * hY))
#define MU_BASEB(u) ((u).g ? (const char*)ws + OFF_W_GATE + ((size_t)(u).b * 1024 + (size_t)(u).pn * 256) * 2048 : (const char*)ws + OFF_W_OMLA + (size_t)(u).b * 1048576 + (size_t)(u).pn * (2 * hY))
    MUnit cur, nxt; int ui = 0; bool ok0;
    MU_NEXT(0, cur, ok0);
    if (!ok0) return;
    f32x4 acc[2][2][4][2];
#pragma unroll
    for (int a = 0; a < 2; ++a)
#pragma unroll
        for (int b = 0; b < 2; ++b)
#pragma unroll
            for (int m = 0; m < 4; ++m)
#pragma unroll
                for (int n = 0; n < 2; ++n) acc[a][b][m][n] = (f32x4){0.f, 0.f, 0.f, 0.f};
    bf16x8 At[4][2], B0[2][2], B1[2][2];
    const char* cA = MU_BASEA(cur); const char* cB = MU_BASEB(cur);
    {
        const unsigned vc = cur.g ? vY0 + vGd : vY0; const size_t hc = cur.g ? hG : hY, qc = hc >> 1;
        PG8_STAGE(PG8_SB(0, 0), cB, vc, qc); PG8_STAGE(PG8_SB(0, 1), cB + hc, vc, qc); PG8_STAGE(PG8_SA(0, 0), cA, vc, qc); PG8_STAGE(PG8_SA(0, 1), cA + hc, vc, qc);
        if (wr == 1) PG8_BAR;
        PG8_WAIT_V(2); PG8_BAR;
        PG8_STAGE(PG8_SB(1, 0), cB + kstep, vc, qc); PG8_STAGE(PG8_SA(1, 0), cA + kstep, vc, qc); PG8_STAGE(PG8_SB(1, 1), cB + hc + kstep, vc, qc);
        PG8_WAIT_V(6); PG8_BAR;
    }
    for (;;) {
        bool has_next; MU_NEXT(ui + 1, nxt, has_next);
        const char* nA = has_next ? MU_BASEA(nxt) : cA; const char* nB = has_next ? MU_BASEB(nxt) : cB;
        const int ng = has_next ? nxt.g : cur.g;
        const unsigned vc = cur.g ? vY0 + vGd : vY0, vn = ng ? vY0 + vGd : vY0;
        const size_t hc = cur.g ? hG : hY, hn = ng ? hG : hY, qc = hc >> 1;
        const int nt = cur.g ? 16 : 8;
        for (int t = 0; t < nt; t += 2) {
            const bool last = (t == nt - 2);
            const char* a1 = cA + (size_t)(t + 1) * kstep;
            const char* a2 = last ? nA : cA + (size_t)(t + 2) * kstep; const char* b2 = last ? nB : cB + (size_t)(t + 2) * kstep;
            const char* a3 = a2 + kstep; const char* b3 = b2 + kstep;
            const unsigned v2 = last ? vn : vc; const size_t h2 = last ? hn : hc, q2 = h2 >> 1;
            PG8_LDB(B0, 0, 0); PG8_LDB(B1, 0, 1); PG8_SCHED; PG8_LDA(At, 0, 0); PG8_STAGE(PG8_SA(1, 1), a1 + hc, vc, qc);
            PG8_WAIT_V(8); PG8_WAIT_L(0); PG8_BAR; PG8_MMA(0, 0, At, B0); PG8_MMA(0, 1, At, B1); PG8_BAR; PG8_SCHED;
            PG8_LDA(At, 0, 1); PG8_STAGE(PG8_SB(0, 0), b2, v2, q2); PG8_STAGE(PG8_SB(0, 1), b2 + h2, v2, q2); PG8_STAGE(PG8_SA(0, 0), a2, v2, q2);
            PG8_WAIT_V(8); PG8_WAIT_L(0); PG8_BAR; PG8_MMA(1, 0, At, B0); PG8_MMA(1, 1, At, B1); PG8_BAR; PG8_SCHED;
            PG8_LDB(B0, 1, 0); PG8_LDB(B1, 1, 1); PG8_SCHED; PG8_LDA(At, 1, 0); PG8_STAGE(PG8_SA(0, 1), a2 + h2, v2, q2);
            PG8_WAIT_V(8); PG8_WAIT_L(0); PG8_BAR; PG8_MMA(0, 0, At, B0); PG8_MMA(0, 1, At, B1); PG8_BAR; PG8_SCHED;
            PG8_LDA(At, 1, 1); PG8_STAGE(PG8_SB(1, 0), b3, v2, q2); PG8_STAGE(PG8_SB(1, 1), b3 + h2, v2, q2); PG8_STAGE(PG8_SA(1, 0), a3, v2, q2);
            PG8_WAIT_V(8); PG8_WAIT_L(0); PG8_BAR; PG8_MMA(1, 0, At, B0); PG8_MMA(1, 1, At, B1); PG8_BAR; PG8_SCHED;
        }
        if (wr == 0) PG8_BAR;
        E(acc, cur, wr, wc, fr, fq);
        if (!has_next) break;
#pragma unroll
        for (int a = 0; a < 2; ++a)
#pragma unroll
            for (int b = 0; b < 2; ++b)
#pragma unroll
                for (int m = 0; m < 4; ++m)
#pragma unroll
                    for (int n = 0; n < 2; ++n) acc[a][b][m][n] = (f32x4){0.f, 0.f, 0.f, 0.f};
        cur = nxt; cA = nA; cB = nB; ++ui;
        if (wr == 1) PG8_BAR;
    }
    PG8_WAIT_V(0);
    PG8_BAR;
#undef MU_NEXT
#undef MU_BASEA
#undef MU_BASEB
#undef PG8_SA
#undef PG8_SB
#undef PG8_STAGE
#undef PG8_LDA
#undef PG8_LDB
#undef PG8_MMA
#undef PG8_WAIT_V
#undef PG8_WAIT_L
#undef PG8_BAR
#undef PG8_SCHED
}
struct EpiMerge {
    uint4* ytile; uint4* stile; const float* rs1; bf16_t* MERGED;
    __device__ __forceinline__ void operator()(const f32x4 (&acc)[2][2][4][2], const MUnit& u, int wr, int wc, int fr, int fq) const {
        asm volatile("" : "+v"(fr), "+v"(fq));
        const int slot = (wr * 4 + wc) * 16 * 64 + fq * 16 + fr;
#pragma unroll
        for (int ai = 0; ai < 2; ++ai) {
            if (!u.g) {
#pragma unroll
                for (int m = 0; m < 4; ++m)
#pragma unroll
                    for (int bj = 0; bj < 2; ++bj) {
                        const f32x4 v0 = acc[ai][bj][m][0], v1 = acc[ai][bj][m][1]; uint4 w;
                        w.x = ::pk2(v0[0], v0[1]); w.y = ::pk2(v0[2], v0[3]); w.z = ::pk2(v1[0], v1[1]); w.w = ::pk2(v1[2], v1[3]);
                        ytile[slot + ((ai * 4 + m) * 2 + bj) * 64] = w;
                    }
            } else {
                uint4 ys[4][2], ss[4][2]; float ri[4];
#pragma unroll
                for (int m = 0; m < 4; ++m) {
                    ri[m] = rs1[u.pm * BM + ai * HALF + wr * 64 + m * 16 + fr];
#pragma unroll
                    for (int bj = 0; bj < 2; ++bj) {
                        ys[m][bj] = ytile[slot + ((ai * 4 + m) * 2 + bj) * 64];
                        if (u.b > 0) ss[m][bj] = stile[slot + ((ai * 4 + m) * 2 + bj) * 64]; else ss[m][bj] = make_uint4(0u, 0u, 0u, 0u);
                    }
                }
#pragma unroll
                for (int m = 0; m < 4; ++m) {
                    const float rinv = rsqrtf(ri[m] * (1.f / 1024.f) + EPS);
                    bf16_t* mp = MERGED + ((size_t)(u.pn * 4 + (wc >> 1)) * NTOK + (size_t)(u.pm * 2 + ai) * 128) * 64 + ((wr * 4 + m) * 4 + (wc & 1) * 2) * 256 + fr * 16 + fq * 4;
#pragma unroll
                    for (int bj = 0; bj < 2; ++bj) {
                        const uint4 yw = ys[m][bj], sw = ss[m][bj];
                        const f32x4 g0 = acc[ai][bj][m][0] * rinv, g1 = acc[ai][bj][m][1] * rinv;
                        const f32x4 y0 = {::bflo(yw.x), ::bfhi(yw.x), ::bflo(yw.y), ::bfhi(yw.y)}, y1 = {::bflo(yw.z), ::bfhi(yw.z), ::bflo(yw.w), ::bfhi(yw.w)};
                        f32x4 v0 = {::bflo(sw.x), ::bfhi(sw.x), ::bflo(sw.y), ::bfhi(sw.y)}, v1 = {::bflo(sw.z), ::bfhi(sw.z), ::bflo(sw.w), ::bfhi(sw.w)};
#pragma unroll
                        for (int j = 0; j < 4; ++j) { v0[j] += y0[j] * __builtin_amdgcn_rcpf(1.f + __expf(-g0[j])); v1[j] += y1[j] * __builtin_amdgcn_rcpf(1.f + __expf(-g1[j])); }
                        if (u.b < 2) {
                            uint4 w; w.x = ::pk2(v0[0], v0[1]); w.y = ::pk2(v0[2], v0[3]); w.z = ::pk2(v1[0], v1[1]); w.w = ::pk2(v1[2], v1[3]);
                            stile[slot + ((ai * 4 + m) * 2 + bj) * 64] = w;
                        } else { ::st_bf4(mp + (size_t)bj * 2 * NTOK * 64, v0); ::st_bf4(mp + (size_t)bj * 2 * NTOK * 64 + 256, v1); }
                    }
                }
            }
        }
    }
};
}

DEVI void copy_rows_bf16(const float* x0, const float* x1, bf16_t* dst, float* rs, int gw, int nw, int lane) {
    for (int row = gw; row < NTOK; row += nw) {
        const float* src = row < 16384 ? x0 + (size_t)row * 1024 : x1 + (size_t)(row - 16384) * 1024;
        f32x4 v[4]; float s = 0.f;
#pragma unroll
        for (int i = 0; i < 4; ++i) { v[i] = __builtin_nontemporal_load((const f32x4*)(src + lane * 4 + 256 * i)); s += dot4(v[i]); }
        s += __shfl_xor(s, 1); s += __shfl_xor(s, 2); s += __shfl_xor(s, 4); s += __shfl_xor(s, 8); s += __shfl_xor(s, 16); s += __shfl_xor(s, 32);
        if (lane == 0) rs[row] = s;
#pragma unroll
        for (int i = 0; i < 4; ++i) st_bf4(dst + (size_t)row * 1024 + lane * 4 + 256 * i, v[i]);
    }
}

#define W1GU ((bf16_t*)(ws + OFF_W1GU))
#define W1DN ((bf16_t*)(ws + OFF_W1DN))
#define W2DN ((bf16_t*)(ws + OFF_W2DN))
#define W2GU ((bf16_t*)((unsigned char*)p.out + D1_W2GU))
#define W_OUT ((bf16_t*)((unsigned char*)p.out + D1_WOUT))
#define RS2 ((float*)((unsigned char*)p.out + D1_RS2))
#define RS0 ((float*)(ws + OFF_RS0))
#define RS1 ((float*)(ws + OFF_RS1))
#define XB ((bf16_t*)p.out)
#define XB0 ((bf16_t*)((unsigned char*)p.out + D1_OFF))
#define X2B ((bf16_t*)(ws + OFF_X2B))
#define HID2 ((bf16_t*)(ws + OFF_HID2))
#define W_IN1 ((bf16_t*)(ws + OFF_W_IN1))
#define W_IN2 ((bf16_t*)(ws + OFF_W_IN2))
#define W_GATE ((bf16_t*)(ws + OFF_W_GATE))
#define W_UQ ((bf16_t*)(ws + OFF_W_UQ))
#define W_UK ((bf16_t*)(ws + OFF_W_UK))
#define W_UV ((bf16_t*)(ws + OFF_W_UV))
#define W_OMLA ((bf16_t*)(ws + OFF_W_OMLA))
#define W_OCONV ((bf16_t*)(ws + OFF_W_OCONV))
#define W_OMEM ((bf16_t*)(ws + OFF_W_OMEM))
#define W_MEMK ((bf16_t*)(ws + OFF_W_MEMK))
#define W_MEMV ((bf16_t*)(ws + OFF_W_MEMV))
#define MK ((bf16_t*)(ws + OFF_MK))
#define MVT ((bf16_t*)(ws + OFF_MVT))
#define ROPE ((float*)(ws + OFF_ROPE))
#define RSQ ((float*)(ws + OFF_RSQ))
#define RSKV ((float*)(ws + OFF_RSKV))
#define MN ((bf16_t*)(ws + OFF_MN))
#define XQ ((bf16_t*)(ws + OFF_XQ))
#define CQ ((bf16_t*)(ws + OFF_CQ))
#define CKV ((bf16_t*)(ws + OFF_CKV))
#define Qb ((bf16_t*)(ws + OFF_Q))
#define Kb ((bf16_t*)(ws + OFF_K))
#define VT ((bf16_t*)(ws + OFF_VT))
#define HID ((bf16_t*)(ws + OFF_HID))
#define AO ((bf16_t*)(ws + OFF_AO))
#define CB ((bf16_t*)(ws + OFF_CB))
#define Ub ((bf16_t*)(ws + OFF_U))
#define MERGED ((bf16_t*)(ws + OFF_MERGED))
#define LAS __attribute__((address_space(3)))
#define XB_TMO      128
#define XB_XCNT(j)  (256  + 64 * (j))
#define XB_XSUB(j)  (1280 + 64 * (j))
#define XB_XGEN(j)  (2304 + 64 * (j))
#define XB_TOP      3328
#define XB_TOPGEN   3392
#define XCD_BAR_WORDS 3456
#define XB_SPIN_CAP (1u << 18)

__device__ __forceinline__ unsigned xb_ld(unsigned* p)              { return __hip_atomic_load(p, __ATOMIC_RELAXED, __HIP_MEMORY_SCOPE_AGENT); }
__device__ __forceinline__ unsigned xb_add(unsigned* p, unsigned v) { return __hip_atomic_fetch_add(p, v, __ATOMIC_RELAXED, __HIP_MEMORY_SCOPE_AGENT); }
__device__ __forceinline__ unsigned xb_xcc_id() { return (unsigned)__builtin_amdgcn_s_getreg((3 << 11) | 20) & 0xFu; }
#define XB_SPIN(cond, bar) do { unsigned _sp = 0; while (cond) { __builtin_amdgcn_s_sleep(1); \
    if ((++_sp & 255u) == 0u) { if (xb_ld(&(bar)[XB_TMO])) break; if (_sp > XB_SPIN_CAP) { atomicAdd(&(bar)[XB_TMO], 1u); break; } } } } while (0)

struct XcdBarrier {
    unsigned* bar; unsigned x;
    volatile LAS unsigned* st;
};

__device__ __forceinline__ XcdBarrier xcd_barrier_post(unsigned* bar, volatile LAS unsigned* st) {
    XcdBarrier b; b.bar = bar; b.x = xb_xcc_id(); b.st = st;
    if (threadIdx.x == 0) (void)xb_add(&bar[XB_XCNT(b.x)], 1u);
    return b;
}
__device__ __forceinline__ void xcd_barrier_complete(unsigned* bar, unsigned x, unsigned& nloc, unsigned& nx) {
    const unsigned G = gridDim.x * gridDim.y * gridDim.z;
    unsigned sum, cnt, mine, sp = 0u;
    for (;;) {
        sum = 0u; cnt = 0u; mine = 0u;
#pragma unroll
        for (unsigned j = 0; j < 16; ++j) { const unsigned c = xb_ld(&bar[XB_XCNT(j)]); sum += c; cnt += (c > 0u) ? 1u : 0u; mine = (j == x) ? c : mine; }
        if (sum == G) break;
        __builtin_amdgcn_s_sleep(1);
        if ((++sp & 255u) == 0u) { if (xb_ld(&bar[XB_TMO])) break; if (sp > XB_SPIN_CAP) { atomicAdd(&bar[XB_TMO], 1u); break; } }
    }
    nloc = mine > 0u ? mine : 1u; nx = cnt > 0u ? cnt : 1u;
}

__device__ __forceinline__ void xcd_barrier(const XcdBarrier& b) {
    asm volatile("s_waitcnt vmcnt(0)" ::: "memory");
    __syncthreads();
    if (threadIdx.x == 0) {
        unsigned* bar = b.bar;
        __builtin_amdgcn_s_waitcnt(0);
        unsigned nloc = b.st[0], nx = b.st[1];
        if (nloc == 0u) { xcd_barrier_complete(bar, b.x, nloc, nx); b.st[0] = nloc; b.st[1] = nx; }
        const unsigned old = xb_add(&bar[XB_XSUB(b.x)], 1u);
        const unsigned gen = old / nloc;
        if (old + 1u == (gen + 1u) * nloc) {
            __builtin_amdgcn_fence(__ATOMIC_RELEASE, "agent");
            asm volatile("s_waitcnt vmcnt(0)" ::: "memory");
            const unsigned og = xb_add(&bar[XB_TOP], 1u);
            const unsigned tg = og / nx;
            if (og + 1u == (tg + 1u) * nx) xb_add(&bar[XB_TOPGEN], 1u);
            else XB_SPIN(xb_ld(&bar[XB_TOPGEN]) == tg, bar);
            __builtin_amdgcn_fence(__ATOMIC_ACQUIRE, "agent");
            xb_add(&bar[XB_XGEN(b.x)], 1u);
            asm volatile("s_waitcnt vmcnt(0)" ::: "memory");
        } else {
            XB_SPIN(xb_ld(&bar[XB_XGEN(b.x)]) == gen, bar);
            __builtin_amdgcn_fence(__ATOMIC_ACQUIRE, "agent");
            asm volatile("s_waitcnt vmcnt(0)" ::: "memory");
        }
    }
    __syncthreads();
}

#define PHASE_VARS \
    int tx_ = threadIdx.x; asm volatile("" : "+v"(tx_)); \
    const int vh = __builtin_amdgcn_readfirstlane(tx_ >> 8); \
    unsigned char* const smem = smem_all + vh * SM_TOTAL; \
    const int tid = tx_ & 255, lane = tid & 63, wid = tid >> 6, wr = wid >> 1, wc = wid & 1, fr = lane & 15, fq = lane >> 4; \
    const int G = gridDim.x * 2, bid = blockIdx.x * 2 + vh; \
    (void)smem; (void)tid; (void)lane; (void)wid; (void)wr; (void)wc; (void)fr; (void)fq; (void)G; (void)bid;
__global__ void __launch_bounds__(512, 2) mega(Params p) {
    extern __shared__ __attribute__((aligned(16))) unsigned char smem_all[];

    unsigned char* ws = p.ws;
    volatile LAS unsigned* bst = (volatile LAS unsigned*)((LAS unsigned char*)smem_all + 2 * SM_TOTAL);
    if (threadIdx.x == 0) { bst[0] = 0u; bst[1] = 0u; }
    __syncthreads();
    const XcdBarrier xbar = xcd_barrier_post((unsigned*)(ws + OFF_BAR), bst);

    { PHASE_VARS
    { int cbase = 0; for (int id = 0; id < 13; ++id) { const WSpec s = get_spec(p, id); convert_spec(s, smem, bid, G, tid, cbase); } }
    for (int i = bid * 256 + tid; i < 3 * NTOK; i += G * 256) RSQ[i] = 0.f;
    for (int i = bid * 256 + tid; i < 8192 * 16; i += G * 256) {
        const int s = i >> 4, f = i & 15, a = f >> 2, b = f & 3;
        const double fa = a == 0 ? 1.0 : (a == 1 ? 0.1 : (a == 2 ? 0.01 : 0.001));
        const double fb = b == 0 ? 1.0 : (b == 1 ? 0.5623413251903491 : (b == 2 ? 0.31622776601683794 : 0.1778279410038923));
        double rev = (double)s * fa * fb * 0.15915494309189535; rev -= floor(rev);
        const float rv = (float)rev;
        ROPE[2 * i] = __builtin_amdgcn_cosf(rv); ROPE[2 * i + 1] = __builtin_amdgcn_sinf(rv);
    }
    for (int row = bid * 4 + wid; row < 1536; row += G * 4) {
        const float* src = row < 512 ? p.memp + (size_t)row * 1024 : p.mems + (size_t)(row - 512) * 1024;
        f32x4 v[4]; float s = 0.f;
#pragma unroll
        for (int i = 0; i < 4; ++i) { v[i] = ld_f4(src + lane * 4 + 256 * i); s += dot4(v[i]); }
        s += __shfl_xor(s, 1); s += __shfl_xor(s, 2); s += __shfl_xor(s, 4); s += __shfl_xor(s, 8); s += __shfl_xor(s, 16); s += __shfl_xor(s, 32);
        const float inv = rsqrtf(s * (1.f / 1024.f) + EPS);
#pragma unroll
        for (int i = 0; i < 4; ++i) st_bf4(MN + (size_t)row * 1024 + lane * 4 + 256 * i, v[i] * inv);
    }
    copy_rows_bf16(p.xp, p.xs, XB0, RS0, bid * 4 + wid, G * 4, lane);
    }
    xcd_barrier(xbar);
    { PHASE_VARS
    { pg8::Gemm g{XB0, W1GU, NTOK, 5632, 1024, 1024, 1024, 128, 128}; pg8::StaticOrder so; so.init(NTOK, 5632, gridDim.x, blockIdx.x);
      pg8::gemm_phase<pg8::EpiGU, pg8::StaticOrder, true, true>((PG8_LAS unsigned char*)smem_all, g, so, pg8::EpiGU{HID, RS0}); }
    }
    xcd_barrier(xbar);
    { PHASE_VARS
    { pg8::Gemm g{HID, W1DN, NTOK, 1024, 2816, 0, 2816, (size_t)NTOK * 128, 128}; pg8::StaticOrder so; so.init(NTOK, 1024, gridDim.x, blockIdx.x);
      pg8::gemm_phase<pg8::EpiRes<1>, pg8::StaticOrder, true, true>((PG8_LAS unsigned char*)smem_all, g, so, pg8::EpiRes<1>{nullptr, nullptr, XB0, XB, RS1, 0.5f}); }
    }
    xcd_barrier(xbar);
    { PHASE_VARS
    { int cbase = 0; for (int id = 13; id < 16; ++id) { const WSpec s = get_spec(p, id); convert_spec(s, smem, bid, G, tid, cbase); } }
    for (int i = bid * 256 + tid; i < NTOK; i += G * 256) RS2[i] = 0.f;
    __syncthreads();
    { pg8::Gemm g{XB, W_IN1, NTOK, 1280, 1024, 1024, 1024, 128, 128}; pg8::StaticOrder so; so.init(NTOK, 1280, gridDim.x, blockIdx.x);
      pg8::gemm_phase<pg8::EpiIn1, pg8::StaticOrder, true, true>((PG8_LAS unsigned char*)smem_all, g, so, pg8::EpiIn1{RS1, CQ, CKV, XQ, RSQ, RSKV}); }
    __syncthreads();
    for (int u = bid - 256; u >= 0 && u < 96; u += 1 << 30) {
        f32x4 acc[4][4]; zero_acc(acc);
        if (u < 48) {
            const int tm = u >> 2, hh = u & 3;
            gemm_tile<false>(acc, MN + (size_t)tm * 128 * 1024, 1024, W_MEMK + (size_t)hh * 128 * 1024, 1024, 16, smem);
            float tot[4]; tile_row_ss(acc, tot, smem, wr, wc, fr, fq);
#pragma unroll
            for (int m = 0; m < 4; ++m) {
                const int row = tm * 128 + wr * 64 + m * 16 + fr; const float inv = rsqrtf(tot[m] * (1.f / 128.f) + EPS);
#pragma unroll
                for (int n = 0; n < 4; ++n) { const int c = wc * 64 + n * 16 + fq * 4; st_bf4(MK + (size_t)row * 512 + hh * 128 + c, acc[m][n] * inv * ld_f4(p.xa_k_norm + c)); }
            }
        } else {
            const int v = u - 48, tm = v / 12, tn = v % 12;
            gemm_tile<false>(acc, W_MEMV + (size_t)tm * 128 * 1024, 1024, MN + (size_t)tn * 128 * 1024, 1024, 16, smem);
#pragma unroll
            for (int m = 0; m < 4; ++m) {
                const int d = wr * 64 + m * 16 + fr;
#pragma unroll
                for (int n = 0; n < 4; ++n) { const int col = tn * 128 + wc * 64 + n * 16 + fq * 4, b = col >> 8, mm = col & 255; st_bf4(MVT + ((size_t)(b * 4 + tm) * 128 + d) * 256 + mm, acc[m][n]); }
            }
        }
    }
    }
    xcd_barrier(xbar);
    { PHASE_VARS
    { pg8::Gemm g{CQ, W_UQ, NTOK, 768, 384, 384, 384, 128, 128}; pg8::StaticOrder so; so.init(NTOK, 768, gridDim.x, blockIdx.x);
      pg8::gemm_phase<pg8::EpiQ, pg8::StaticOrder, true, true>((PG8_LAS unsigned char*)smem_all, g, so, pg8::EpiQ{RSQ, Qb}); }
    { pg8::Gemm g{CKV, W_UK, NTOK, 512, 256, 288, 288, 128, 128}; pg8::StaticOrder so; so.init(NTOK, 512, gridDim.x, blockIdx.x);
      pg8::gemm_phase<pg8::EpiK, pg8::StaticOrder, true, true>((PG8_LAS unsigned char*)smem_all, g, so, pg8::EpiK{RSKV, CKV, p.mla_k_norm, ROPE, Kb}); }
    { pg8::Gemm g{W_UV, CKV, 512, NTOK, 256, 288, 288, 128, 128}; pg8::StaticOrder so; so.init(512, NTOK, gridDim.x, blockIdx.x);
      pg8::gemm_phase<pg8::EpiVt, pg8::StaticOrder, true, true>((PG8_LAS unsigned char*)smem_all, g, so, pg8::EpiVt{RSKV, VT}); }
    }
    xcd_barrier(xbar);
    { PHASE_VARS
    for (int j = blockIdx.x; j < 1024; j += gridDim.x) {
        int tok0i, pair, qt, nk, vtoff;
        if (j < 512) { const int r = j >> 8, i = j & 255; pair = (i & 7) + 8 * r; qt = i >> 3; tok0i = (pair >> 3) * 8192; nk = 8192; vtoff = 0; }
        else { const int jj = j - 512, r = jj >> 8, i = jj & 255, slot = i >> 3; pair = (i & 7) + 8 * (2 * r + (slot >> 4)); qt = slot & 15; tok0i = 16384 + (pair >> 3) * 4096; nk = 4096; vtoff = 8388608; }
        const int h = pair & 7;
        const size_t tok0 = (size_t)tok0i;
        attn_mla_item(p.mla_q_norm, ROPE, qt * 256, Qb + ((tok0 + qt * 256) * 8 + h) * 96, Kb + (tok0 * 8 + h) * 96, VT + (size_t)vtoff + (size_t)pair * 64 * nk, nk, nk, AO + (tok0 + qt * 256) * 512 + h * 64, smem_all, tx_);
    }
    __syncthreads();
    for (int jj = bid; jj < 1024; jj += G) {
        const int tile = jj >> 2, hh = jj & 3, tok0 = tile * 128;
        const int mb = tok0 < 16384 ? (tok0 >> 13) : 2 + ((tok0 - 16384) >> 12);
        bf16_t* qp = XQ + (size_t)tok0 * 512 + hh * 128;
        attn_item<128, 128, false, true>(p.xa_q_norm, QSCALE_XA, qp, 512, MK + (size_t)mb * 256 * 512 + hh * 128, 512, MVT + (size_t)(mb * 4 + hh) * 128 * 256, 256, 256, qp, 512, smem);
    }
    }
    xcd_barrier(xbar);
    { PHASE_VARS
    { pg8::Gemm g{XB, W_IN2, NTOK, 1536, 1024, 1024, 1024, 128, 128}; pg8::StaticOrder so; so.init(NTOK, 1536, gridDim.x, blockIdx.x);
      pg8::gemm_phase<pg8::EpiIn2, pg8::StaticOrder, true, true>((PG8_LAS unsigned char*)smem_all, g, so, pg8::EpiIn2{RS1, CB, Ub}); }
    }
    xcd_barrier(xbar);
    { PHASE_VARS
    for (int i = bid * 256 + tid; i < NTOK * 64; i += G * 256) {
        const int tok = i >> 6, c0 = (i & 63) * 8, pos = tok_pos(tok), slen = tok < 16384 ? 8192 : 4096;
        const bf16_t* up = Ub + (size_t)tok * 512 + c0;
        const uint4 z = {0u, 0u, 0u, 0u};
        const uint4 u0 = pos > 0 ? *(const uint4*)(up - 512) : z, u1 = *(const uint4*)up, u2 = pos < slen - 1 ? *(const uint4*)(up + 512) : z;
        const uint4 cb = *(const uint4*)(CB + (size_t)tok * 512 + c0);
        const unsigned a0[4] = {u0.x, u0.y, u0.z, u0.w}, a1[4] = {u1.x, u1.y, u1.z, u1.w}, a2[4] = {u2.x, u2.y, u2.z, u2.w}, ab[4] = {cb.x, cb.y, cb.z, cb.w};
        unsigned o[4];
#pragma unroll
        for (int q = 0; q < 4; ++q) {
            const int c = c0 + 2 * q;
            const float w0l = p.conv_w[c], w0h = p.conv_w[c + 1], w1l = p.conv_w[512 + c], w1h = p.conv_w[512 + c + 1], w2l = p.conv_w[1024 + c], w2h = p.conv_w[1024 + c + 1];
            const float yl = bflo(a0[q]) * w0l + bflo(a1[q]) * w1l + bflo(a2[q]) * w2l, yh = bfhi(a0[q]) * w0h + bfhi(a1[q]) * w1h + bfhi(a2[q]) * w2h;
            o[q] = pk2(bflo(ab[q]) * yl, bfhi(ab[q]) * yh);
        }
        uint4 ov; ov.x = o[0]; ov.y = o[1]; ov.z = o[2]; ov.w = o[3];
        *(uint4*)(CB + (size_t)tok * 512 + c0) = ov;
    }
    }
    xcd_barrier(xbar);
    { PHASE_VARS
    { pg8::StaticOrder so; so.init(NTOK, 1024, gridDim.x, blockIdx.x);
      pg8::gemm_phase_merge<pg8::EpiMerge>((PG8_LAS unsigned char*)smem_all, ws, XB, so, pg8::EpiMerge{(uint4*)Ub + (size_t)blockIdx.x * 8192, (uint4*)((unsigned char*)p.out + D1_STILE) + (size_t)blockIdx.x * 8192, RS1, MERGED}); }
    }
    xcd_barrier(xbar);
    { PHASE_VARS
    { pg8::Gemm g{MERGED, W_OUT, NTOK, 1024, 1024, 0, 1024, (size_t)NTOK * 128, 128}; pg8::StaticOrder so; so.init(NTOK, 1024, gridDim.x, blockIdx.x);
      pg8::gemm_phase<pg8::EpiRes<1>, pg8::StaticOrder, true, true>((PG8_LAS unsigned char*)smem_all, g, so, pg8::EpiRes<1>{nullptr, nullptr, XB, X2B, RS2, 1.0f}); }
    }
    xcd_barrier(xbar);
    { PHASE_VARS
    { pg8::Gemm g{X2B, W2GU, NTOK, 5632, 1024, 1024, 1024, 128, 128}; pg8::StaticOrder so; so.init(NTOK, 5632, gridDim.x, blockIdx.x);
      pg8::gemm_phase<pg8::EpiGU, pg8::StaticOrder, true, true>((PG8_LAS unsigned char*)smem_all, g, so, pg8::EpiGU{HID2, RS2}); }
    }
    xcd_barrier(xbar);
    { PHASE_VARS
    { pg8::Gemm g{HID2, W2DN, NTOK, 1024, 2816, 0, 2816, (size_t)NTOK * 128, 128}; pg8::StaticOrder so; so.init(NTOK, 1024, gridDim.x, blockIdx.x);
      pg8::gemm_phase<pg8::EpiFinal, pg8::StaticOrder, true, true>((PG8_LAS unsigned char*)smem_all, g, so, pg8::EpiFinal{X2B, p.out}); }
    }
}

extern "C" void kernel_launch(void* const* d_in, const int* in_sizes, int n_in, void* d_out, int out_size, void* d_ws, size_t ws_size, hipStream_t stream) {
    (void)in_sizes; (void)n_in; (void)out_size;
    static int grid_blocks = 0;
    if (!grid_blocks) {
        int dev = 0, cus = 0, per_cu = 0;
        (void)hipGetDevice(&dev);
        (void)hipDeviceGetAttribute(&cus, hipDeviceAttributeMultiprocessorCount, dev);
        (void)hipFuncSetAttribute((const void*)mega, hipFuncAttributeMaxDynamicSharedMemorySize, 2 * SM_TOTAL + 16);
        (void)hipOccupancyMaxActiveBlocksPerMultiprocessor(&per_cu, (const void*)mega, 512, 2 * SM_TOTAL + 16);
        if (per_cu > 1) per_cu = 1;
        if (per_cu < 1) per_cu = 1;
        grid_blocks = cus * per_cu;
        if (grid_blocks > 256) grid_blocks = 256;
    }
    if (ws_size < WS_SIZE) { fprintf(stderr, "workspace too small: %zu < %zu\n", ws_size, (size_t)WS_SIZE); return; }
    Params p{};
    const float* const* in = (const float* const*)d_in;
    p.xp = in[0]; p.xs = in[1]; p.memp = in[2]; p.mems = in[3];
    p.ffn1_norm = in[4]; p.ffn1_gu = in[5]; p.ffn1_down = in[6]; p.mix_norm = in[7]; p.w_in = in[8]; p.q_lora_norm = in[9]; p.w_uq = in[10];
    p.kv_lora_norm = in[11]; p.w_uk = in[12]; p.w_uv = in[13]; p.mla_q_norm = in[14]; p.mla_k_norm = in[15]; p.w_o_mla = in[16]; p.conv_w = in[17];
    p.w_o_conv = in[18]; p.mem_norm = in[19]; p.w_mem_kv = in[20]; p.xa_q_norm = in[21]; p.xa_k_norm = in[22]; p.w_o_mem = in[23]; p.w_out = in[24];
    p.ffn2_norm = in[25]; p.ffn2_gu = in[26]; p.ffn2_down = in[27];
    p.out = (float*)d_out; p.ws = (unsigned char*)d_ws;
    if (hipMemsetAsync((unsigned char*)d_ws + OFF_BAR, 0, 16384, stream) != hipSuccess) { fprintf(stderr, "memset of the barrier words failed\n"); return; }
    void* args[] = {&p};
    hipError_t e = hipLaunchCooperativeKernel((const void*)mega, dim3(grid_blocks), dim3(512), args, 2 * SM_TOTAL + 16, stream);
    if (e != hipSuccess) fprintf(stderr, "cooperative launch failed: %s (grid %d)\n", hipGetErrorString(e), grid_blocks);
}
```
